# Optimizing an MI355X kernel written in HIP

```python
import math
import jax, jax.numpy as jnp
from jax import lax
import numpy as np

D_MODEL = 2048
BATCH = 4
SEQ = 2048
DEPTH = 1

N_HEADS_A = 8
HEAD_DIM_A = 128
WIDTH_A = N_HEADS_A * HEAD_DIM_A
N_IDX_HEADS = 16
IDX_DIM = 64
TOPK_MAX = 256
Q_BLOCK = 128
N_GROUPS_B = 8
GROUP_DIM_B = 128
WIDTH_B = N_GROUPS_B * GROUP_DIM_B
CHUNK = 128
D_FF = ((8 * D_MODEL + 3 * 256 - 1) // (3 * 256)) * 256
N_BUCKETS = 32
MAX_DISTANCE = 128
EPS = 1e-6
IN_SPLITS = (WIDTH_A, WIDTH_A, WIDTH_A, N_IDX_HEADS * IDX_DIM, IDX_DIM, N_IDX_HEADS,
             WIDTH_B, WIDTH_B, D_MODEL, D_MODEL)
D_IN = sum(IN_SPLITS)

kernel_name = "hybrid_dsa_gmlp_gated_block"


def _rmsnorm(x, g):
    xf = x.astype(jnp.float32)
    y = xf * lax.rsqrt(jnp.mean(xf * xf, axis=-1, keepdims=True) + EPS)
    return (y * g.astype(jnp.float32)).astype(x.dtype)


def _t5_bucket(dist):
    max_exact = N_BUCKETS // 2
    d = jnp.maximum(dist.astype(jnp.float32), 1.0)
    large = max_exact + (jnp.log(d / max_exact) / math.log(MAX_DISTANCE / max_exact)
                         * (N_BUCKETS - max_exact)).astype(jnp.int32)
    large = jnp.minimum(large, N_BUCKETS - 1)
    return jnp.where(dist < max_exact, dist, large)


def _split_cols(proj):
    offs = np.cumsum(IN_SPLITS)[:-1].tolist()
    return jnp.split(proj, offs, axis=-1)


def _sparse_attention(q, k, v, q_idx, k_idx, w_idx, rel_bias):
    B, S = q.shape[0], q.shape[1]
    n_sel = min(TOPK_MAX, S // 4)
    n_blocks = S // Q_BLOCK
    scale = HEAD_DIM_A ** -0.5
    idx_scale = (IDX_DIM ** -0.5) * (N_IDX_HEADS ** -0.5)
    key_pos = jnp.arange(S, dtype=jnp.int32)
    b_ix = jnp.arange(B)[:, None, None]
    k_idx_f = k_idx.astype(jnp.float32)

    def block(i):
        t0 = i * Q_BLOCK
        qb = lax.dynamic_slice_in_dim(q, t0, Q_BLOCK, axis=1)
        qib = lax.dynamic_slice_in_dim(q_idx, t0, Q_BLOCK, axis=1).astype(jnp.float32)
        wib = lax.dynamic_slice_in_dim(w_idx, t0, Q_BLOCK, axis=1).astype(jnp.float32)
        q_pos = t0 + jnp.arange(Q_BLOCK, dtype=jnp.int32)
        head_scores = jax.nn.relu(jnp.einsum('bqhd,bsd->bqhs', qib, k_idx_f))
        score = jnp.einsum('bqhs,bqh->bqs', head_scores, wib) * idx_scale
        causal = key_pos[None, :] <= q_pos[:, None]
        score = jnp.where(causal[None], score, -jnp.inf)
        _, sel = lax.top_k(score, n_sel)
        k_sel = k[b_ix, sel]
        v_sel = v[b_ix, sel]
        dist = q_pos[None, :, None] - sel
        valid = dist >= 0
        bias = rel_bias[_t5_bucket(jnp.maximum(dist, 0))]
        logits = (jnp.einsum('bqhd,bqkhd->bhqk', qb, k_sel).astype(jnp.float32) * scale
                  + bias.astype(jnp.float32).transpose(0, 3, 1, 2))
        logits = jnp.where(valid[:, None], logits, -jnp.inf)
        p = jax.nn.softmax(logits, axis=-1).astype(v.dtype)
        return jnp.einsum('bhqk,bqkhd->bqhd', p, v_sel)

    out = lax.map(block, jnp.arange(n_blocks, dtype=jnp.int32))
    return out.transpose(1, 0, 2, 3, 4).reshape(B, S, WIDTH_A)


def _chunked_sgu(u, v, w_spatial, b_spatial, norm_g):
    B, S = u.shape[0], u.shape[1]
    v = _rmsnorm(v, norm_g)
    vc = v.reshape(B, S // CHUNK, CHUNK, N_GROUPS_B, GROUP_DIM_B)
    mask = jnp.tril(jnp.ones((CHUNK, CHUNK), dtype=bool))
    w = jnp.where(mask[None], w_spatial, 0.0)
    z = jnp.einsum('gts,bcsgd->bctgd', w, vc) + b_spatial.T[:, :, None]
    return u * z.reshape(B, S, WIDTH_B)


def setup_inputs(seed: int = 0) -> dict:
    key = jax.random.key(seed)
    ks = jax.random.split(key, 17)

    def nrm(k, shape, scale):
        return jax.random.normal(k, shape, jnp.float32) * scale

    return {
        "x": nrm(ks[0], (BATCH, SEQ, D_MODEL), 1.0),
        "norm1_g": 1.0 + nrm(ks[1], (DEPTH, D_MODEL), 0.02),
        "w_in": nrm(ks[2], (DEPTH, D_MODEL, D_IN), D_MODEL ** -0.5),
        "q_norm_g": 1.0 + nrm(ks[3], (DEPTH, HEAD_DIM_A), 0.02),
        "k_norm_g": 1.0 + nrm(ks[4], (DEPTH, HEAD_DIM_A), 0.02),
        "idx_k_norm_g": 1.0 + nrm(ks[5], (DEPTH, IDX_DIM), 0.02),
        "sgu_norm_g": 1.0 + nrm(ks[6], (DEPTH, WIDTH_B), 0.02),
        "w_spatial": nrm(ks[7], (DEPTH, N_GROUPS_B, CHUNK, CHUNK), 0.5 * CHUNK ** -0.5),
        "b_spatial": 1.0 + nrm(ks[8], (DEPTH, N_GROUPS_B, CHUNK), 0.1),
        "w_proj_a": nrm(ks[9], (DEPTH, WIDTH_A, D_MODEL), WIDTH_A ** -0.5),
        "w_proj_b": nrm(ks[10], (DEPTH, WIDTH_B, D_MODEL), WIDTH_B ** -0.5),
        "w_out": nrm(ks[11], (DEPTH, D_MODEL, D_MODEL), D_MODEL ** -0.5),
        "norm2_g": 1.0 + nrm(ks[12], (DEPTH, D_MODEL), 0.02),
        "w_ffn_gate": nrm(ks[13], (DEPTH, D_MODEL, D_FF), D_MODEL ** -0.5),
        "w_ffn_up": nrm(ks[14], (DEPTH, D_MODEL, D_FF), D_MODEL ** -0.5),
        "w_ffn_down": nrm(ks[15], (DEPTH, D_FF, D_MODEL), D_FF ** -0.5),
        "rel_bias": nrm(ks[16], (N_BUCKETS, N_HEADS_A), 0.5),
    }


def reference(x, norm1_g, w_in, q_norm_g, k_norm_g, idx_k_norm_g, sgu_norm_g,
              w_spatial, b_spatial, w_proj_a, w_proj_b, w_out, norm2_g,
              w_ffn_gate, w_ffn_up, w_ffn_down, rel_bias):
    B, S = x.shape[0], x.shape[1]
    for l in range(DEPTH):
        h = _rmsnorm(x, norm1_g[l])
        proj = h @ w_in[l]
        q, k, v, q_i, k_i, w_i, u_b, v_b, g_a, g_b = _split_cols(proj)
        q = _rmsnorm(q.reshape(B, S, N_HEADS_A, HEAD_DIM_A), q_norm_g[l])
        k = _rmsnorm(k.reshape(B, S, N_HEADS_A, HEAD_DIM_A), k_norm_g[l])
        v = v.reshape(B, S, N_HEADS_A, HEAD_DIM_A)
        q_i = q_i.reshape(B, S, N_IDX_HEADS, IDX_DIM)
        k_i = _rmsnorm(k_i, idx_k_norm_g[l])
        out_a = _sparse_attention(q, k, v, q_i, k_i, w_i, rel_bias)
        out_b = _chunked_sgu(jax.nn.gelu(u_b), jax.nn.gelu(v_b),
                             w_spatial[l], b_spatial[l], sgu_norm_g[l])
        merged = (jax.nn.sigmoid(g_a) * (out_a @ w_proj_a[l])
                  + jax.nn.sigmoid(g_b) * (out_b @ w_proj_b[l]))
        x = x + merged @ w_out[l]
        h = _rmsnorm(x, norm2_g[l])
        x = x + (jax.nn.silu(h @ w_ffn_gate[l]) * (h @ w_ffn_up[l])) @ w_ffn_down[l]
    return x
```

```cpp
#include <hip/hip_runtime.h>
#include <hip/hip_cooperative_groups.h>
#include <cstdio>
#include <cstdint>
namespace cg = cooperative_groups;

#ifndef ONE_LAUNCH
#define ONE_LAUNCH 1
#endif
#ifndef REP_MASK
#define REP_MASK 0
#endif
#define NREP(k) (((REP_MASK >> (k)) & 1) ? 2 : 1)

#define LAS __attribute__((address_space(3)))
typedef unsigned short bf16;
typedef short bf16x8 __attribute__((ext_vector_type(8)));
typedef float f32x4 __attribute__((ext_vector_type(4)));
typedef float f32x16 __attribute__((ext_vector_type(16)));
typedef unsigned u32x4 __attribute__((ext_vector_type(4)));
typedef unsigned u32x2 __attribute__((ext_vector_type(2)));
typedef int i32x4 __attribute__((ext_vector_type(4)));
typedef int i32x8 __attribute__((ext_vector_type(8)));

constexpr int NB = 4, SEQ = 2048, DM = 2048, MTOK = NB * SEQ;
constexpr int WA = 1024, NH = 8, HD = 128, NIH = 16, IDXD = 64, WBW = 1024, NG = 8, CHUNK = 128;
constexpr int DFF = 5632, DIN = 10320, NIN = 10496;
constexpr float EPS = 1e-6f;
constexpr float LOG2E = 1.4426950408889634f;

constexpr size_t MiB = 1u << 20;
constexpr size_t WS_CTL = 0, CTL_BYTES = 144 * 1024;
constexpr size_t WS_KI = 1 * MiB;
constexpr size_t WS_WI = 2 * MiB;
constexpr size_t WS_WSP = 2 * MiB + 512 * 1024, WS_TBL = 2 * MiB + 768 * 1024;
constexpr size_t WS_MASK = 3 * MiB;
constexpr size_t WS_WIN = 5 * MiB;
constexpr size_t WS_MERGED = 5 * MiB;
constexpr size_t WS_SLAB = 5 * MiB;
constexpr size_t WS_WAB = 46 * MiB;
constexpr size_t WS_WOUT = 54 * MiB;
constexpr size_t WS_W1 = 62 * MiB;
constexpr size_t WS_W2 = 106 * MiB;
constexpr size_t WS_H1 = 128 * MiB;
constexpr size_t WS_OAB = 128 * MiB;
constexpr size_t WS_ACT = 128 * MiB;
constexpr size_t WS_Q = 160 * MiB, WS_K = 176 * MiB, WS_VT = 192 * MiB, WS_QI = 208 * MiB;
constexpr size_t WS_U = 224 * MiB, WS_VBT = 240 * MiB;
constexpr size_t WS_X1B = 224 * MiB;
constexpr size_t WS_GA = 256 * MiB, WS_GB = 288 * MiB;
constexpr size_t WS_END = 320 * MiB;
constexpr size_t OUT_H1F8 = 0, OUT_W8 = 16 * MiB;
constexpr size_t CTL_ROWSQ_VB = 0, CTL_ROWSQ2 = 32768, CTL_BAR = 65536, CTL_PAIR = 131072;

constexpr int RING_BYTES = 131072, SCR_OFF = RING_BYTES, LDS_BYTES = 147456;

__device__ const unsigned char T5_BUCKET[128] = {0, 1, 2, 3, 4, 5, 6, 7, 8, 9, 10, 11, 12, 13, 14, 15, 16, 16, 16, 17, 17, 18, 18, 18, 19, 19, 19, 20, 20, 20, 20, 21, 21, 21, 21, 22, 22, 22, 22, 22, 23, 23, 23, 23, 23, 23, 24, 24, 24, 24, 24, 24, 25, 25, 25, 25, 25, 25, 25, 26, 26, 26, 26, 26, 26, 26, 26, 27, 27, 27, 27, 27, 27, 27, 27, 27, 27, 28, 28, 28, 28, 28, 28, 28, 28, 28, 28, 29, 29, 29, 29, 29, 29, 29, 29, 29, 29, 29, 29, 30, 30, 30, 30, 30, 30, 30, 30, 30, 30, 30, 30, 30, 30, 31, 31, 31, 31, 31, 31, 31, 31, 31, 31, 31, 31, 31, 31, 31};

__device__ __forceinline__ unsigned f2bf(float f) { unsigned u = __builtin_bit_cast(unsigned, f); return (u + 0x7fffu + ((u >> 16) & 1u)) >> 16; }
typedef float f32x2_t __attribute__((ext_vector_type(2))); typedef __bf16 bf16x2_t __attribute__((ext_vector_type(2)));
__device__ __forceinline__ unsigned pk2(float lo, float hi) { f32x2_t v = {lo, hi}; bf16x2_t b = __builtin_convertvector(v, bf16x2_t); return __builtin_bit_cast(unsigned, b); }
__device__ __forceinline__ float bf2f(unsigned v) { return __builtin_bit_cast(float, v << 16); }
__device__ __forceinline__ float sigmoidf_(float x) { return __builtin_amdgcn_rcpf(1.0f + __builtin_amdgcn_exp2f(-x * LOG2E)); }
__device__ __forceinline__ float gelu_tanh(float x) { const float t = x * (1.0f + 0.044715f * x * x) * (2.0f * 0.7978845608028654f); return x * sigmoidf_(t); }
__device__ __forceinline__ float wave_sum(float v) {
#pragma unroll
    for (int o = 1; o < 64; o <<= 1) v += __shfl_xor(v, o);
    return v;
}
__device__ __forceinline__ int rowoff16(int i) { return (i & 3) + 8 * (i >> 2); }
#define LDS_WAIT() asm volatile("s_waitcnt lgkmcnt(0)" ::: "memory")
#define LDS_BARRIER() do { asm volatile("s_waitcnt lgkmcnt(0)" ::: "memory"); __builtin_amdgcn_s_barrier(); asm volatile("" ::: "memory"); } while (0)
#define AT_WAIT_BARRIER() do { asm volatile("s_waitcnt vmcnt(0) lgkmcnt(0)" ::: "memory"); __builtin_amdgcn_s_barrier(); asm volatile("" ::: "memory"); } while (0)

namespace pg8 {
#define PG8_LAS __attribute__((address_space(3)))
typedef unsigned short bf16_t;
constexpr int BM = 256, BK = 64, HALF = 128, HTB = HALF * BK * 2, STAGE_BYTES = 8 * HTB, NXCD = 8, WGM = 8;
__host__ __device__ __forceinline__ int lds_byte(int r, int c) { const int st = (r >> 4) * 2 + (c >> 5), rr = r & 15, cc = c & 31, ob = rr * 64 + cc * 2; return st * 1024 + (ob ^ (((ob >> 9) & 1) << 5)); }
__host__ __device__ __forceinline__ void stage_rc(int b, int& R, int& C) { const int st = b / 1024, sb = b % 1024, swz = sb ^ (((sb >> 9) & 1) << 5); R = (st >> 1) * 16 + swz / 64; C = (st & 1) * 32 + (swz % 64) / 2; }
__host__ __device__ __forceinline__ int perm32(int rho) { const int n = rho >> 4, i = rho & 15; return 8 * (i >> 2) + 4 * n + (i & 3); }
struct Unit { int pm, pn; };
struct Gemm { const bf16_t* A; const bf16_t* Bt; int M, N, K, lda, ldb, T8 = 0; };
struct StaticOrder {
    int nM, nN, nwg, G, c;
    __host__ __device__ void init(int M, int N, int G_, int c_) { nM = M / BM; nN = N / BM; nwg = nM * nN; G = G_; c = c_; }
    __host__ __device__ bool next(int i, Unit& u) const {
        const long L = (long)i * G + c; if (L >= nwg) return false;
        int wgid = (int)L; { const int q = nwg / NXCD, r = nwg % NXCD, xcd = wgid % NXCD, off = wgid / NXCD; wgid = (xcd < r ? xcd * (q + 1) : r * (q + 1) + (xcd - r) * q) + off; }
        const int nig = WGM * nN, gid = wgid / nig, fm = gid * WGM, gsz = (nM - fm) < WGM ? (nM - fm) : WGM;
        u.pm = fm + ((wgid % nig) % gsz); u.pn = (wgid % nig) / gsz; return true;
    }
};
typedef f32x4 Acc[2][2][4][2];

template <bool F8> struct Frag;
template <> struct Frag<false> { bf16x8 k[2]; };
template <> struct Frag<true>  { i32x8 v; };
__device__ __forceinline__ void frag_ld(Frag<false>& d, const PG8_LAS unsigned char* p) { d.k[0] = *(const PG8_LAS bf16x8*)p; d.k[1] = *(const PG8_LAS bf16x8*)(p + 1024); }
__device__ __forceinline__ void frag_ld(Frag<true>& d, const PG8_LAS unsigned char* p) { d.v.lo = *(const PG8_LAS i32x4*)p; d.v.hi = *(const PG8_LAS i32x4*)(p + 1024); }
template <bool ASM> __device__ __forceinline__ void frag_mma(f32x4& c, const Frag<false>& b, const Frag<false>& a) {
    if constexpr (ASM) { asm volatile("v_mfma_f32_16x16x32_bf16 %0, %1, %2, %0" : "+v"(c) : "v"(b.k[0]), "v"(a.k[0])); asm volatile("v_mfma_f32_16x16x32_bf16 %0, %1, %2, %0" : "+v"(c) : "v"(b.k[1]), "v"(a.k[1])); }
    else { c = __builtin_amdgcn_mfma_f32_16x16x32_bf16(b.k[0], a.k[0], c, 0, 0, 0); c = __builtin_amdgcn_mfma_f32_16x16x32_bf16(b.k[1], a.k[1], c, 0, 0, 0); }
}
template <bool ASM> __device__ __forceinline__ void frag_mma(f32x4& c, const Frag<true>& b, const Frag<true>& a) { asm volatile("v_mfma_f32_16x16x128_f8f6f4 %0, %1, %2, %0" : "+v"(c) : "v"(b.v), "v"(a.v)); }
struct NoMid { static constexpr bool ACTIVE = false; __device__ __forceinline__ void operator()(Acc&, const Unit&, int, int, int, int) const {} };
struct OneUnit { int pm, pn; __device__ __forceinline__ bool next(int i, Unit& u) const { if (i != 0) return false; u.pm = pm; u.pn = pn; return true; } };
template <class Epi, class Mid = NoMid, int EREP = 1, class Sched = StaticOrder, int MODE = 0>
__device__ __forceinline__ void gemm_phase(PG8_LAS unsigned char* lds, const Gemm g, const Sched& S, const Epi& E, const Mid& H = Mid()) {
    int tid_ = threadIdx.x; asm volatile("" : "+v"(tid_));
    const int tid = tid_, wid = __builtin_amdgcn_readfirstlane(tid >> 6), lane = tid & 63, wr = wid >> 2, wc = wid & 3, fr = lane & 15, fq = lane >> 4;
    constexpr bool FP8 = MODE != 0;
    const int K = g.K, nt = K / BK, T8 = MODE == 2 ? g.T8 : 0, th = MODE == 2 ? T8 : (nt >> 1);
    unsigned voffA[2], voffB[2];
#pragma unroll
    for (int i = 0; i < 2; ++i) { int R, C; stage_rc(tid * 16 + i * 8192, R, C); const int Rb = Epi::PERM ? ((R & ~31) + perm32(R & 31)) : R; voffA[i] = (unsigned)(R * g.lda + C) * 2u; voffB[i] = (unsigned)(Rb * g.ldb + C) * 2u; }
    const size_t kstep = (size_t)(BK * 2);
    const size_t hstepA = (size_t)HALF * g.lda * 2, hstepB = (size_t)HALF * g.ldb * 2;
    const size_t tstepA = 2 * hstepA, tstepB = 2 * hstepB;
    const unsigned ldsw = (unsigned)wid * 1024u;
    const int aoff = lds_byte(wr * 64 + fr, fq * 8), boff = lds_byte(wc * 32 + fr, fq * 8);
#define PG8_SA(b, h) (((b) * 2 + (h)) * HTB)
#define PG8_SB(b, h) ((4 + (b) * 2 + (h)) * HTB)
#define PG8_STAGE(bufoff, gbase, voff) do { _Pragma("unroll") for (int _i = 0; _i < 2; ++_i) \
        __builtin_amdgcn_global_load_lds((const unsigned*)((const char*)(gbase) + (voff)[_i]), (PG8_LAS unsigned*)(lds + (bufoff) + ldsw + _i * 8192), 16, 0, 0); } while (0)
#define PG8_LDF(dst, i, base) frag_ld(dst[i], lds + (base) + (i) * 2048)
#define PG8_LDA(dst, b, h) do { _Pragma("unroll") for (int m = 0; m < 4; ++m) PG8_LDF(dst, m, PG8_SA(b, h) + aoff); } while (0)
#define PG8_LDB(dst, b, h) do { _Pragma("unroll") for (int n = 0; n < 2; ++n) PG8_LDF(dst, n, PG8_SB(b, h) + boff); } while (0)
#define PG8_MMA(ai, bj, At, Bt) do { __builtin_amdgcn_s_setprio(1); _Pragma("unroll") for (int m = 0; m < 4; ++m) _Pragma("unroll") for (int n = 0; n < 2; ++n) frag_mma<MODE == 2>(acc[ai][bj][m][n], Bt[n], At[m]); \
        __builtin_amdgcn_s_setprio(0); } while (0)
#define PG8_WAIT_V(n) asm volatile("s_waitcnt vmcnt(" #n ")" ::: "memory")
#define PG8_WAIT_L(n) asm volatile("s_waitcnt lgkmcnt(" #n ")" ::: "memory")
#define PG8_BAR __builtin_amdgcn_s_barrier()
#define PG8_SCHED __builtin_amdgcn_sched_barrier(0)
    Unit cur, nxt; int ui = 0;
    if (!S.next(0, cur)) return;
    Acc acc;
#pragma unroll
    for (int a = 0; a < 2; ++a)
#pragma unroll
        for (int b = 0; b < 2; ++b)
#pragma unroll
            for (int m = 0; m < 4; ++m)
#pragma unroll
                for (int n = 0; n < 2; ++n) acc[a][b][m][n] = (f32x4){0.f, 0.f, 0.f, 0.f};
    Frag<false> Ab[4], Bb0[2], Bb1[2]; Frag<true> Af[4], Bf0[2], Bf1[2];
    const char* cA = (const char*)g.A + (size_t)cur.pm * tstepA; const char* cB = (const char*)g.Bt + (size_t)cur.pn * tstepB;
    PG8_STAGE(PG8_SB(0, 0), cB, voffB); PG8_STAGE(PG8_SB(0, 1), cB + hstepB, voffB); PG8_STAGE(PG8_SA(0, 0), cA, voffA); PG8_STAGE(PG8_SA(0, 1), cA + hstepA, voffA);
    if (wr == 1) PG8_BAR;
    PG8_WAIT_V(2); PG8_BAR;
    PG8_STAGE(PG8_SB(1, 0), cB + kstep, voffB); PG8_STAGE(PG8_SA(1, 0), cA + kstep, voffA); PG8_STAGE(PG8_SB(1, 1), cB + hstepB + kstep, voffB);
    PG8_WAIT_V(6); PG8_BAR;
    for (;;) {
        const bool has_next = S.next(ui + 1, nxt);
        const char* nA = has_next ? (const char*)g.A + (size_t)nxt.pm * tstepA : cA; const char* nB = has_next ? (const char*)g.Bt + (size_t)nxt.pn * tstepB : cB;
#define PG8_KOFF(t) ((size_t)(t) * kstep + ((MODE == 2 && (t) >= T8) ? (size_t)T8 * kstep : (size_t)0))
#define PG8_TRIP(At, B0, B1) do { \
            const bool last = (t == nt - 2); \
            const char* a1 = cA + PG8_KOFF(t + 1); \
            const char* a2 = last ? nA : cA + PG8_KOFF(t + 2); const char* b2 = last ? nB : cB + PG8_KOFF(t + 2); \
            const char* a3 = a2 + kstep; const char* b3 = b2 + kstep; \
            if constexpr (Mid::ACTIVE) { if (t == th) { if constexpr (MODE == 2) asm volatile("s_nop 15\n\ts_nop 15" ::: "memory"); H(acc, cur, wr, wc, fr, fq); } } \
            PG8_LDB(B0, 0, 0); PG8_LDB(B1, 0, 1); PG8_SCHED; PG8_LDA(At, 0, 0); PG8_STAGE(PG8_SA(1, 1), a1 + hstepA, voffA); \
            PG8_WAIT_V(8); PG8_WAIT_L(0); PG8_BAR; PG8_MMA(0, 0, At, B0); PG8_MMA(0, 1, At, B1); PG8_BAR; PG8_SCHED; \
            PG8_LDA(At, 0, 1); PG8_STAGE(PG8_SB(0, 0), b2, voffB); PG8_STAGE(PG8_SB(0, 1), b2 + hstepB, voffB); PG8_STAGE(PG8_SA(0, 0), a2, voffA); \
            PG8_WAIT_V(8); PG8_WAIT_L(0); PG8_BAR; PG8_MMA(1, 0, At, B0); PG8_MMA(1, 1, At, B1); PG8_BAR; PG8_SCHED; \
            PG8_LDB(B0, 1, 0); PG8_LDB(B1, 1, 1); PG8_SCHED; PG8_LDA(At, 1, 0); PG8_STAGE(PG8_SA(0, 1), a2 + hstepA, voffA); \
            PG8_WAIT_V(8); PG8_WAIT_L(0); PG8_BAR; PG8_MMA(0, 0, At, B0); PG8_MMA(0, 1, At, B1); PG8_BAR; PG8_SCHED; \
            PG8_LDA(At, 1, 1); PG8_STAGE(PG8_SB(1, 0), b3, voffB); PG8_STAGE(PG8_SB(1, 1), b3 + hstepB, voffB); PG8_STAGE(PG8_SA(1, 0), a3, voffA); \
            PG8_WAIT_V(8); PG8_WAIT_L(0); PG8_BAR; PG8_MMA(1, 0, At, B0); PG8_MMA(1, 1, At, B1); PG8_BAR; PG8_SCHED; \
        } while (0)
        if constexpr (MODE == 2) {
            for (int t = 0; t < T8; t += 2) PG8_TRIP(Af, Bf0, Bf1);
            for (int t = T8; t < nt; t += 2) PG8_TRIP(Ab, Bb0, Bb1);
        } else if constexpr (MODE == 1) {
            for (int t = 0; t < nt; t += 2) PG8_TRIP(Af, Bf0, Bf1);
        } else {
            for (int t = 0; t < nt; t += 2) PG8_TRIP(Ab, Bb0, Bb1);
        }
        if constexpr (FP8) asm volatile("s_nop 15\n\ts_nop 15" ::: "memory");
        if (wr == 0) PG8_BAR;
        E(acc, cur, wr, wc, fr, fq, lds + STAGE_BYTES);
        if constexpr (EREP == 2) { asm volatile("" ::: "memory"); E(acc, cur, wr, wc, fr, fq, lds + STAGE_BYTES); }
        if (!has_next) break;
#pragma unroll
        for (int a = 0; a < 2; ++a)
#pragma unroll
            for (int b = 0; b < 2; ++b)
#pragma unroll
                for (int m = 0; m < 4; ++m)
#pragma unroll
                    for (int n = 0; n < 2; ++n) acc[a][b][m][n] = (f32x4){0.f, 0.f, 0.f, 0.f};
        cur = nxt; cA = nA; cB = nB; ++ui;
        if (wr == 1) PG8_BAR;
    }
    PG8_WAIT_V(0);
    PG8_BAR;
#undef PG8_SA
#undef PG8_SB
#undef PG8_STAGE
#undef PG8_LDA
#undef PG8_LDB
#undef PG8_MMA
#undef PG8_LDF
#undef PG8_TRIP
#undef PG8_KOFF
#undef PG8_WAIT_V
#undef PG8_WAIT_L
#undef PG8_BAR
#undef PG8_SCHED
}
}

struct Ptrs {
    const float *x, *norm1_g, *w_in, *q_norm_g, *k_norm_g, *idx_k_norm_g, *sgu_norm_g, *w_spatial, *b_spatial, *w_proj_a, *w_proj_b, *w_out, *norm2_g, *w_gate, *w_up, *w_down, *rel_bias;
    float* out; unsigned char* ws;
};

__device__ __forceinline__ unsigned pk4_fp8(float a, float b, float c, float d) { int w = __builtin_amdgcn_cvt_pk_fp8_f32(a, b, 0, false); w = __builtin_amdgcn_cvt_pk_fp8_f32(c, d, w, true); return (unsigned)w; }
__device__ __forceinline__ f32x4 ld_bf16x4(const bf16* p) { const u32x2 w = *(const u32x2*)p; f32x4 r; r[0] = bf2f(w.x & 0xffffu); r[1] = bf2f(w.x >> 16); r[2] = bf2f(w.y & 0xffffu); r[3] = bf2f(w.y >> 16); return r; }
__device__ __forceinline__ void store_bf16x4(bf16* p, f32x4 v) { u32x2 w; w.x = pk2(v[0], v[1]); w.y = pk2(v[2], v[3]); *(u32x2*)p = w; }

__device__ __forceinline__ void store_bf16x8(void* p, f32x4 a, f32x4 b) { u32x4 w; w.x = pk2(a[0], a[1]); w.y = pk2(a[2], a[3]); w.z = pk2(b[0], b[1]); w.w = pk2(b[2], b[3]); *(u32x4*)p = w; }
template <int ACT> __device__ __forceinline__ f32x4 act4(f32x4 v) {
    if (ACT == 1) { v[0] = gelu_tanh(v[0]); v[1] = gelu_tanh(v[1]); v[2] = gelu_tanh(v[2]); v[3] = gelu_tanh(v[3]); }
    if (ACT == 2) { v[0] = sigmoidf_(v[0]); v[1] = sigmoidf_(v[1]); v[2] = sigmoidf_(v[2]); v[3] = sigmoidf_(v[3]); }
    return v;
}
template <int ACT> __device__ __forceinline__ void epi_rowmajor(pg8::Acc& acc, char* dt, int rowb, unsigned lo) {
#pragma unroll
    for (int ai = 0; ai < 2; ++ai)
#pragma unroll
        for (int m = 0; m < 4; ++m) { char* dr = dt + (size_t)(ai * 128 + m * 16) * rowb;
#pragma unroll
            for (int bj = 0; bj < 2; ++bj) store_bf16x8(dr + lo + bj * 256, act4<ACT>(acc[ai][bj][m][0]), act4<ACT>(acc[ai][bj][m][1])); }
}
#ifndef FP8_QK
#define FP8_QK 1
#endif
constexpr int P1_NB16 = FP8_QK ? 2048 : 4096, P1_NF8 = FP8_QK ? 8192 : 6144;
constexpr int FFN_T8 = 12, FFN_KF = 128 * FFN_T8;
constexpr float OA_SCALE = 4.0f;
constexpr float GATE_WSCALE = 32.0f;
template <bool F8>
struct EpiIn {
    static constexpr bool PERM = true;
    unsigned char* ws; const float *gq, *gk;
    __device__ __forceinline__ void operator()(pg8::Acc& acc, const pg8::Unit& u, int wr, int wc, int fr, int fq, LAS unsigned char* scr) const {
        constexpr float SC = F8 ? 1.0f / GATE_WSCALE : 1.0f;
        const int rt0 = wr * 64 + fr; const int row0 = u.pm * 256 + rt0;
        if constexpr (F8) if (u.pn < 16) {
            unsigned char* ga_ = ws + WS_GA + (size_t)u.pm * 256 * 2048 + u.pn * 128; unsigned char* gb_ = ws + WS_GB + (size_t)u.pm * 256 * 2048 + u.pn * 128;
            unsigned lo = (unsigned)(rt0 * 2048 + wc * 32 + 8 * fq); asm volatile("" : "+v"(lo));
            constexpr float NS = -LOG2E * SC;
#pragma unroll
            for (int ai = 0; ai < 2; ++ai)
#pragma unroll
                for (int m = 0; m < 4; ++m) {
                    u32x2 wa, wb; wa.x = wa.y = wb.x = wb.y = 0u;
#pragma unroll
                    for (int n = 0; n < 2; ++n)
#pragma unroll
                        for (int e = 0; e < 4; ++e) {
                            const float ea = __builtin_amdgcn_exp2f(acc[ai][0][m][n][e] * NS), eb = __builtin_amdgcn_exp2f(acc[ai][1][m][n][e] * NS);
                            const float sa = 255.0f * __builtin_amdgcn_rcpf(1.0f + ea), sb = fmaxf(255.0f * __builtin_amdgcn_rcpf(1.0f + eb), 1.0f);
                            if (n == 0) { wa.x = __builtin_amdgcn_cvt_pk_u8_f32(sa, e, wa.x); wb.x = __builtin_amdgcn_cvt_pk_u8_f32(sb, e, wb.x); }
                            else        { wa.y = __builtin_amdgcn_cvt_pk_u8_f32(sa, e, wa.y); wb.y = __builtin_amdgcn_cvt_pk_u8_f32(sb, e, wb.y); }
                        }
                    *(u32x2*)(ga_ + (size_t)(ai * 128 + m * 16) * 2048 + lo) = wa; *(u32x2*)(gb_ + (size_t)(ai * 128 + m * 16) * 2048 + lo) = wb;
                }
            return;
        }
        const int pn = F8 ? (u.pn < 20 ? u.pn - 8 : (u.pn < 24 ? u.pn : u.pn - 24)) : (FP8_QK ? u.pn + 12 : (u.pn < 8 ? u.pn : u.pn + 4));
        LAS float* P = (LAS float*)scr;
        if (pn < 8) {
            const bool isq = pn < 4; const float* g = isq ? gq : gk;
            const float osc = (isq ? (0.08838834764831845f * LOG2E) : 1.0f) * SC;
#pragma unroll
            for (int ai = 0; ai < 2; ++ai)
#pragma unroll
                for (int m = 0; m < 4; ++m)
#pragma unroll
                    for (int bj = 0; bj < 2; ++bj) {
                        float s = 0.f;
#pragma unroll
                        for (int n = 0; n < 2; ++n) { const f32x4 v = acc[ai][bj][m][n]; s += (v[0] * v[0] + v[1] * v[1]) + (v[2] * v[2] + v[3] * v[3]); }
                        s += __shfl_xor(s, 16); s += __shfl_xor(s, 32);
                        if (fq == 0) P[(ai * 128 + rt0 + m * 16) * 8 + bj * 4 + wc] = s;
                    }
            LDS_BARRIER();
            f32x4 gv[2];
#pragma unroll
            for (int n = 0; n < 2; ++n) gv[n] = *(const f32x4*)(g + wc * 32 + 8 * fq + 4 * n) * osc;
            char* dt = (char*)ws + (isq ? WS_Q : WS_K) + ((size_t)u.pm * 256 * 1024 + (pn & 3) * 256) * 2;
            unsigned lo = (unsigned)(rt0 * 1024 + wc * 32 + 8 * fq) * 2u; asm volatile("" : "+v"(lo));
#pragma unroll
            for (int ai = 0; ai < 2; ++ai)
#pragma unroll
                for (int m = 0; m < 4; ++m) { char* dr = dt + (size_t)(ai * 128 + m * 16) * 2048;
#pragma unroll
                    for (int bj = 0; bj < 2; ++bj) {
                        const f32x4 pp = *(const LAS f32x4*)(P + (ai * 128 + rt0 + m * 16) * 8 + bj * 4);
                        const float rs = __builtin_amdgcn_rsqf(((pp[0] + pp[1]) + (pp[2] + pp[3])) * (SC * SC / 128.0f) + EPS);
                        store_bf16x8(dr + lo + bj * 256, acc[ai][bj][m][0] * rs * gv[0], acc[ai][bj][m][1] * rs * gv[1]);
                    } }
        } else if (pn < 12 || (pn >= 20 && pn < 24)) {
            const bool isv = pn < 12; bf16* dst = (bf16*)(ws + (isv ? WS_VT : WS_VBT)); const int chbase = ((isv ? pn - 8 : pn - 20)) * 256; float* rowsq_vb = (float*)(ws + WS_CTL + CTL_ROWSQ_VB);
            const int frp = isv ? (8 * ((fr >> 2) & 1) + 4 * (fr >> 3) + (fr & 3)) : fr;
            const int b = u.pm >> 3, s0 = (u.pm & 7) * 256 + wr * 64 + frp;
#pragma unroll
            for (int ai = 0; ai < 2; ++ai)
#pragma unroll
                for (int m = 0; m < 4; ++m) {
                    float ss = 0.f;
#pragma unroll
                    for (int bj = 0; bj < 2; ++bj)
#pragma unroll
                        for (int n = 0; n < 2; ++n) {
                            f32x4 v = acc[ai][bj][m][n];
                            if constexpr (F8) v = v * SC;
                            if (!isv) { v = act4<1>(v); ss += (v[0] * v[0] + v[1] * v[1]) + (v[2] * v[2] + v[3] * v[3]); }
                            const int ch = chbase + bj * 128 + wc * 32 + 8 * fq + 4 * n;
                            bf16* p = dst + ((size_t)(b * 1024 + ch)) * 2048 + s0 + ai * 128 + m * 16;
                            const unsigned w01 = pk2(v[0], v[1]), w23 = pk2(v[2], v[3]);
                            p[0] = (bf16)(w01 & 0xffffu); p[2048] = (bf16)(w01 >> 16); p[4096] = (bf16)(w23 & 0xffffu); p[6144] = (bf16)(w23 >> 16);
                        }
                    if (!isv) { ss += __shfl_xor(ss, 16); ss += __shfl_xor(ss, 32); if (fq == 0) unsafeAtomicAdd(rowsq_vb + row0 + ai * 128 + m * 16, ss); }
                }
        } else if constexpr (!F8) {
            const size_t doff = pn < 16 ? WS_QI : WS_U; const int colbase = (pn & 3) * 256;
            char* dt = (char*)ws + doff + ((size_t)u.pm * 256 * 1024 + colbase) * 2;
            unsigned lo = (unsigned)(rt0 * 1024 + wc * 32 + 8 * fq) * 2u; asm volatile("" : "+v"(lo));
            if (pn < 16) epi_rowmajor<0>(acc, dt, 2048, lo); else epi_rowmajor<1>(acc, dt, 2048, lo);
        }
    }
};

__device__ __forceinline__ void ld_bf16x8(const void* p, f32x4& a, f32x4& b) { const u32x4 w = *(const u32x4*)p; a[0] = bf2f(w.x & 0xffffu); a[1] = bf2f(w.x >> 16); a[2] = bf2f(w.y & 0xffffu); a[3] = bf2f(w.y >> 16); b[0] = bf2f(w.z & 0xffffu); b[1] = bf2f(w.z >> 16); b[2] = bf2f(w.w & 0xffffu); b[3] = bf2f(w.w >> 16); }
struct MidScale {
    static constexpr bool ACTIVE = true; float sc;
    __device__ __forceinline__ void operator()(pg8::Acc& acc, const pg8::Unit&, int, int, int, int) const {
#pragma unroll
        for (int ai = 0; ai < 2; ++ai)
#pragma unroll
            for (int bj = 0; bj < 2; ++bj)
#pragma unroll
                for (int m = 0; m < 4; ++m)
#pragma unroll
                    for (int n = 0; n < 2; ++n) acc[ai][bj][m][n] *= sc;
    }
};
__device__ __forceinline__ void ld_u8x8(const void* p, f32x4& a, f32x4& b) { const u32x2 w = *(const u32x2*)p;
    a[0] = (float)(w.x & 0xffu); a[1] = (float)((w.x >> 8) & 0xffu); a[2] = (float)((w.x >> 16) & 0xffu); a[3] = (float)(w.x >> 24);
    b[0] = (float)(w.y & 0xffu); b[1] = (float)((w.y >> 8) & 0xffu); b[2] = (float)((w.y >> 16) & 0xffu); b[3] = (float)(w.y >> 24); }
struct MidMerge {
    static constexpr bool ACTIVE = true;
    const unsigned char *GA, *GB; float sc;
    __device__ __forceinline__ void operator()(pg8::Acc& acc, const pg8::Unit& u, int wr, int wc, int fr, int fq) const {
        unsigned lane_off = (unsigned)((wr * 64 + fr) * 2048 + wc * 32 + fq * 8); asm volatile("" : "+v"(lane_off));
        const size_t tile = (size_t)u.pm * 256 * 2048 + (size_t)u.pn * 256;
        const unsigned char* ga_t = GA + tile; const unsigned char* gb_t = GB + tile;
#pragma unroll
        for (int ai = 0; ai < 2; ++ai)
#pragma unroll
            for (int m = 0; m < 4; ++m) {
                const unsigned char* ga_r = ga_t + (size_t)(ai * 128 + m * 16) * 2048; const unsigned char* gb_r = gb_t + (size_t)(ai * 128 + m * 16) * 2048;
#pragma unroll
                for (int bj = 0; bj < 2; ++bj) {
                    f32x4 a0, a1, b0, b1; ld_u8x8(ga_r + lane_off + bj * 128, a0, a1); ld_u8x8(gb_r + lane_off + bj * 128, b0, b1);
#pragma unroll
                    for (int e = 0; e < 4; ++e) { acc[ai][bj][m][0][e] *= a0[e] * __builtin_amdgcn_rcpf(b0[e]) * sc; acc[ai][bj][m][1][e] *= a1[e] * __builtin_amdgcn_rcpf(b1[e]) * sc; }
                }
                asm volatile("" ::: "memory");
            }
    }
};
struct EpiMerge {
    static constexpr bool PERM = true;
    const unsigned char* GB; bf16* MERGED;
    __device__ __forceinline__ void operator()(pg8::Acc& acc, const pg8::Unit& u, int wr, int wc, int fr, int fq, LAS unsigned char*) const {
        unsigned lane_off = (unsigned)((wr * 64 + fr) * 2048 + wc * 32 + fq * 8) * 2u; asm volatile("" : "+v"(lane_off));
        const size_t tile = ((size_t)u.pm * 256 * 2048 + (size_t)u.pn * 256) * 2;
        const unsigned char* gb_t = GB + (tile >> 1); char* mt = (char*)MERGED + tile;
#pragma unroll
        for (int ai = 0; ai < 2; ++ai)
#pragma unroll
            for (int m = 0; m < 4; ++m) {
                const unsigned char* gb_r = gb_t + (size_t)(ai * 128 + m * 16) * 2048; char* mr = mt + (size_t)(ai * 128 + m * 16) * 4096;
#pragma unroll
                for (int bj = 0; bj < 2; ++bj) { f32x4 gb0, gb1; ld_u8x8(gb_r + (lane_off >> 1) + bj * 128, gb0, gb1); store_bf16x8(mr + lane_off + bj * 256, acc[ai][bj][m][0] * (gb0 * (1.0f / 255.0f)), acc[ai][bj][m][1] * (gb1 * (1.0f / 255.0f))); }
            }
    }
};
struct EpiOut {
    static constexpr bool PERM = false;
    const float* X; bf16* X1B; float* rowsq2;
    __device__ __forceinline__ void operator()(pg8::Acc& acc, const pg8::Unit& u, int wr, int wc, int fr, int fq, LAS unsigned char*) const {
        const int row0 = u.pm * 256 + wr * 64 + fr;
        unsigned lo = (unsigned)((wr * 64 + fr) * 2048 + wc * 32 + fq * 4) * 4u; asm volatile("" : "+v"(lo));
        const size_t tile = ((size_t)u.pm * 256 * 2048 + (size_t)u.pn * 256) * 4;
        const char* xt = (const char*)X + tile; char* bt = (char*)X1B + tile / 2;
#pragma unroll
        for (int ai = 0; ai < 2; ++ai)
#pragma unroll
            for (int m = 0; m < 4; ++m) {
                const size_t ro = (size_t)(ai * 128 + m * 16) * 8192;
                float ss = 0.f;
#pragma unroll
                for (int bj = 0; bj < 2; ++bj)
#pragma unroll
                    for (int n = 0; n < 2; ++n) {
                        const f32x4 v = __builtin_nontemporal_load((const f32x4*)(xt + ro + lo + bj * 512 + n * 64)) + acc[ai][bj][m][n];
                        ss += (v[0] * v[0] + v[1] * v[1]) + (v[2] * v[2] + v[3] * v[3]);
                        store_bf16x4((bf16*)(bt + ro / 2 + (lo >> 1) + bj * 256 + n * 32), v);
                    }
                ss += __shfl_xor(ss, 16); ss += __shfl_xor(ss, 32);
                if (fq == 0) unsafeAtomicAdd(rowsq2 + row0 + ai * 128 + m * 16, ss);
            }
    }
};
__device__ __forceinline__ void ffn_up_store(pg8::Acc& acc, const float* rowsq2, bf16* ACT, int pm, int pnc, int wr, int wc, int fr, int fq) {
    const int row0 = pm * 256 + wr * 64 + fr;
    unsigned lane_off = (unsigned)((wr * 64 + fr) * DFF + wc * 32 + fq * 8) * 2u; asm volatile("" : "+v"(lane_off));
    const bool f8 = pnc < FFN_T8;
    char* at = (char*)ACT + (size_t)pm * 256 * DFF * 2 + (size_t)pnc * 128 * (f8 ? 1 : 2);
    if (f8) { lane_off = (unsigned)((wr * 64 + fr) * DFF * 2 + wc * 32 + fq * 8); asm volatile("" : "+v"(lane_off)); }
#pragma unroll
    for (int ai = 0; ai < 2; ++ai)
#pragma unroll
        for (int m = 0; m < 4; ++m) {
            const int row = row0 + ai * 128 + m * 16;
            const float rs = __builtin_amdgcn_rsqf(rowsq2[row] * (1.0f / (2048.0f * NREP(5))) + EPS);
            f32x4 o[2];
#pragma unroll
            for (int n = 0; n < 2; ++n) {
                const f32x4 gt = acc[ai][0][m][n] * rs, up = acc[ai][1][m][n] * rs;
#pragma unroll
                for (int e = 0; e < 4; ++e) o[n][e] = gt[e] * sigmoidf_(gt[e]) * up[e];
            }
            if (f8) { u32x2 w; w.x = pk4_fp8(o[0][0], o[0][1], o[0][2], o[0][3]); w.y = pk4_fp8(o[1][0], o[1][1], o[1][2], o[1][3]); *(u32x2*)(at + (size_t)(ai * 128 + m * 16) * (DFF * 2) + lane_off) = w; }
            else store_bf16x8(at + (size_t)(ai * 128 + m * 16) * (DFF * 2) + lane_off, o[0], o[1]);
        }
}
struct EpiFfnUp {
    static constexpr bool PERM = true;
    const float* rowsq2; bf16* ACT; int pn_off;
    __device__ __forceinline__ void operator()(pg8::Acc& acc, const pg8::Unit& u, int wr, int wc, int fr, int fq, LAS unsigned char*) const { ffn_up_store(acc, rowsq2, ACT, u.pm, u.pn + pn_off, wr, wc, fr, fq); }
};
struct EpiFfnUpPair {
    static constexpr bool PERM = true;
    const float* rowsq2; bf16* ACT; int pn_off; int half; float* slab; unsigned* flag;
    __device__ __forceinline__ void operator()(pg8::Acc& acc, const pg8::Unit& u, int wr, int wc, int fr, int fq, LAS unsigned char*) const {
        const int tid = threadIdx.x;
        unsigned so = (unsigned)tid * 16u; asm volatile("" : "+v"(so));
        char* sb = (char*)slab;
        if (half) {
#pragma unroll
            for (int ai = 0; ai < 2; ++ai)
#pragma unroll
                for (int bj = 0; bj < 2; ++bj)
#pragma unroll
                    for (int m = 0; m < 4; ++m)
#pragma unroll
                        for (int n = 0; n < 2; ++n) *(f32x4*)(sb + (size_t)((((ai * 2 + bj) * 4 + m) * 2 + n) * 8192) + so) = acc[ai][bj][m][n];
            asm volatile("s_waitcnt vmcnt(0)" ::: "memory");
            __builtin_amdgcn_s_barrier(); asm volatile("" ::: "memory");
            if (tid == 0) { __builtin_amdgcn_fence(__ATOMIC_RELEASE, "agent"); asm volatile("s_waitcnt vmcnt(0)" ::: "memory"); __hip_atomic_store(flag, 1u, __ATOMIC_RELAXED, __HIP_MEMORY_SCOPE_AGENT); }
        } else {
            if (tid < 64) {
                unsigned spins = 0;
                while ((unsigned)__builtin_amdgcn_readfirstlane(__hip_atomic_load(flag, __ATOMIC_RELAXED, __HIP_MEMORY_SCOPE_AGENT)) == 0u) { __builtin_amdgcn_s_sleep(2); if (++spins > (1u << 24)) break; }
                __builtin_amdgcn_fence(__ATOMIC_ACQUIRE, "agent");
                asm volatile("s_waitcnt vmcnt(0)" ::: "memory");
            }
            asm volatile("" ::: "memory"); __builtin_amdgcn_s_barrier(); asm volatile("" ::: "memory");
#pragma unroll
            for (int ai = 0; ai < 2; ++ai)
#pragma unroll
                for (int bj = 0; bj < 2; ++bj)
#pragma unroll
                    for (int m = 0; m < 4; ++m) {
#pragma unroll
                        for (int n = 0; n < 2; ++n) acc[ai][bj][m][n] += *(const f32x4*)(sb + (size_t)((((ai * 2 + bj) * 4 + m) * 2 + n) * 8192) + so);
                        asm volatile("" ::: "memory");
                    }
            ffn_up_store(acc, rowsq2, ACT, u.pm, u.pn + pn_off, wr, wc, fr, fq);
        }
    }
};
struct EpiFfnDown {
    static constexpr bool PERM = false;
    const bf16* X1B; float* OUT;
    __device__ __forceinline__ void operator()(pg8::Acc& acc, const pg8::Unit& u, int wr, int wc, int fr, int fq, LAS unsigned char*) const {
        unsigned lo = (unsigned)((wr * 64 + fr) * 2048 + wc * 32 + fq * 4) * 4u; asm volatile("" : "+v"(lo));
        const size_t tile = ((size_t)u.pm * 256 * 2048 + (size_t)u.pn * 256) * 4;
        const char* st = (const char*)X1B + tile / 2; char* ot = (char*)OUT + tile;
#pragma unroll
        for (int ai = 0; ai < 2; ++ai)
#pragma unroll
            for (int m = 0; m < 4; ++m) {
                const size_t ro = (size_t)(ai * 128 + m * 16) * 8192;
#pragma unroll
                for (int bj = 0; bj < 2; ++bj)
#pragma unroll
                    for (int n = 0; n < 2; ++n) __builtin_nontemporal_store(ld_bf16x4((const bf16*)(st + ro / 2 + (lo >> 1) + bj * 256 + n * 32)) + acc[ai][bj][m][n], (f32x4*)(ot + ro + lo + bj * 512 + n * 64));
            }
    }
};

__device__ __forceinline__ void kiwi_issue(const bf16* H1r, const bf16* Wr, int kc, LAS unsigned char* buf, int wave, int lane) {
    const int sub = lane >> 4, pos = lane & 15;
#pragma unroll
    for (int j = 0; j < 4; ++j) {
        const int rowi = 4 * (wave + 8 * j) + sub;
        const bf16* base = (j == 0) ? H1r + (size_t)rowi * 2048 : Wr + (size_t)(rowi - 32) * 2048;
        __builtin_amdgcn_global_load_lds((const unsigned*)(base + kc * 128 + ((pos ^ (rowi & 15)) * 8)), (LAS unsigned*)(buf + (wave + 8 * j) * 1024), 16, 0, 0);
    }
}
__device__ __forceinline__ void kiwi_unit(int rb, const bf16* H1, const bf16* WIN, const float* gki, bf16* KI, float* WI, LAS unsigned char* lds, int wave, int lane) {
    const int r = lane & 31, hs = lane >> 5;
    const bf16* H1r = H1 + (size_t)(rb * 32) * 2048; const bf16* Wr = WIN + (size_t)10240 * 2048;
    f32x16 acc[3];
#pragma unroll
    for (int cb = 0; cb < 3; ++cb)
#pragma unroll
        for (int i = 0; i < 16; ++i) acc[cb][i] = 0.f;
    kiwi_issue(H1r, Wr, 0, lds, wave, lane); kiwi_issue(H1r, Wr, 1, lds + 32768, wave, lane); kiwi_issue(H1r, Wr, 2, lds + 65536, wave, lane);
    asm volatile("s_waitcnt vmcnt(8)" ::: "memory"); LDS_BARRIER();
    const unsigned fbase = (unsigned)(r * 256 + (((2 * wave + hs) ^ (r & 15)) << 4));
#pragma unroll 1
    for (int kc = 0; kc < 16; ++kc) {
        LAS unsigned char* cur = lds + (kc & 3) * 32768;
        if (kc + 3 < 16) kiwi_issue(H1r, Wr, kc + 3, lds + ((kc + 3) & 3) * 32768, wave, lane);
        const bf16x8 a = *(const LAS bf16x8*)(cur + fbase);
#pragma unroll
        for (int cb = 0; cb < 3; ++cb) { const bf16x8 bfr = *(const LAS bf16x8*)(cur + (32 + 32 * cb) * 256 + fbase); acc[cb] = __builtin_amdgcn_mfma_f32_32x32x16_bf16(a, bfr, acc[cb], 0, 0, 0); }
        if (kc + 3 < 16) asm volatile("s_waitcnt vmcnt(8)" ::: "memory"); else if (kc + 2 < 16) asm volatile("s_waitcnt vmcnt(4)" ::: "memory"); else asm volatile("s_waitcnt vmcnt(0)" ::: "memory");
        LDS_BARRIER();
    }
    LAS float* part = (LAS float*)lds;
#pragma unroll
    for (int cb = 0; cb < 3; ++cb)
#pragma unroll
        for (int i = 0; i < 16; ++i) part[(wave * 48 + cb * 16 + i) * 64 + lane] = acc[cb][i];
    LDS_BARRIER();
#pragma unroll
    for (int ii = 0; ii < 2; ++ii) {
        const int i = 2 * wave + ii; float v[3];
#pragma unroll
        for (int cb = 0; cb < 3; ++cb) { float s = 0.f;
#pragma unroll
            for (int w = 0; w < 8; ++w) s += part[(w * 48 + cb * 16 + i) * 64 + lane];
            v[cb] = s; }
        float ss = v[0] * v[0] + v[1] * v[1];
        ss += __shfl_xor(ss, 1); ss += __shfl_xor(ss, 2); ss += __shfl_xor(ss, 4); ss += __shfl_xor(ss, 8); ss += __shfl_xor(ss, 16);
        const float rs = 1.0f / sqrtf(ss * (1.0f / 64.0f) + EPS);
        const size_t row = (size_t)(rb * 32 + rowoff16(i) + 4 * hs);
        KI[row * 64 + r] = (bf16)f2bf(v[0] * rs * gki[r]); KI[row * 64 + 32 + r] = (bf16)f2bf(v[1] * rs * gki[32 + r]);
        if (r < 16) WI[row * 16 + r] = v[2];
    }
    LDS_BARRIER();
}

constexpr int W8_FLAG = 0x10000;
__device__ __forceinline__ int rowmap(int mode, int n) {
    if (mode == 1) {
        if (n < 2048) return FP8_QK ? (W8_FLAG | (6144 + n)) : n;
        if (n < 3072) return W8_FLAG | (4096 + (n - 2048));
        if (n < 4096) return (FP8_QK ? 0 : 2048) + (n - 3072);
        if (n < 4160) return 10240 + (n - 4096); if (n < 4176) return 10240 + 64 + (n - 4160);
        if (n < 5200) return (FP8_QK ? 1024 : 3072) + (n - 4176);
        if (n < 6224) return W8_FLAG | (5120 + (n - 5200));
        const int j = n - 6224, gb = j >> 11, c = j & 2047; return W8_FLAG | ((c >> 7) * 256 + gb * 128 + (c & 127)); }
    if (mode == 4) return W8_FLAG | n;
    if (mode == 2) return (n >> 7) * 256 + (n & 127);
    if (mode == 3) return (n >> 7) * 256 + 128 + (n & 127);
    return n;
}
constexpr int P0_PITCH = 68, P0_WAVE_BYTES = 64 * P0_PITCH * 4;
__device__ __forceinline__ void p0_transpose_item(const float* W, int N, bf16* WT, int ldk, int koff, int mode, const float* kscale, LAS float* scr, int item, int lane, unsigned char* W8 = nullptr, int pitch8 = 2048) {
    const int nblk = (N + 63) / 64, kb = item / nblk, nb = item % nblk, k0 = 64 * kb, n0 = 64 * nb;
    const int kr = lane >> 4, nc = lane & 15; const bool ok = (n0 + 4 * nc) < N;
    const float* wp = W + (size_t)(k0 + kr) * N + n0 + 4 * nc;
    f32x4 v[16];
#pragma unroll
    for (int i = 0; i < 16; ++i) v[i] = ok ? __builtin_nontemporal_load((const f32x4*)(wp + (size_t)(4 * i) * N)) : (f32x4){0.f, 0.f, 0.f, 0.f};
#pragma unroll
    for (int i = 0; i < 16; ++i) *(LAS f32x4*)(scr + (4 * i + kr) * P0_PITCH + 4 * nc) = v[i];
    LDS_WAIT(); asm volatile("" ::: "memory");
    const int c = lane & 7, ng = lane >> 3;
    f32x4 ks0 = (f32x4){1.f, 1.f, 1.f, 1.f}, ks1 = ks0;
    if (kscale) { ks0 = *(const f32x4*)(kscale + k0 + 8 * c); ks1 = *(const f32x4*)(kscale + k0 + 8 * c + 4); }
#pragma unroll
    for (int j = 0; j < 2; ++j) {
        const int nn = 4 * (ng + 8 * j);
        f32x4 r[8];
#pragma unroll
        for (int kk = 0; kk < 8; ++kk) r[kk] = *(const LAS f32x4*)(scr + (8 * c + kk) * P0_PITCH + nn) * (kk < 4 ? ks0[kk] : ks1[kk - 4]);
        const int rm = (n0 + nn < N) ? rowmap(mode, n0 + nn) : 0;
        if (((mode == 1 || mode == 4) && (rm & W8_FLAG)) || (mode == 5 && k0 < FFN_KF)) {
            {
                unsigned char* op8 = W8 + (size_t)(rm & (W8_FLAG - 1)) * pitch8 + k0 + 8 * c;
#pragma unroll
                for (int e = 0; e < 4; ++e) { u32x2 o; o.x = pk4_fp8(r[0][e] * GATE_WSCALE, r[1][e] * GATE_WSCALE, r[2][e] * GATE_WSCALE, r[3][e] * GATE_WSCALE); o.y = pk4_fp8(r[4][e] * GATE_WSCALE, r[5][e] * GATE_WSCALE, r[6][e] * GATE_WSCALE, r[7][e] * GATE_WSCALE); __builtin_nontemporal_store(o, (u32x2*)(op8 + (size_t)e * pitch8)); }
            }
        } else if (n0 + nn < N) {
            bf16* op = WT + (size_t)rm * ldk + koff + k0 + 8 * c;
#pragma unroll
            for (int e = 0; e < 4; ++e) { u32x4 o; o.x = pk2(r[0][e], r[1][e]); o.y = pk2(r[2][e], r[3][e]); o.z = pk2(r[4][e], r[5][e]); o.w = pk2(r[6][e], r[7][e]); __builtin_nontemporal_store(o, (u32x4*)(op + (size_t)e * ldk)); }
        }
    }
    LDS_WAIT(); asm volatile("" ::: "memory");
}
__device__ __forceinline__ void p0_prologue(const Ptrs& P, LAS unsigned char* lds, int vcu, int G) {
    const int tid = threadIdx.x, lane = tid & 63, wave = __builtin_amdgcn_readfirstlane(tid >> 6);
    unsigned char* ws = P.ws;
    LAS float* scr = (LAS float*)(lds + wave * P0_WAVE_BYTES);
    const int gw = vcu * 8 + wave, NGW = G * 8;
    bf16* WIN = (bf16*)(ws + WS_WIN); bf16* WAB = (bf16*)(ws + WS_WAB); bf16* WOUT = (bf16*)(ws + WS_WOUT); bf16* W1 = (bf16*)(ws + WS_W1); bf16* W2 = (bf16*)(ws + WS_W2);
    unsigned char* H1F8 = (unsigned char*)P.out + OUT_H1F8; unsigned char* W8 = (unsigned char*)P.out + OUT_W8;
    constexpr int I_IN = 32 * 162, I_A = 16 * 32, I_O = 32 * 32, I_G = 32 * 88, I_D = 88 * 32;
    constexpr int NITEMS = I_IN + 2 * I_A + I_O + 2 * I_G + I_D;
    for (int it = gw; it < NITEMS; it += NGW) {
        int r = it;
        if (r < I_IN) { p0_transpose_item(P.w_in, DIN, WIN, 2048, 0, 1, nullptr, scr, r, lane, W8); continue; } r -= I_IN;
        if (r < I_A) { p0_transpose_item(P.w_proj_a, 2048, WAB, 2048, 0, 4, nullptr, scr, r, lane, (unsigned char*)WAB, 4096); continue; } r -= I_A;
        if (r < I_A) { p0_transpose_item(P.w_proj_b, 2048, WAB, 2048, 1024, 0, nullptr, scr, r, lane); continue; } r -= I_A;
        if (r < I_O) { p0_transpose_item(P.w_out, 2048, WOUT, 2048, 0, 0, nullptr, scr, r, lane); continue; } r -= I_O;
        if (r < I_G) { p0_transpose_item(P.w_gate, DFF, W1, 2048, 0, 2, P.norm2_g, scr, r, lane); continue; } r -= I_G;
        if (r < I_G) { p0_transpose_item(P.w_up, DFF, W1, 2048, 0, 3, P.norm2_g, scr, r, lane); continue; } r -= I_G;
        p0_transpose_item(P.w_down, 2048, W2, DFF, 0, 5, nullptr, scr, r, lane, (unsigned char*)W2, DFF * 2);
    }
    for (int rr = DIN + gw; rr < NIN; rr += NGW) { u32x4* p = (u32x4*)(WIN + (size_t)rr * 2048); for (int j = lane; j < 256; j += 64) p[j] = (u32x4){0u, 0u, 0u, 0u}; }
    bf16* H1 = (bf16*)(ws + WS_H1);
    for (int m = gw; m < MTOK; m += NGW) {
        const f32x4* xr = (const f32x4*)(P.x + (size_t)m * DM) + lane; const f32x4* gr = (const f32x4*)P.norm1_g + lane;
        f32x4 v[8]; float s = 0.f;
#pragma unroll
        for (int j = 0; j < 8; ++j) { v[j] = __builtin_nontemporal_load(xr + 64 * j); s += (v[j][0] * v[j][0] + v[j][1] * v[j][1]) + (v[j][2] * v[j][2] + v[j][3] * v[j][3]); }
        const float rs = 1.0f / sqrtf(wave_sum(s) * (1.0f / DM) + EPS);
        u32x2* o = (u32x2*)(H1 + (size_t)m * DM) + lane; unsigned* o8 = (unsigned*)(H1F8 + (size_t)m * DM) + lane;
#pragma unroll
        for (int j = 0; j < 8; ++j) { const f32x4 gg = gr[64 * j]; const float h0 = v[j][0] * rs * gg[0], h1 = v[j][1] * rs * gg[1], h2 = v[j][2] * rs * gg[2], h3 = v[j][3] * rs * gg[3];
            u32x2 w; w.x = pk2(h0, h1); w.y = pk2(h2, h3); __builtin_nontemporal_store(w, o + 64 * j); __builtin_nontemporal_store(pk4_fp8(h0, h1, h2, h3), o8 + 64 * j); }
    }
    const int gt = vcu * 512 + tid, NGT = G * 512;
    bf16* WSP = (bf16*)(ws + WS_WSP); float* TBL = (float*)(ws + WS_TBL);
    for (int i = gt; i < NG * CHUNK * CHUNK; i += NGT) { const int s = i & 127, t = (i >> 7) & 127; WSP[i] = (bf16)f2bf(s <= t ? P.w_spatial[i] : 0.f); }
    for (int i = gt; i < NH * 132; i += NGT) { const int h = i / 132, d = i % 132; const int bk = d < 128 ? (int)T5_BUCKET[d] : 31; TBL[i] = P.rel_bias[bk * NH + h] * LOG2E; }
}

constexpr int IDX_ROW = 2048, IDX_WAVE_BYTES = 2 * IDX_ROW * 4;
__device__ __forceinline__ float half_min(float v) { v = fminf(v, __shfl_xor(v, 1)); v = fminf(v, __shfl_xor(v, 2)); v = fminf(v, __shfl_xor(v, 4)); v = fminf(v, __shfl_xor(v, 8)); return fminf(v, __shfl_xor(v, 16)); }
__device__ __forceinline__ float half_max(float v) { v = fmaxf(v, __shfl_xor(v, 1)); v = fmaxf(v, __shfl_xor(v, 2)); v = fmaxf(v, __shfl_xor(v, 4)); v = fmaxf(v, __shfl_xor(v, 8)); return fmaxf(v, __shfl_xor(v, 16)); }
__device__ __forceinline__ void indexer_unit(int b, int tb, const bf16* QI, const bf16* KI, const float* WI, unsigned* MASK, LAS unsigned char* lds, int wave, int lane, int mode = 0) {
    const int r = lane & 31, hs = lane >> 5;
    const int qa = tb * 16 + 2 * wave;
    const int cmax = (qa + 1) >> 5;
    const int aq = qa + ((r >> 2) & 1), ah = (r & 3) + 4 * (r >> 3);
    const bf16* ap = QI + ((size_t)(b * SEQ + aq)) * 1024 + ah * 64 + 8 * hs;
    bf16x8 af[4];
#pragma unroll
    for (int kk = 0; kk < 4; ++kk) af[kk] = *(const bf16x8*)(ap + 16 * kk);
    const int myq = qa + hs;
    const f32x4* wp = (const f32x4*)(WI + (size_t)(b * SEQ + myq) * 16);
    float wg[16];
#pragma unroll
    for (int j = 0; j < 4; ++j) { const f32x4 t = wp[j]; wg[4 * j] = t[0]; wg[4 * j + 1] = t[1]; wg[4 * j + 2] = t[2]; wg[4 * j + 3] = t[3]; }
    const bf16* kib = KI + (size_t)(b * SEQ) * 64;
    const unsigned kio = (unsigned)((8 * wave + (lane >> 3)) * 64 + (((lane & 7) ^ (((8 * wave + (lane >> 3)) >> 1) & 7)) * 8)) * 2u;
#define IDX_ISSUE(ch, buf) do { _Pragma("unroll") for (int _j = 0; _j < 4; ++_j) \
        __builtin_amdgcn_global_load_lds((const unsigned*)((const char*)kib + (size_t)(ch) * 32768 + (size_t)_j * 8192 + kio), (LAS unsigned*)((buf) + (wave + 8 * _j) * 1024), 16, 0, 0); } while (0)
    const unsigned fb = (unsigned)(r * 128 + ((((r >> 1) & 7) ^ hs) << 4));
    float u[64];
    float mn4[4] = {INFINITY, INFINITY, INFINITY, INFINITY}, mx4[4] = {-INFINITY, -INFINITY, -INFINITY, -INFINITY};
    if (mode != 2) {
        IDX_ISSUE(0, lds);
        if (8 <= cmax) { IDX_ISSUE(1, lds + 32768); asm volatile("s_waitcnt vmcnt(4)" ::: "memory"); } else asm volatile("s_waitcnt vmcnt(0)" ::: "memory");
        LDS_BARRIER();
    }
#pragma unroll
    for (int ch = 0; ch < 8; ++ch) {
        if (8 * ch <= cmax && mode != 2) {
            LAS unsigned char* cur = lds + (ch % 3) * 32768;
            const bool ahead = (ch + 2 < 8) && (8 * (ch + 2) <= cmax);
            if (ahead) IDX_ISSUE(ch + 2, lds + ((ch + 2) % 3) * 32768);
#pragma unroll
            for (int j = 0; j < 8; ++j) {
                const int c = 8 * ch + j;
                {
                    f32x16 acc;
#pragma unroll
                    for (int i = 0; i < 16; ++i) acc[i] = 0.f;
#pragma unroll
                    for (int kk = 0; kk < 4; ++kk) { const bf16x8 kf = *(const LAS bf16x8*)(cur + j * 4096 + (fb ^ (unsigned)(kk << 5))); acc = __builtin_amdgcn_mfma_f32_32x32x16_bf16(af[kk], kf, acc, 0, 0, 0); }
                    float s4[4] = {0.f, 0.f, 0.f, 0.f};
#pragma unroll
                    for (int i = 0; i < 16; ++i) { const float av = acc[i]; const int rb = __float_as_int(av); s4[i & 3] += wg[i] * __int_as_float(rb > 0 ? rb : 0); }
                    const float sv = (s4[0] + s4[1]) + (s4[2] + s4[3]); const bool ok = (32 * c + r <= myq);
                    u[c] = ok ? sv : -INFINITY; mx4[j & 3] = fmaxf(mx4[j & 3], ok ? sv : -INFINITY); mn4[j & 3] = fminf(mn4[j & 3], ok ? sv : INFINITY);
                }
            }
            if (ahead) asm volatile("s_waitcnt vmcnt(4)" ::: "memory"); else asm volatile("s_waitcnt vmcnt(0)" ::: "memory");
            LDS_BARRIER();
        } else {
#pragma unroll
            for (int j = 0; j < 8; ++j) u[8 * ch + j] = -INFINITY;
        }
    }
#undef IDX_ISSUE
    if (mode == 1) return;
    float T = -3.0e38f;
    if (qa >= 256) {
        float L = half_min(fminf(fminf(mn4[0], mn4[1]), fminf(mn4[2], mn4[3]))), H = half_max(fmaxf(fmaxf(mx4[0], mx4[1]), fmaxf(mx4[2], mx4[3])));
        bool done0 = false, done1 = false;
        for (int it = 0; it < 48; ++it) {
            const float mid = 0.5f * L + 0.5f * H;
            int cn4[4] = {0, 0, 0, 0};
#pragma unroll
            for (int g = 0; g < 8; ++g)
                if (8 * g <= cmax) {
#pragma unroll
                    for (int j = 0; j < 8; ++j) cn4[j & 3] += (u[8 * g + j] >= mid) ? 1 : 0;
                }
            int cnt = (cn4[0] + cn4[1]) + (cn4[2] + cn4[3]);
            cnt += __builtin_amdgcn_update_dpp(0, cnt, 0xB1, 0xF, 0xF, true);
            cnt += __builtin_amdgcn_update_dpp(0, cnt, 0x4E, 0xF, 0xF, true);
            cnt += __builtin_amdgcn_update_dpp(0, cnt, 0x141, 0xF, 0xF, true);
            cnt += __builtin_amdgcn_update_dpp(0, cnt, 0x140, 0xF, 0xF, true);
            const int c0 = __builtin_amdgcn_readlane(cnt, 0) + __builtin_amdgcn_readlane(cnt, 16);
            const int c1 = __builtin_amdgcn_readlane(cnt, 32) + __builtin_amdgcn_readlane(cnt, 48);
            const int mine = hs ? c1 : c0; const bool mydone = hs ? done1 : done0;
            if (!mydone) { if (mine == 256) T = mid; else if (mine > 256) L = mid; else H = mid; }
            done0 |= (c0 == 256); done1 |= (c1 == 256);
            if (done0 && done1) break;
        }
        if (!(hs ? done1 : done0)) T = L;
    }
    unsigned wl4[4] = {0u, 0u, 0u, 0u}, wh4[4] = {0u, 0u, 0u, 0u};
#pragma unroll
    for (int g = 0; g < 8; ++g)
        if (8 * g <= cmax) {
#pragma unroll
            for (int j = 0; j < 8; ++j) {
                const int c = 8 * g + j;
                const unsigned long long bal = __ballot(u[c] >= T);
                const unsigned blo = (unsigned)bal, bhi = (unsigned)(bal >> 32);
                asm volatile("s_nop 3\n\tv_writelane_b32 %0, %2, %4\n\tv_writelane_b32 %1, %3, %4" : "+v"(wl4[j & 3]), "+v"(wh4[j & 3]) : "s"(blo), "s"(bhi), "i"(c));
            }
            __builtin_amdgcn_sched_barrier(0);
        }
    const unsigned wlo = (wl4[0] | wl4[1]) | (wl4[2] | wl4[3]), whi = (wh4[0] | wh4[1]) | (wh4[2] | wh4[3]);
    MASK[(size_t)(b * SEQ + qa) * 64 + lane] = wlo; MASK[(size_t)(b * SEQ + qa + 1) * 64 + lane] = whi;
    LDS_WAIT();
}

__device__ __forceinline__ void sgu_unit(int b, int c, int g, const bf16* WSP, const bf16* VBT, const bf16* U, const float* rowsq_vb, float vbscale, const float* sgu_g, const float* bsp, bf16* OAB, LAS float* rsl, int wave, int lane) {
    const int tb = (wave >> 1) * 32, dblk = (wave & 1) * 64, r = lane & 31, hs = lane >> 5;
    LAS float* rw = rsl + wave * 128;
    const float q0 = rowsq_vb[b * SEQ + c * CHUNK + lane], q1 = rowsq_vb[b * SEQ + c * CHUNK + 64 + lane];
    f32x16 acc[2];
#pragma unroll
    for (int i = 0; i < 16; ++i) { acc[0][i] = 0.f; acc[1][i] = 0.f; }
    const int kkmax = 2 * (wave >> 1) + 1;
    u32x4 raw[8]; bf16x8 vfr[8][2];
#pragma unroll
    for (int kk = 0; kk < 8; ++kk)
        if (kk <= kkmax) {
            raw[kk] = *(const u32x4*)(WSP + (size_t)(g * CHUNK + tb + r) * CHUNK + 16 * kk + 8 * hs);
#pragma unroll
            for (int j2 = 0; j2 < 2; ++j2) vfr[kk][j2] = *(const bf16x8*)(VBT + ((size_t)(b * 1024 + g * 128 + dblk + 32 * j2 + r)) * 2048 + c * CHUNK + 16 * kk + 8 * hs);
        }
    const int t = tb + r; const size_t row = (size_t)(b * SEQ + c * CHUNK + t); const float bt = bsp[g * CHUNK + t];
    u32x2 uraw[2][4];
#pragma unroll
    for (int j2 = 0; j2 < 2; ++j2)
#pragma unroll
        for (int q4 = 0; q4 < 4; ++q4) uraw[j2][q4] = *(const u32x2*)(U + row * 1024 + g * 128 + dblk + 32 * j2 + 8 * q4 + 4 * hs);
    rw[lane] = 1.0f / sqrtf(q0 * vbscale + EPS); rw[64 + lane] = 1.0f / sqrtf(q1 * vbscale + EPS);
    LDS_WAIT();
#pragma unroll
    for (int kk = 0; kk < 8; ++kk)
        if (kk <= kkmax) {
            const LAS float* rp = rw + 16 * kk + 8 * hs;
            u32x4 sc;
            sc.x = pk2(bf2f(raw[kk].x & 0xffffu) * rp[0], bf2f(raw[kk].x >> 16) * rp[1]); sc.y = pk2(bf2f(raw[kk].y & 0xffffu) * rp[2], bf2f(raw[kk].y >> 16) * rp[3]);
            sc.z = pk2(bf2f(raw[kk].z & 0xffffu) * rp[4], bf2f(raw[kk].z >> 16) * rp[5]); sc.w = pk2(bf2f(raw[kk].w & 0xffffu) * rp[6], bf2f(raw[kk].w >> 16) * rp[7]);
            const bf16x8 wfr = __builtin_bit_cast(bf16x8, sc);
#pragma unroll
            for (int j2 = 0; j2 < 2; ++j2) acc[j2] = __builtin_amdgcn_mfma_f32_32x32x16_bf16(vfr[kk][j2], wfr, acc[j2], 0, 0, 0);
        }
#pragma unroll
    for (int j2 = 0; j2 < 2; ++j2)
#pragma unroll
        for (int q4 = 0; q4 < 4; ++q4) {
            const int d = g * 128 + dblk + 32 * j2 + 8 * q4 + 4 * hs;
            const f32x4 gd = *(const f32x4*)(sgu_g + d); const u32x2 uw = uraw[j2][q4]; f32x4 uv, o;
            uv[0] = bf2f(uw.x & 0xffffu); uv[1] = bf2f(uw.x >> 16); uv[2] = bf2f(uw.y & 0xffffu); uv[3] = bf2f(uw.y >> 16);
#pragma unroll
            for (int e = 0; e < 4; ++e) o[e] = uv[e] * (acc[j2][4 * q4 + e] * gd[e] + bt);
            store_bf16x4(OAB + row * 2048 + 1024 + d, o);
        }
    LDS_WAIT();
}

constexpr int AT_TILE = 16384, AT_BUF = 65536;
__device__ __forceinline__ void attn_issue(const bf16* Kg, const bf16* Vg, int s, LAS unsigned char* buf, int wave, unsigned voffK, unsigned voffV) {
#pragma unroll
    for (int tt = 0; tt < 2; ++tt)
#pragma unroll
        for (int j = 0; j < 2; ++j) {
            const int blk = wave + 8 * j;
            __builtin_amdgcn_global_load_lds((const unsigned*)((const char*)Kg + (size_t)(2 * s + tt) * 131072 + (size_t)j * 65536 + voffK), (LAS unsigned*)(buf + tt * AT_TILE + blk * 1024), 16, 0, 0);
            __builtin_amdgcn_global_load_lds((const unsigned*)((const char*)Vg + (size_t)(2 * s + tt) * 128 + (size_t)j * 262144 + voffV), (LAS unsigned*)(buf + 2 * AT_TILE + tt * AT_TILE + blk * 1024), 16, 0, 0);
        }
}
__device__ __forceinline__ void attn_unit(int b, int h, int iq, const bf16* Q, const bf16* K, const bf16* VT, const unsigned* MASK, const LAS float* tbl, bf16* OAB, LAS unsigned char* lds, int wave, int lane) {
    const int tid = threadIdx.x, qg = wave & 3, kg = wave >> 2, r = lane & 31, hs = lane >> 5;
    const int qw = 128 * iq + 32 * qg;
    const size_t qrow = (size_t)(b * SEQ + qw + r);
    const bf16* Kg = K + (size_t)(b * SEQ) * 1024 + h * HD;
    const bf16* Vg = VT + (size_t)(b * 1024 + h * HD) * 2048;
    const int nsteps = iq + 1;
    const int rq = 4 * wave + (lane >> 4);
    const unsigned voffK = (unsigned)(rq * 1024 + (((lane & 15) ^ (rq & 15)) * 8)) * 2u;
    const unsigned voffV = (unsigned)((8 * wave + (lane >> 3)) * 2048 + (((lane & 7) ^ (rq & 7)) * 8)) * 2u;
    attn_issue(Kg, Vg, 0, lds, wave, voffK, voffV);
    {
        const char* Qg = (const char*)(Q + (size_t)(b * SEQ + 128 * iq) * 1024 + h * HD);
#pragma unroll
        for (int j = 0; j < 4; ++j) __builtin_amdgcn_global_load_lds((const unsigned*)(Qg + (size_t)j * 65536 + voffK), (LAS unsigned*)(lds + AT_BUF + (wave + 8 * j) * 1024), 16, 0, 0);
    }
    u32x2 mw = *(const u32x2*)(MASK + qrow * 64 + 2 * kg);
    f32x16 o[4];
#pragma unroll
    for (int db = 0; db < 4; ++db)
#pragma unroll
        for (int i = 0; i < 16; ++i) o[db][i] = 0.f;
    float mref = 0.f, lrun = 0.f;
    const float c31 = tbl[128];
    const unsigned kbase = (unsigned)(r * 256 + (((r & 15) ^ hs) << 4));
    const unsigned vbase = (unsigned)(r * 128 + ((((r >> 1) & 7) ^ hs) << 4));
    AT_WAIT_BARRIER();
    bf16x8 qf[8];
#pragma unroll
    for (int kk = 0; kk < 8; ++kk) qf[kk] = *(const LAS bf16x8*)(lds + AT_BUF + qg * 8192 + (kbase ^ (unsigned)(kk << 5)));
    LDS_BARRIER();
    for (int s = 0; s < nsteps; ++s) {
        LAS unsigned char* cur = lds + (s & 1) * AT_BUF; LAS unsigned char* nxt = lds + ((s + 1) & 1) * AT_BUF;
        const bool more = (s + 1 < nsteps);
        if (more) attn_issue(Kg, Vg, s + 1, nxt, wave, voffK, voffV);
        const int t = 2 * s + kg;
        u32x2 mwn = mw;
        if (more) mwn = *(const u32x2*)(MASK + qrow * 64 + 2 * (t + 2));
        f32x16 p[2];
        const LAS unsigned char* Kt = cur + kg * AT_TILE;
        unsigned kofs = kbase; asm volatile("" : "+v"(kofs));
        const bool far = (qw - (64 * t + 63)) >= 113;
        if (far) {
            const int cb = __float_as_int(c31 - mref);
#pragma unroll
            for (int kb = 0; kb < 2; ++kb) {
                const int word = (int)((kb == 0 ? mw.x : mw.y) >> (4 * hs));
#pragma unroll
                for (int i = 0; i < 16; ++i) { const int tmask = __builtin_amdgcn_sbfe(word, rowoff16(i), 1); int rr; asm("v_bfi_b32 %0, %1, %2, %3" : "=v"(rr) : "v"(tmask), "v"(cb), "v"((int)0xFF800000)); p[kb][i] = __int_as_float(rr); }
            }
        } else {
            const int dist0 = (qw + r) - (64 * t + 4 * hs);
#pragma unroll
            for (int kb = 0; kb < 2; ++kb) {
                const int word = (int)((kb == 0 ? mw.x : mw.y) >> (4 * hs));
#pragma unroll
                for (int i = 0; i < 16; ++i) {
                    int di = dist0 - 32 * kb - rowoff16(i); di = di < 0 ? 0 : (di > 128 ? 128 : di);
                    const int cb = __float_as_int(tbl[di] - mref); const int tmask = __builtin_amdgcn_sbfe(word, rowoff16(i), 1); int rr;
                    asm("v_bfi_b32 %0, %1, %2, %3" : "=v"(rr) : "v"(tmask), "v"(cb), "v"((int)0xFF800000)); p[kb][i] = __int_as_float(rr);
                }
            }
        }
#pragma unroll
        for (int kb = 0; kb < 2; ++kb)
#pragma unroll
            for (int kk = 0; kk < 8; ++kk) {
                const bf16x8 kf = *(const LAS bf16x8*)(Kt + kb * 8192 + (kofs ^ (unsigned)(kk << 5)));
                p[kb] = __builtin_amdgcn_mfma_f32_32x32x16_bf16(kf, qf[kk], p[kb], 0, 0, 0);
            }
        float mx4[4] = {-INFINITY, -INFINITY, -INFINITY, -INFINITY};
#pragma unroll
        for (int kb = 0; kb < 2; ++kb)
#pragma unroll
            for (int i = 0; i < 16; ++i) { const float v = p[kb][i]; mx4[i & 3] = fmaxf(mx4[i & 3], v); }
        float mx = fmaxf(fmaxf(mx4[0], mx4[1]), fmaxf(mx4[2], mx4[3]));
        mx = fmaxf(mx, __shfl_xor(mx, 32));
        if (__any(mx > 8.0f)) {
            const float d = fmaxf(mx, 0.f), f = __builtin_amdgcn_exp2f(-d);
            mref += d; lrun *= f;
#pragma unroll
            for (int kb = 0; kb < 2; ++kb)
#pragma unroll
                for (int i = 0; i < 16; ++i) p[kb][i] -= d;
#pragma unroll
            for (int db = 0; db < 4; ++db)
#pragma unroll
                for (int i = 0; i < 16; ++i) o[db][i] *= f;
        }
        float ls4[4] = {0.f, 0.f, 0.f, 0.f};
#pragma unroll
        for (int kb = 0; kb < 2; ++kb)
#pragma unroll
            for (int i = 0; i < 16; ++i) { const float pv = p[kb][i]; const float e = __builtin_amdgcn_exp2f(pv); p[kb][i] = e; ls4[i & 3] += e; }
        lrun += (ls4[0] + ls4[1]) + (ls4[2] + ls4[3]);
        const LAS unsigned char* Vt = cur + 2 * AT_TILE + kg * AT_TILE;
        unsigned vofs = vbase; asm volatile("" : "+v"(vofs));
#pragma unroll
        for (int s4 = 0; s4 < 4; ++s4) {
            const int kb = s4 >> 1, e0 = 8 * (s4 & 1);
            u32x4 w; w.x = pk2(p[kb][e0], p[kb][e0 + 1]); w.y = pk2(p[kb][e0 + 2], p[kb][e0 + 3]); w.z = pk2(p[kb][e0 + 4], p[kb][e0 + 5]); w.w = pk2(p[kb][e0 + 6], p[kb][e0 + 7]);
            const bf16x8 pf = __builtin_bit_cast(bf16x8, w);
#pragma unroll
            for (int db = 0; db < 4; ++db) {
                const bf16x8 vf = *(const LAS bf16x8*)(Vt + db * 4096 + (vofs ^ (unsigned)((2 * s4) << 4)));
                o[db] = __builtin_amdgcn_mfma_f32_32x32x16_bf16(vf, pf, o[db], 0, 0, 0);
            }
        }
        mw = mwn;
        AT_WAIT_BARRIER();
    }
    lrun += __shfl_xor(lrun, 32);
    LAS float* comb = (LAS float*)(lds + qg * 16896);
    if (kg == 1) {
#pragma unroll
        for (int db = 0; db < 4; ++db)
#pragma unroll
            for (int i = 0; i < 16; ++i) comb[(db * 16 + i) * 64 + lane] = o[db][i];
        comb[4096 + lane] = mref; comb[4160 + lane] = lrun;
    }
    LDS_BARRIER();
    if (kg == 0) {
        const float m1 = comb[4096 + lane], l1 = comb[4160 + lane];
        const float mm = fmaxf(mref, m1);
        const float a0 = __builtin_amdgcn_exp2f(mref - mm), a1 = __builtin_amdgcn_exp2f(m1 - mm);
        const float inv = 1.0f / (lrun * a0 + l1 * a1);
        const float s0 = a0 * inv, s1 = a1 * inv;
        LAS unsigned char* stg = lds + 69632 + qg * 8704;
#pragma unroll
        for (int db = 0; db < 4; ++db)
#pragma unroll
            for (int i4 = 0; i4 < 4; ++i4) {
                float v[4];
#pragma unroll
                for (int e = 0; e < 4; ++e) { const int i = 4 * i4 + e; v[e] = o[db][i] * s0 + comb[(db * 16 + i) * 64 + lane] * s1; }
                *(LAS unsigned*)(stg + r * 144 + (32 * db + 8 * i4 + 4 * hs)) = pk4_fp8(v[0] * OA_SCALE, v[1] * OA_SCALE, v[2] * OA_SCALE, v[3] * OA_SCALE);
            }
        LDS_WAIT();
#pragma unroll
        for (int j = 0; j < 4; ++j) {
            const int cid = lane + 64 * j, row = cid >> 3, ch = cid & 7;
            const u32x4 v = *(const LAS u32x4*)(stg + row * 144 + ch * 16);
            *(u32x4*)((unsigned char*)OAB + ((size_t)(b * SEQ + qw + row)) * 4096 + h * HD + ch * 16) = v;
        }
    }
    LDS_BARRIER();
}

#define XB_TMO      128
#define XB_XCNT(j)  (256  + 64 * (j))
#define XB_XSUB(j)  (1280 + 64 * (j))
#define XB_XGEN(j)  (2304 + 64 * (j))
#define XB_TOP      3328
#define XB_TOPGEN   3392
#define XCD_BAR_WORDS 3456
#define XB_SPIN_CAP (1u << 22)
__device__ __forceinline__ unsigned xb_ld(unsigned* p)              { return __hip_atomic_load(p, __ATOMIC_RELAXED, __HIP_MEMORY_SCOPE_AGENT); }
__device__ __forceinline__ unsigned xb_add(unsigned* p, unsigned v) { return __hip_atomic_fetch_add(p, v, __ATOMIC_RELAXED, __HIP_MEMORY_SCOPE_AGENT); }
__device__ __forceinline__ unsigned xb_xcc_id() { return (unsigned)__builtin_amdgcn_s_getreg((3 << 11) | 20) & 0xFu; }
#define XB_SPIN(cond, bar) do { unsigned _sp = 0; while (cond) { __builtin_amdgcn_s_sleep(1); \
    if ((++_sp & 255u) == 0u) { if (xb_ld(&(bar)[XB_TMO])) break; if (_sp > XB_SPIN_CAP) { atomicAdd(&(bar)[XB_TMO], 1u); break; } } } } while (0)
struct XcdBarrier { unsigned* bar; unsigned x; volatile LAS unsigned* st; };
__device__ __forceinline__ XcdBarrier xcd_barrier_post(unsigned* bar, volatile LAS unsigned* st) {
    XcdBarrier b; b.bar = bar; b.x = xb_xcc_id(); b.st = st;
    if (threadIdx.x == 0) (void)xb_add(&bar[XB_XCNT(b.x)], 1u);
    return b;
}
__device__ __forceinline__ void xcd_barrier_complete(unsigned* bar, unsigned x, unsigned& nloc, unsigned& nx) {
    const unsigned G = gridDim.x * gridDim.y * gridDim.z;
    unsigned sum, cnt, mine, sp = 0u;
    for (;;) {
        sum = 0u; cnt = 0u; mine = 0u;
#pragma unroll
        for (unsigned j = 0; j < 16; ++j) { const unsigned c = xb_ld(&bar[XB_XCNT(j)]); sum += c; cnt += (c > 0u) ? 1u : 0u; mine = (j == x) ? c : mine; }
        if (sum == G) break;
        __builtin_amdgcn_s_sleep(1);
        if ((++sp & 255u) == 0u) { if (xb_ld(&bar[XB_TMO])) break; if (sp > XB_SPIN_CAP) { atomicAdd(&bar[XB_TMO], 1u); break; } }
    }
    nloc = mine > 0u ? mine : 1u; nx = cnt > 0u ? cnt : 1u;
}
__device__ __forceinline__ void xcd_barrier(const XcdBarrier& b) {
    asm volatile("s_waitcnt vmcnt(0)" ::: "memory");
    __syncthreads();
    if (threadIdx.x == 0) {
        unsigned* bar = b.bar;
        __builtin_amdgcn_s_waitcnt(0);
        unsigned nloc = b.st[0], nx = b.st[1];
        if (nloc == 0u) { xcd_barrier_complete(bar, b.x, nloc, nx); b.st[0] = nloc; b.st[1] = nx; }
        const unsigned old = xb_add(&bar[XB_XSUB(b.x)], 1u);
        const unsigned gen = old / nloc;
        if (old + 1u == (gen + 1u) * nloc) {
            __builtin_amdgcn_fence(__ATOMIC_RELEASE, "agent");
            asm volatile("s_waitcnt vmcnt(0)" ::: "memory");
            const unsigned og = xb_add(&bar[XB_TOP], 1u);
            const unsigned tg = og / nx;
            if (og + 1u == (tg + 1u) * nx) xb_add(&bar[XB_TOPGEN], 1u);
            else XB_SPIN(xb_ld(&bar[XB_TOPGEN]) == tg, bar);
            __builtin_amdgcn_fence(__ATOMIC_ACQUIRE, "agent");
            xb_add(&bar[XB_XGEN(b.x)], 1u);
            asm volatile("s_waitcnt vmcnt(0)" ::: "memory");
        } else {
            XB_SPIN(xb_ld(&bar[XB_XGEN(b.x)]) == gen, bar);
            __builtin_amdgcn_fence(__ATOMIC_ACQUIRE, "agent");
            asm volatile("s_waitcnt vmcnt(0)" ::: "memory");
        }
    }
    __syncthreads();
}

struct Args { Ptrs p; int ph_lo, ph_hi, vbrep, mode; };
constexpr int NPHASE = 8;

__global__ void __launch_bounds__(512, 2) fwd(Args args) {
    extern __shared__ __attribute__((aligned(16))) unsigned char lds_raw[];
    LAS unsigned char* lds = (LAS unsigned char*)lds_raw;
    const Ptrs& P = args.p; unsigned char* ws = P.ws;
    const int tid = threadIdx.x, lane = tid & 63, wave = __builtin_amdgcn_readfirstlane(tid >> 6);
    const int G = gridDim.x, bx = blockIdx.x;
    const int vcu = (G % 8 == 0) ? (bx % 8) * (G / 8) + bx / 8 : bx;
    const int lo = args.ph_lo, hi = args.ph_hi;
#ifndef PHASE_MASK
#define PHASE_MASK 0xff
#endif
#define IN(k) (((PHASE_MASK >> (k)) & 1) && lo <= (k) && (k) < hi)
#if ONE_LAUNCH
    volatile LAS unsigned* bst = (volatile LAS unsigned*)(lds + LDS_BYTES - 64);
    if (tid < 16) bst[tid] = 0u;
    {
        unsigned* ctl = (unsigned*)(ws + WS_CTL);
        for (int i = bx * 512 + tid; i < (int)(CTL_BYTES / 4); i += G * 512) __hip_atomic_store(&ctl[i], 0u, __ATOMIC_RELAXED, __HIP_MEMORY_SCOPE_AGENT);
        asm volatile("s_waitcnt vmcnt(0)" ::: "memory");
    }
    __syncthreads();
    if (tid == 0) __builtin_amdgcn_fence(__ATOMIC_RELEASE, "agent");
    cg::this_grid().sync();
    XcdBarrier xbar = xcd_barrier_post((unsigned*)(ws + WS_CTL + CTL_BAR), bst);
#define SEAM(k) do { if (IN(k) && IN((k) + 1)) { xcd_barrier(xbar); if (NREP(13) == 2) xcd_barrier(xbar); } } while (0)
#else
#define SEAM(k) do { } while (0)
#endif
    bf16* WIN = (bf16*)(ws + WS_WIN); bf16* WAB = (bf16*)(ws + WS_WAB); bf16* WOUT = (bf16*)(ws + WS_WOUT); bf16* W1 = (bf16*)(ws + WS_W1); bf16* W2 = (bf16*)(ws + WS_W2);
    bf16* H1 = (bf16*)(ws + WS_H1); bf16* OAB = (bf16*)(ws + WS_OAB); bf16* ACT = (bf16*)(ws + WS_ACT);
    bf16* Qb = (bf16*)(ws + WS_Q); bf16* Kb = (bf16*)(ws + WS_K); bf16* VT = (bf16*)(ws + WS_VT); bf16* QI = (bf16*)(ws + WS_QI);
    bf16* Ub = (bf16*)(ws + WS_U); bf16* VBT = (bf16*)(ws + WS_VBT); bf16* X1B = (bf16*)(ws + WS_X1B); const unsigned char* GA = ws + WS_GA; const unsigned char* GB = ws + WS_GB;
    bf16* KI = (bf16*)(ws + WS_KI); float* WI = (float*)(ws + WS_WI); bf16* WSP = (bf16*)(ws + WS_WSP); float* TBL = (float*)(ws + WS_TBL);
    unsigned* MASK = (unsigned*)(ws + WS_MASK); bf16* MERGED = (bf16*)(ws + WS_MERGED);
    float* rowsq_vb = (float*)(ws + WS_CTL + CTL_ROWSQ_VB); float* rowsq2 = (float*)(ws + WS_CTL + CTL_ROWSQ2);

    if (IN(0)) for (int rep = 0; rep < NREP(0); ++rep) { p0_prologue(P, lds, vcu, G); }
    SEAM(0);
    if (IN(1)) for (int rep = 0; rep < NREP(1); ++rep) {
        { pg8::Gemm g{H1, WIN, MTOK, P1_NB16, DM, DM, DM}; pg8::StaticOrder S; S.init(MTOK, P1_NB16, G, bx);
          EpiIn<false> E{ws, P.q_norm_g, P.k_norm_g};
          pg8::gemm_phase<EpiIn<false>, pg8::NoMid, NREP(12)>(lds, g, S, E); }
        { pg8::Gemm g{(const pg8::bf16_t*)((const unsigned char*)P.out + OUT_H1F8), (const pg8::bf16_t*)((const unsigned char*)P.out + OUT_W8), MTOK, P1_NF8, DM / 2, DM / 2, DM / 2}; pg8::StaticOrder S; S.init(MTOK, P1_NF8, G, bx);
          EpiIn<true> E{ws, P.q_norm_g, P.k_norm_g};
          pg8::gemm_phase<EpiIn<true>, pg8::NoMid, 1, pg8::StaticOrder, true>(lds, g, S, E); }
        for (int rb = bx; rb < MTOK / 32; rb += G) kiwi_unit(rb, H1, WIN, P.idx_k_norm_g, KI, WI, lds, wave, lane);
    }
    SEAM(1);
    if (IN(2)) for (int rep = 0; rep < NREP(2); ++rep) {
        for (int r2 = 0; r2 < NREP(8); ++r2)
        for (int p = vcu; p < 256; p += G) { const int b = p >> 6, i = p & 63; indexer_unit(b, i, QI, KI, WI, MASK, lds, wave, lane, args.mode); indexer_unit(b, 127 - i, QI, KI, WI, MASK, lds, wave, lane, args.mode); }
        __syncthreads();
        if (args.mode == 0)
        for (int r2 = 0; r2 < NREP(9); ++r2)
        for (int un = vcu; un < 512; un += G) { const int b = un >> 7, c = (un >> 3) & 15, g = un & 7; sgu_unit(b, c, g, WSP, VBT, Ub, rowsq_vb, 1.0f / (float)(WBW * NREP(1) * NREP(12) * args.vbrep), P.sgu_norm_g, P.b_spatial, OAB, (LAS float*)(lds + SCR_OFF), wave, lane); }
    }
    SEAM(2);
    if (IN(3)) for (int rep = 0; rep < NREP(3); ++rep) {
        LAS float* tbl = (LAS float*)(lds + SCR_OFF);
        for (int p = vcu; p < 256; p += G) {
            const int b = p >> 6, h = (p >> 3) & 7, i = p & 7;
            __syncthreads();
            if (tid < 132) tbl[tid] = TBL[h * 132 + tid];
            __syncthreads();
            attn_unit(b, h, i, Qb, Kb, VT, MASK, tbl, OAB, lds, wave, lane);
            attn_unit(b, h, 15 - i, Qb, Kb, VT, MASK, tbl, OAB, lds, wave, lane);
        }
    }
    SEAM(3);
    if (IN(4)) for (int rep = 0; rep < NREP(4); ++rep) {
        pg8::Gemm g{OAB, WAB, MTOK, DM, 1536, DM, DM, 8}; pg8::StaticOrder S; S.init(MTOK, DM, G, bx);
        EpiMerge E{GB, MERGED}; MidMerge H{GA, GB, 1.0f / (GATE_WSCALE * OA_SCALE)}; pg8::gemm_phase<EpiMerge, MidMerge, 1, pg8::StaticOrder, 2>(lds, g, S, E, H);
    }
    SEAM(4);
    if (IN(5)) for (int rep = 0; rep < NREP(5); ++rep) {
        pg8::Gemm g{MERGED, WOUT, MTOK, DM, DM, DM, DM}; pg8::StaticOrder S; S.init(MTOK, DM, G, bx);
        EpiOut E{P.x, X1B, rowsq2}; pg8::gemm_phase(lds, g, S, E);
    }
    SEAM(5);
    if (IN(6)) for (int rep = 0; rep < NREP(6); ++rep) {
        { pg8::Gemm g{X1B, W1, MTOK, 10240, DM, DM, DM}; pg8::StaticOrder S; S.init(MTOK, 10240, G, bx); EpiFfnUp E{rowsq2, ACT, 0}; pg8::gemm_phase(lds, g, S, E); }
        if (G == 256) {
            const int xcd = bx & 7, idx = bx >> 3, t = xcd * 16 + (idx >> 1), half = idx & 1;
            pg8::Gemm g{X1B + half * 1024, W1 + (size_t)10240 * 2048 + half * 1024, MTOK, 1024, 1024, DM, DM}; pg8::OneUnit S{t >> 2, t & 3};
            EpiFfnUpPair E{rowsq2, ACT, 40, half, (float*)(ws + WS_SLAB) + (size_t)t * 65536, (unsigned*)(ws + WS_CTL + CTL_PAIR) + t * 16};
            pg8::gemm_phase<EpiFfnUpPair, pg8::NoMid, 1, pg8::OneUnit>(lds, g, S, E);
        } else {
            pg8::Gemm g{X1B, W1 + (size_t)10240 * 2048, MTOK, 1024, DM, DM, DM}; pg8::StaticOrder S; S.init(MTOK, 1024, G, bx); EpiFfnUp E{rowsq2, ACT, 40}; pg8::gemm_phase(lds, g, S, E);
        }
    }
    SEAM(6);
    if (IN(7)) for (int rep = 0; rep < NREP(7); ++rep) {
        pg8::Gemm g{ACT, W2, MTOK, DM, FFN_T8 * 64 + (DFF - FFN_KF), DFF, DFF, FFN_T8}; pg8::StaticOrder S; S.init(MTOK, DM, G, bx);
        EpiFfnDown E{X1B, P.out}; MidScale H{1.0f / GATE_WSCALE}; pg8::gemm_phase<EpiFfnDown, MidScale, 1, pg8::StaticOrder, 2>(lds, g, S, E, H);
    }
#undef IN
#undef SEAM
}

extern "C" void kernel_launch(void* const* d_in, const int* in_sizes, int n_in, void* d_out, int out_size, void* d_ws, size_t ws_size, hipStream_t stream) {
    static int grid = 0;
    if (grid == 0) {
        if (n_in != 17 || in_sizes[0] != MTOK * DM || out_size != MTOK * DM || ws_size < WS_END) { fprintf(stderr, "kernel_launch: unexpected shapes (n_in %d, in0 %d, out %d, ws %zu < %zu); nothing launched\n", n_in, n_in > 0 ? in_sizes[0] : -1, out_size, ws_size, (size_t)WS_END); grid = -1; return; }
        int dev = 0, cus = 0;
        if (hipGetDevice(&dev) != hipSuccess || hipDeviceGetAttribute(&cus, hipDeviceAttributeMultiprocessorCount, dev) != hipSuccess) { grid = -1; return; }
        if (hipFuncSetAttribute((const void*)fwd, hipFuncAttributeMaxDynamicSharedMemorySize, LDS_BYTES) != hipSuccess) { fprintf(stderr, "kernel_launch: hipFuncSetAttribute failed\n"); grid = -1; return; }
        int per_cu = 0;
        if (hipOccupancyMaxActiveBlocksPerMultiprocessor(&per_cu, (const void*)fwd, 512, LDS_BYTES) != hipSuccess || per_cu < 1) { fprintf(stderr, "kernel_launch: occupancy query says %d blocks per CU\n", per_cu); (void)hipGetLastError(); grid = -1; return; }
        grid = cus;
    }
    if (grid < 0) return;
#if !ONE_LAUNCH
    (void)hipMemsetAsync((char*)d_ws + WS_CTL, 0, CTL_BYTES, stream);
#endif
    Args a{};
    const float** pp = (const float**)&a.p;
    for (int i = 0; i < 17; ++i) pp[i] = (const float*)d_in[i];
    a.p.out = (float*)d_out; a.p.ws = (unsigned char*)d_ws;
#if ONE_LAUNCH
    a.ph_lo = 0; a.ph_hi = NPHASE; a.vbrep = 1; a.mode = 0;
    void* kargs[] = {&a};
    hipError_t e = hipLaunchCooperativeKernel((const void*)fwd, dim3(grid), dim3(512), kargs, LDS_BYTES, stream);
    if (e != hipSuccess) fprintf(stderr, "cooperative launch failed: %s (grid %d)\n", hipGetErrorString(e), grid);
#else
#ifndef ML_REP_PHASE
#define ML_REP_PHASE -1
#endif
    a.vbrep = (ML_REP_PHASE == 1) ? 2 : 1; a.mode = 0;
#ifndef ML_P2_MODE
#define ML_P2_MODE 0
#endif
    for (int ph = 0; ph < NPHASE; ++ph) { a.ph_lo = ph; a.ph_hi = ph + 1; if (ph == 2 && ML_P2_MODE) { a.mode = ML_P2_MODE; hipLaunchKernelGGL(fwd, dim3(grid), dim3(512), LDS_BYTES, stream, a); a.mode = 0; }
        for (int k = 0; k < ((ph == ML_REP_PHASE) ? 2 : 1); ++k) hipLaunchKernelGGL(fwd, dim3(grid), dim3(512), LDS_BYTES, stream, a); }
#endif
}
```

```cpp
#include <hip/hip_runtime.h>
#include <hip/hip_cooperative_groups.h>
#include <cstdio>
#include <cstdint>
namespace cg = cooperative_groups;

#ifndef ONE_LAUNCH
#define ONE_LAUNCH 1
#endif
#ifndef REP_MASK
#define REP_MASK 0
#endif
#define NREP(k) (((REP_MASK >> (k)) & 1) ? 2 : 1)

#define LAS __attribute__((address_space(3)))
typedef unsigned short bf16;
typedef short bf16x8 __attribute__((ext_vector_type(8)));
typedef float f32x4 __attribute__((ext_vector_type(4)));
typedef float f32x16 __attribute__((ext_vector_type(16)));
typedef unsigned u32x4 __attribute__((ext_vector_type(4)));
typedef unsigned u32x2 __attribute__((ext_vector_type(2)));
typedef int i32x4 __attribute__((ext_vector_type(4)));
typedef int i32x8 __attribute__((ext_vector_type(8)));

constexpr int NB = 4, SEQ = 2048, DM = 2048, MTOK = NB * SEQ;
constexpr int WA = 1024, NH = 8, HD = 128, NIH = 16, IDXD = 64, WBW = 1024, NG = 8, CHUNK = 128;
constexpr int DFF = 5632, DIN = 10320, NIN = 10496;
constexpr float EPS = 1e-6f;
constexpr float LOG2E = 1.4426950408889634f;

constexpr size_t MiB = 1u << 20;
constexpr size_t WS_CTL = 0, CTL_BYTES = 144 * 1024;
constexpr size_t WS_KI = 1 * MiB;
constexpr size_t WS_WI = 2 * MiB;
constexpr size_t WS_WSP = 2 * MiB + 512 * 1024, WS_TBL = 2 * MiB + 768 * 1024;
constexpr size_t WS_MASK = 3 * MiB;
constexpr size_t WS_WIN = 5 * MiB;
constexpr size_t WS_MERGED = 5 * MiB;
constexpr size_t WS_SLAB = 5 * MiB;
constexpr size_t WS_WAB = 46 * MiB;
constexpr size_t WS_WOUT = 54 * MiB;
constexpr size_t WS_W1 = 62 * MiB;
constexpr size_t WS_W2 = 106 * MiB;
constexpr size_t WS_H1 = 128 * MiB;
constexpr size_t WS_OAB = 128 * MiB;
constexpr size_t WS_ACT = 128 * MiB;
constexpr size_t WS_Q = 160 * MiB, WS_K = 176 * MiB, WS_VT = 192 * MiB, WS_QI = 208 * MiB;
constexpr size_t WS_U = 224 * MiB, WS_VBT = 240 * MiB;
constexpr size_t WS_X1B = 224 * MiB;
constexpr size_t WS_GA = 256 * MiB, WS_GB = 288 * MiB;
constexpr size_t WS_END = 320 * MiB;
constexpr size_t OUT_H1F8 = 0, OUT_W8 = 16 * MiB;
constexpr size_t CTL_ROWSQ_VB = 0, CTL_ROWSQ2 = 32768, CTL_BAR = 65536, CTL_PAIR = 131072;

constexpr int RING_BYTES = 131072, SCR_OFF = RING_BYTES, LDS_BYTES = 147456;

__device__ const unsigned char T5_BUCKET[128] = {0, 1, 2, 3, 4, 5, 6, 7, 8, 9, 10, 11, 12, 13, 14, 15, 16, 16, 16, 17, 17, 18, 18, 18, 19, 19, 19, 20, 20, 20, 20, 21, 21, 21, 21, 22, 22, 22, 22, 22, 23, 23, 23, 23, 23, 23, 24, 24, 24, 24, 24, 24, 25, 25, 25, 25, 25, 25, 25, 26, 26, 26, 26, 26, 26, 26, 26, 27, 27, 27, 27, 27, 27, 27, 27, 27, 27, 28, 28, 28, 28, 28, 28, 28, 28, 28, 28, 29, 29, 29, 29, 29, 29, 29, 29, 29, 29, 29, 29, 30, 30, 30, 30, 30, 30, 30, 30, 30, 30, 30, 30, 30, 30, 31, 31, 31, 31, 31, 31, 31, 31, 31, 31, 31, 31, 31, 31, 31};

__device__ __forceinline__ unsigned f2bf(float f) { unsigned u = __builtin_bit_cast(unsigned, f); return (u + 0x7fffu + ((u >> 16) & 1u)) >> 16; }
typedef float f32x2_t __attribute__((ext_vector_type(2))); typedef __bf16 bf16x2_t __attribute__((ext_vector_type(2)));
__device__ __forceinline__ unsigned pk2(float lo, float hi) { f32x2_t v = {lo, hi}; bf16x2_t b = __builtin_convertvector(v, bf16x2_t); return __builtin_bit_cast(unsigned, b); }
__device__ __forceinline__ float bf2f(unsigned v) { return __builtin_bit_cast(float, v << 16); }
__device__ __forceinline__ float sigmoidf_(float x) { return __builtin_amdgcn_rcpf(1.0f + __builtin_amdgcn_exp2f(-x * LOG2E)); }
__device__ __forceinline__ float gelu_tanh(float x) { const float t = x * (1.0f + 0.044715f * x * x) * (2.0f * 0.7978845608028654f); return x * sigmoidf_(t); }
__device__ __forceinline__ float wave_sum(float v) {
#pragma unroll
    for (int o = 1; o < 64; o <<= 1) v += __shfl_xor(v, o);
    return v;
}
__device__ __forceinline__ int rowoff16(int i) { return (i & 3) + 8 * (i >> 2); }
#define LDS_WAIT() asm volatile("s_waitcnt lgkmcnt(0)" ::: "memory")
#define LDS_BARRIER() do { asm volatile("s_waitcnt lgkmcnt(0)" ::: "memory"); __builtin_amdgcn_s_barrier(); asm volatile("" ::: "memory"); } while (0)
#define AT_WAIT_BARRIER() do { asm volatile("s_waitcnt vmcnt(0) lgkmcnt(0)" ::: "memory"); __builtin_amdgcn_s_barrier(); asm volatile("" ::: "memory"); } while (0)

namespace pg8 {
#define PG8_LAS __attribute__((address_space(3)))
typedef unsigned short bf16_t;
constexpr int BM = 256, BK = 64, HALF = 128, HTB = HALF * BK * 2, STAGE_BYTES = 8 * HTB, NXCD = 8, WGM = 8;
__host__ __device__ __forceinline__ int lds_byte(int r, int c) { const int st = (r >> 4) * 2 + (c >> 5), rr = r & 15, cc = c & 31, ob = rr * 64 + cc * 2; return st * 1024 + (ob ^ (((ob >> 9) & 1) << 5)); }
__host__ __device__ __forceinline__ void stage_rc(int b, int& R, int& C) { const int st = b / 1024, sb = b % 1024, swz = sb ^ (((sb >> 9) & 1) << 5); R = (st >> 1) * 16 + swz / 64; C = (st & 1) * 32 + (swz % 64) / 2; }
__host__ __device__ __forceinline__ int perm32(int rho) { const int n = rho >> 4, i = rho & 15; return 8 * (i >> 2) + 4 * n + (i & 3); }
struct Unit { int pm, pn; };
struct Gemm { const bf16_t* A; const bf16_t* Bt; int M, N, K, lda, ldb, T8 = 0; };
struct StaticOrder {
    int nM, nN, nwg, G, c;
    __host__ __device__ void init(int M, int N, int G_, int c_) { nM = M / BM; nN = N / BM; nwg = nM * nN; G = G_; c = c_; }
    __host__ __device__ bool next(int i, Unit& u) const {
        const long L = (long)i * G + c; if (L >= nwg) return false;
        int wgid = (int)L; { const int q = nwg / NXCD, r = nwg % NXCD, xcd = wgid % NXCD, off = wgid / NXCD; wgid = (xcd < r ? xcd * (q + 1) : r * (q + 1) + (xcd - r) * q) + off; }
        const int nig = WGM * nN, gid = wgid / nig, fm = gid * WGM, gsz = (nM - fm) < WGM ? (nM - fm) : WGM;
        u.pm = fm + ((wgid % nig) % gsz); u.pn = (wgid % nig) / gsz; return true;
    }
};
typedef f32x4 Acc[2][2][4][2];

template <bool F8> struct Frag;
template <> struct Frag<false> { bf16x8 k[2]; };
template <> struct Frag<true>  { i32x8 v; };
__device__ __forceinline__ void frag_ld(Frag<false>& d, const PG8_LAS unsigned char* p) { d.k[0] = *(const PG8_LAS bf16x8*)p; d.k[1] = *(const PG8_LAS bf16x8*)(p + 1024); }
__device__ __forceinline__ void frag_ld(Frag<true>& d, const PG8_LAS unsigned char* p) { d.v.lo = *(const PG8_LAS i32x4*)p; d.v.hi = *(const PG8_LAS i32x4*)(p + 1024); }
template <bool ASM> __device__ __forceinline__ void frag_mma(f32x4& c, const Frag<false>& b, const Frag<false>& a) {
    if constexpr (ASM) { asm volatile("v_mfma_f32_16x16x32_bf16 %0, %1, %2, %0" : "+v"(c) : "v"(b.k[0]), "v"(a.k[0])); asm volatile("v_mfma_f32_16x16x32_bf16 %0, %1, %2, %0" : "+v"(c) : "v"(b.k[1]), "v"(a.k[1])); }
    else { c = __builtin_amdgcn_mfma_f32_16x16x32_bf16(b.k[0], a.k[0], c, 0, 0, 0); c = __builtin_amdgcn_mfma_f32_16x16x32_bf16(b.k[1], a.k[1], c, 0, 0, 0); }
}
template <bool ASM> __device__ __forceinline__ void frag_mma(f32x4& c, const Frag<true>& b, const Frag<true>& a) { asm volatile("v_mfma_f32_16x16x128_f8f6f4 %0, %1, %2, %0" : "+v"(c) : "v"(b.v), "v"(a.v)); }
struct NoMid { static constexpr bool ACTIVE = false; __device__ __forceinline__ void operator()(Acc&, const Unit&, int, int, int, int) const {} };
struct OneUnit { int pm, pn; __device__ __forceinline__ bool next(int i, Unit& u) const { if (i != 0) return false; u.pm = pm; u.pn = pn; return true; } };
template <class Epi, class Mid = NoMid, int EREP = 1, class Sched = StaticOrder, int MODE = 0>
__device__ __forceinline__ void gemm_phase(PG8_LAS unsigned char* lds, const Gemm g, const Sched& S, const Epi& E, const Mid& H = Mid()) {
    int tid_ = threadIdx.x; asm volatile("" : "+v"(tid_));
    const int tid = tid_, wid = __builtin_amdgcn_readfirstlane(tid >> 6), lane = tid & 63, wr = wid >> 2, wc = wid & 3, fr = lane & 15, fq = lane >> 4;
    constexpr bool FP8 = MODE != 0;
    const int K = g.K, nt = K / BK, T8 = MODE == 2 ? g.T8 : 0, th = MODE == 2 ? T8 : (nt >> 1);
    unsigned voffA[2], voffB[2];
#pragma unroll
    for (int i = 0; i < 2; ++i) { int R, C; stage_rc(tid * 16 + i * 8192, R, C); const int Rb = Epi::PERM ? ((R & ~31) + perm32(R & 31)) : R; voffA[i] = (unsigned)(R * g.lda + C) * 2u; voffB[i] = (unsigned)(Rb * g.ldb + C) * 2u; }
    const size_t kstep = (size_t)(BK * 2);
    const size_t hstepA = (size_t)HALF * g.lda * 2, hstepB = (size_t)HALF * g.ldb * 2;
    const size_t tstepA = 2 * hstepA, tstepB = 2 * hstepB;
    const unsigned ldsw = (unsigned)wid * 1024u;
    const int aoff = lds_byte(wr * 64 + fr, fq * 8), boff = lds_byte(wc * 32 + fr, fq * 8);
#define PG8_SA(b, h) (((b) * 2 + (h)) * HTB)
#define PG8_SB(b, h) ((4 + (b) * 2 + (h)) * HTB)
#define PG8_STAGE(bufoff, gbase, voff) do { _Pragma("unroll") for (int _i = 0; _i < 2; ++_i) \
        __builtin_amdgcn_global_load_lds((const unsigned*)((const char*)(gbase) + (voff)[_i]), (PG8_LAS unsigned*)(lds + (bufoff) + ldsw + _i * 8192), 16, 0, 0); } while (0)
#define PG8_LDF(dst, i, base) frag_ld(dst[i], lds + (base) + (i) * 2048)
#define PG8_LDA(dst, b, h) do { _Pragma("unroll") for (int m = 0; m < 4; ++m) PG8_LDF(dst, m, PG8_SA(b, h) + aoff); } while (0)
#define PG8_LDB(dst, b, h) do { _Pragma("unroll") for (int n = 0; n < 2; ++n) PG8_LDF(dst, n, PG8_SB(b, h) + boff); } while (0)
#define PG8_MMA(ai, bj, At, Bt) do { __builtin_amdgcn_s_setprio(1); _Pragma("unroll") for (int m = 0; m < 4; ++m) _Pragma("unroll") for (int n = 0; n < 2; ++n) frag_mma<MODE == 2>(acc[ai][bj][m][n], Bt[n], At[m]); \
        __builtin_amdgcn_s_setprio(0); } while (0)
#define PG8_WAIT_V(n) asm volatile("s_waitcnt vmcnt(" #n ")" ::: "memory")
#define PG8_WAIT_L(n) asm volatile("s_waitcnt lgkmcnt(" #n ")" ::: "memory")
#define PG8_BAR __builtin_amdgcn_s_barrier()
#define PG8_SCHED __builtin_amdgcn_sched_barrier(0)
    Unit cur, nxt; int ui = 0;
    if (!S.next(0, cur)) return;
    Acc acc;
#pragma unroll
    for (int a = 0; a < 2; ++a)
#pragma unroll
        for (int b = 0; b < 2; ++b)
#pragma unroll
            for (int m = 0; m < 4; ++m)
#pragma unroll
                for (int n = 0; n < 2; ++n) acc[a][b][m][n] = (f32x4){0.f, 0.f, 0.f, 0.f};
    Frag<false> Ab[4], Bb0[2], Bb1[2]; Frag<true> Af[4], Bf0[2], Bf1[2];
    const char* cA = (const char*)g.A + (size_t)cur.pm * tstepA; const char* cB = (const char*)g.Bt + (size_t)cur.pn * tstepB;
    PG8_STAGE(PG8_SB(0, 0), cB, voffB); PG8_STAGE(PG8_SB(0, 1), cB + hstepB, voffB); PG8_STAGE(PG8_SA(0, 0), cA, voffA); PG8_STAGE(PG8_SA(0, 1), cA + hstepA, voffA);
    if (wr == 1) PG8_BAR;
    PG8_WAIT_V(2); PG8_BAR;
    PG8_STAGE(PG8_SB(1, 0), cB + kstep, voffB); PG8_STAGE(PG8_SA(1, 0), cA + kstep, voffA); PG8_STAGE(PG8_SB(1, 1), cB + hstepB + kstep, voffB);
    PG8_WAIT_V(6); PG8_BAR;
    for (;;) {
        const bool has_next = S.next(ui + 1, nxt);
        const char* nA = has_next ? (const char*)g.A + (size_t)nxt.pm * tstepA : cA; const char* nB = has_next ? (const char*)g.Bt + (size_t)nxt.pn * tstepB : cB;
#define PG8_KOFF(t) ((size_t)(t) * kstep + ((MODE == 2 && (t) >= T8) ? (size_t)T8 * kstep : (size_t)0))
#define PG8_TRIP(At, B0, B1) do { \
            const bool last = (t == nt - 2); \
            const char* a1 = cA + PG8_KOFF(t + 1); \
            const char* a2 = last ? nA : cA + PG8_KOFF(t + 2); const char* b2 = last ? nB : cB + PG8_KOFF(t + 2); \
            const char* a3 = a2 + kstep; const char* b3 = b2 + kstep; \
            if constexpr (Mid::ACTIVE) { if (t == th) { if constexpr (MODE == 2) asm volatile("s_nop 15\n\ts_nop 15" ::: "memory"); H(acc, cur, wr, wc, fr, fq); } } \
            PG8_LDB(B0, 0, 0); PG8_LDB(B1, 0, 1); PG8_SCHED; PG8_LDA(At, 0, 0); PG8_STAGE(PG8_SA(1, 1), a1 + hstepA, voffA); \
            PG8_WAIT_V(8); PG8_WAIT_L(0); PG8_BAR; PG8_MMA(0, 0, At, B0); PG8_MMA(0, 1, At, B1); PG8_BAR; PG8_SCHED; \
            PG8_LDA(At, 0, 1); PG8_STAGE(PG8_SB(0, 0), b2, voffB); PG8_STAGE(PG8_SB(0, 1), b2 + hstepB, voffB); PG8_STAGE(PG8_SA(0, 0), a2, voffA); \
            PG8_WAIT_V(8); PG8_WAIT_L(0); PG8_BAR; PG8_MMA(1, 0, At, B0); PG8_MMA(1, 1, At, B1); PG8_BAR; PG8_SCHED; \
            PG8_LDB(B0, 1, 0); PG8_LDB(B1, 1, 1); PG8_SCHED; PG8_LDA(At, 1, 0); PG8_STAGE(PG8_SA(0, 1), a2 + hstepA, voffA); \
            PG8_WAIT_V(8); PG8_WAIT_L(0); PG8_BAR; PG8_MMA(0, 0, At, B0); PG8_MMA(0, 1, At, B1); PG8_BAR; PG8_SCHED; \
            PG8_LDA(At, 1, 1); PG8_STAGE(PG8_SB(1, 0), b3, voffB); PG8_STAGE(PG8_SB(1, 1), b3 + hstepB, voffB); PG8_STAGE(PG8_SA(1, 0), a3, voffA); \
            PG8_WAIT_V(8); PG8_WAIT_L(0); PG8_BAR; PG8_MMA(1, 0, At, B0); PG8_MMA(1, 1, At, B1); PG8_BAR; PG8_SCHED; \
        } while (0)
        if constexpr (MODE == 2) {
            for (int t = 0; t < T8; t += 2) PG8_TRIP(Af, Bf0, Bf1);
            for (int t = T8; t < nt; t += 2) PG8_TRIP(Ab, Bb0, Bb1);
        } else if constexpr (MODE == 1) {
            for (int t = 0; t < nt; t += 2) PG8_TRIP(Af, Bf0, Bf1);
        } else {
            for (int t = 0; t < nt; t += 2) PG8_TRIP(Ab, Bb0, Bb1);
        }
        if constexpr (FP8) asm volatile("s_nop 15\n\ts_nop 15" ::: "memory");
        if (wr == 0) PG8_BAR;
        E(acc, cur, wr, wc, fr, fq, lds + STAGE_BYTES);
        if constexpr (EREP == 2) { asm volatile("" ::: "memory"); E(acc, cur, wr, wc, fr, fq, lds + STAGE_BYTES); }
        if (!has_next) break;
#pragma unroll
        for (int a = 0; a < 2; ++a)
#pragma unroll
            for (int b = 0; b < 2; ++b)
#pragma unroll
                for (int m = 0; m < 4; ++m)
#pragma unroll
                    for (int n = 0; n < 2; ++n) acc[a][b][m][n] = (f32x4){0.f, 0.f, 0.f, 0.f};
        cur = nxt; cA = nA; cB = nB; ++ui;
        if (wr == 1) PG8_BAR;
    }
    PG8_WAIT_V(0);
    PG8_BAR;
#undef PG8_SA
#undef PG8_SB
#undef PG8_STAGE
#undef PG8_LDA
#undef PG8_LDB
#undef PG8_MMA
#undef PG8_LDF
#undef PG8_TRIP
#undef PG8_KOFF
#undef PG8_WAIT_V
#undef PG8_WAIT_L
#undef PG8_BAR
#undef PG8_SCHED
}
}

struct Ptrs {
    const float *x, *norm1_g, *w_in, *q_norm_g, *k_norm_g, *idx_k_norm_g, *sgu_norm_g, *w_spatial, *b_spatial, *w_proj_a, *w_proj_b, *w_out, *norm2_g, *w_gate, *w_up, *w_down, *rel_bias;
    float* out; unsigned char* ws;
};

__device__ __forceinline__ unsigned pk4_fp8(float a, float b, float c, float d) { int w = __builtin_amdgcn_cvt_pk_fp8_f32(a, b, 0, false); w = __builtin_amdgcn_cvt_pk_fp8_f32(c, d, w, true); return (unsigned)w; }
__device__ __forceinline__ f32x4 ld_bf16x4(const bf16* p) { const u32x2 w = *(const u32x2*)p; f32x4 r; r[0] = bf2f(w.x & 0xffffu); r[1] = bf2f(w.x >> 16); r[2] = bf2f(w.y & 0xffffu); r[3] = bf2f(w.y >> 16); return r; }
__device__ __forceinline__ void store_bf16x4(bf16* p, f32x4 v) { u32x2 w; w.x = pk2(v[0], v[1]); w.y = pk2(v[2], v[3]); *(u32x2*)p = w; }

__device__ __forceinline__ void store_bf16x8(void* p, f32x4 a, f32x4 b) { u32x4 w; w.x = pk2(a[0], a[1]); w.y = pk2(a[2], a[3]); w.z = pk2(b[0], b[1]); w.w = pk2(b[2], b[3]); *(u32x4*)p = w; }
template <int ACT> __device__ __forceinline__ f32x4 act4(f32x4 v) {
    if (ACT == 1) { v[0] = gelu_tanh(v[0]); v[1] = gelu_tanh(v[1]); v[2] = gelu_tanh(v[2]); v[3] = gelu_tanh(v[3]); }
    if (ACT == 2) { v[0] = sigmoidf_(v[0]); v[1] = sigmoidf_(v[1]); v[2] = sigmoidf_(v[2]); v[3] = sigmoidf_(v[3]); }
    return v;
}
template <int ACT> __device__ __forceinline__ void epi_rowmajor(pg8::Acc& acc, char* dt, int rowb, unsigned lo) {
#pragma unroll
    for (int ai = 0; ai < 2; ++ai)
#pragma unroll
        for (int m = 0; m < 4; ++m) { char* dr = dt + (size_t)(ai * 128 + m * 16) * rowb;
#pragma unroll
            for (int bj = 0; bj < 2; ++bj) store_bf16x8(dr + lo + bj * 256, act4<ACT>(acc[ai][bj][m][0]), act4<ACT>(acc[ai][bj][m][1])); }
}
#ifndef FP8_QK
#define FP8_QK 1
#endif
constexpr int P1_NB16 = FP8_QK ? 2048 : 4096, P1_NF8 = FP8_QK ? 8192 : 6144;
constexpr int FFN_T8 = 12, FFN_KF = 128 * FFN_T8;
constexpr float OA_SCALE = 4.0f;
constexpr float GATE_WSCALE = 32.0f;
template <bool F8>
struct EpiIn {
    static constexpr bool PERM = true;
    unsigned char* ws; const float *gq, *gk;
    __device__ __forceinline__ void operator()(pg8::Acc& acc, const pg8::Unit& u, int wr, int wc, int fr, int fq, LAS unsigned char* scr) const {
        constexpr float SC = F8 ? 1.0f / GATE_WSCALE : 1.0f;
        const int rt0 = wr * 64 + fr; const int row0 = u.pm * 256 + rt0;
        if constexpr (F8) if (u.pn < 16) {
            unsigned char* ga_ = ws + WS_GA + (size_t)u.pm * 256 * 2048 + u.pn * 128; unsigned char* gb_ = ws + WS_GB + (size_t)u.pm * 256 * 2048 + u.pn * 128;
            unsigned lo = (unsigned)(rt0 * 2048 + wc * 32 + 8 * fq); asm volatile("" : "+v"(lo));
            constexpr float NS = -LOG2E * SC;
#pragma unroll
            for (int ai = 0; ai < 2; ++ai)
#pragma unroll
                for (int m = 0; m < 4; ++m) {
                    u32x2 wa, wb; wa.x = wa.y = wb.x = wb.y = 0u;
#pragma unroll
                    for (int n = 0; n < 2; ++n)
#pragma unroll
                        for (int e = 0; e < 4; ++e) {
                            const float ea = __builtin_amdgcn_exp2f(acc[ai][0][m][n][e] * NS), eb = __builtin_amdgcn_exp2f(acc[ai][1][m][n][e] * NS);
                            const float sa = 255.0f * __builtin_amdgcn_rcpf(1.0f + ea), sb = fmaxf(255.0f * __builtin_amdgcn_rcpf(1.0f + eb), 1.0f);
                            if (n == 0) { wa.x = __builtin_amdgcn_cvt_pk_u8_f32(sa, e, wa.x); wb.x = __builtin_amdgcn_cvt_pk_u8_f32(sb, e, wb.x); }
                            else        { wa.y = __builtin_amdgcn_cvt_pk_u8_f32(sa, e, wa.y); wb.y = __builtin_amdgcn_cvt_pk_u8_f32(sb, e, wb.y); }
                        }
                    *(u32x2*)(ga_ + (size_t)(ai * 128 + m * 16) * 2048 + lo) = wa; *(u32x2*)(gb_ + (size_t)(ai * 128 + m * 16) * 2048 + lo) = wb;
                }
            return;
        }
        const int pn = F8 ? (u.pn < 20 ? u.pn - 8 : (u.pn < 24 ? u.pn : u.pn - 24)) : (FP8_QK ? u.pn + 12 : (u.pn < 8 ? u.pn : u.pn + 4));
        LAS float* P = (LAS float*)scr;
        if (pn < 8) {
            const bool isq = pn < 4; const float* g = isq ? gq : gk;
            const float osc = (isq ? (0.08838834764831845f * LOG2E) : 1.0f) * SC;
#pragma unroll
            for (int ai = 0; ai < 2; ++ai)
#pragma unroll
                for (int m = 0; m < 4; ++m)
#pragma unroll
                    for (int bj = 0; bj < 2; ++bj) {
                        float s = 0.f;
#pragma unroll
                        for (int n = 0; n < 2; ++n) { const f32x4 v = acc[ai][bj][m][n]; s += (v[0] * v[0] + v[1] * v[1]) + (v[2] * v[2] + v[3] * v[3]); }
                        s += __shfl_xor(s, 16); s += __shfl_xor(s, 32);
                        if (fq == 0) P[(ai * 128 + rt0 + m * 16) * 8 + bj * 4 + wc] = s;
                    }
            LDS_BARRIER();
            f32x4 gv[2];
#pragma unroll
            for (int n = 0; n < 2; ++n) gv[n] = *(const f32x4*)(g + wc * 32 + 8 * fq + 4 * n) * osc;
            char* dt = (char*)ws + (isq ? WS_Q : WS_K) + ((size_t)u.pm * 256 * 1024 + (pn & 3) * 256) * 2;
            unsigned lo = (unsigned)(rt0 * 1024 + wc * 32 + 8 * fq) * 2u; asm volatile("" : "+v"(lo));
#pragma unroll
            for (int ai = 0; ai < 2; ++ai)
#pragma unroll
                for (int m = 0; m < 4; ++m) { char* dr = dt + (size_t)(ai * 128 + m * 16) * 2048;
#pragma unroll
                    for (int bj = 0; bj < 2; ++bj) {
                        const f32x4 pp = *(const LAS f32x4*)(P + (ai * 128 + rt0 + m * 16) * 8 + bj * 4);
                        const float rs = __builtin_amdgcn_rsqf(((pp[0] + pp[1]) + (pp[2] + pp[3])) * (SC * SC / 128.0f) + EPS);
                        store_bf16x8(dr + lo + bj * 256, acc[ai][bj][m][0] * rs * gv[0], acc[ai][bj][m][1] * rs * gv[1]);
                    } }
        } else if (pn < 12 || (pn >= 20 && pn < 24)) {
            const bool isv = pn < 12; bf16* dst = (bf16*)(ws + (isv ? WS_VT : WS_VBT)); const int chbase = ((isv ? pn - 8 : pn - 20)) * 256; float* rowsq_vb = (float*)(ws + WS_CTL + CTL_ROWSQ_VB);
            const int frp = isv ? (8 * ((fr >> 2) & 1) + 4 * (fr >> 3) + (fr & 3)) : fr;
            const int b = u.pm >> 3, s0 = (u.pm & 7) * 256 + wr * 64 + frp;
#pragma unroll
            for (int ai = 0; ai < 2; ++ai)
#pragma unroll
                for (int m = 0; m < 4; ++m) {
                    float ss = 0.f;
#pragma unroll
                    for (int bj = 0; bj < 2; ++bj)
#pragma unroll
                        for (int n = 0; n < 2; ++n) {
                            f32x4 v = acc[ai][bj][m][n];
                            if constexpr (F8) v = v * SC;
                            if (!isv) { v = act4<1>(v); ss += (v[0] * v[0] + v[1] * v[1]) + (v[2] * v[2] + v[3] * v[3]); }
                            const int ch = chbase + bj * 128 + wc * 32 + 8 * fq + 4 * n;
                            bf16* p = dst + ((size_t)(b * 1024 + ch)) * 2048 + s0 + ai * 128 + m * 16;
                            const unsigned w01 = pk2(v[0], v[1]), w23 = pk2(v[2], v[3]);
                            p[0] = (bf16)(w01 & 0xffffu); p[2048] = (bf16)(w01 >> 16); p[4096] = (bf16)(w23 & 0xffffu); p[6144] = (bf16)(w23 >> 16);
                        }
                    if (!isv) { ss += __shfl_xor(ss, 16); ss += __shfl_xor(ss, 32); if (fq == 0) unsafeAtomicAdd(rowsq_vb + row0 + ai * 128 + m * 16, ss); }
                }
        } else if constexpr (!F8) {
            const size_t doff = pn < 16 ? WS_QI : WS_U; const int colbase = (pn & 3) * 256;
            char* dt = (char*)ws + doff + ((size_t)u.pm * 256 * 1024 + colbase) * 2;
            unsigned lo = (unsigned)(rt0 * 1024 + wc * 32 + 8 * fq) * 2u; asm volatile("" : "+v"(lo));
            if (pn < 16) epi_rowmajor<0>(acc, dt, 2048, lo); else epi_rowmajor<1>(acc, dt, 2048, lo);
        }
    }
};

__device__ __forceinline__ void ld_bf16x8(const void* p, f32x4& a, f32x4& b) { const u32x4 w = *(const u32x4*)p; a[0] = bf2f(w.x & 0xffffu); a[1] = bf2f(w.x >> 16); a[2] = bf2f(w.y & 0xffffu); a[3] = bf2f(w.y >> 16); b[0] = bf2f(w.z & 0xffffu); b[1] = bf2f(w.z >> 16); b[2] = bf2f(w.w & 0xffffu); b[3] = bf2f(w.w >> 16); }
struct MidScale {
    static constexpr bool ACTIVE = true; float sc;
    __device__ __forceinline__ void operator()(pg8::Acc& acc, const pg8::Unit&, int, int, int, int) const {
#pragma unroll
        for (int ai = 0; ai < 2; ++ai)
#pragma unroll
            for (int bj = 0; bj < 2; ++bj)
#pragma unroll
                for (int m = 0; m < 4; ++m)
#pragma unroll
                    for (int n = 0; n < 2; ++n) acc[ai][bj][m][n] *= sc;
    }
};
__device__ __forceinline__ void ld_u8x8(const void* p, f32x4& a, f32x4& b) { const u32x2 w = *(const u32x2*)p;
    a[0] = (float)(w.x & 0xffu); a[1] = (float)((w.x >> 8) & 0xffu); a[2] = (float)((w.x >> 16) & 0xffu); a[3] = (float)(w.x >> 24);
    b[0] = (float)(w.y & 0xffu); b[1] = (float)((w.y >> 8) & 0xffu); b[2] = (float)((w.y >> 16) & 0xffu); b[3] = (float)(w.y >> 24); }
struct MidMerge {
    static constexpr bool ACTIVE = true;
    const unsigned char *GA, *GB; float sc;
    __device__ __forceinline__ void operator()(pg8::Acc& acc, const pg8::Unit& u, int wr, int wc, int fr, int fq) const {
        unsigned lane_off = (unsigned)((wr * 64 + fr) * 2048 + wc * 32 + fq * 8); asm volatile("" : "+v"(lane_off));
        const size_t tile = (size_t)u.pm * 256 * 2048 + (size_t)u.pn * 256;
        const unsigned char* ga_t = GA + tile; const unsigned char* gb_t = GB + tile;
#pragma unroll
        for (int ai = 0; ai < 2; ++ai)
#pragma unroll
            for (int m = 0; m < 4; ++m) {
                const unsigned char* ga_r = ga_t + (size_t)(ai * 128 + m * 16) * 2048; const unsigned char* gb_r = gb_t + (size_t)(ai * 128 + m * 16) * 2048;
#pragma unroll
                for (int bj = 0; bj < 2; ++bj) {
                    f32x4 a0, a1, b0, b1; ld_u8x8(ga_r + lane_off + bj * 128, a0, a1); ld_u8x8(gb_r + lane_off + bj * 128, b0, b1);
#pragma unroll
                    for (int e = 0; e < 4; ++e) { acc[ai][bj][m][0][e] *= a0[e] * __builtin_amdgcn_rcpf(b0[e]) * sc; acc[ai][bj][m][1][e] *= a1[e] * __builtin_amdgcn_rcpf(b1[e]) * sc; }
                }
                asm volatile("" ::: "memory");
            }
    }
};
struct EpiMerge {
    static constexpr bool PERM = true;
    const unsigned char* GB; bf16* MERGED;
    __device__ __forceinline__ void operator()(pg8::Acc& acc, const pg8::Unit& u, int wr, int wc, int fr, int fq, LAS unsigned char*) const {
        unsigned lane_off = (unsigned)((wr * 64 + fr) * 2048 + wc * 32 + fq * 8) * 2u; asm volatile("" : "+v"(lane_off));
        const size_t tile = ((size_t)u.pm * 256 * 2048 + (size_t)u.pn * 256) * 2;
        const unsigned char* gb_t = GB + (tile >> 1); char* mt = (char*)MERGED + tile;
#pragma unroll
        for (int ai = 0; ai < 2; ++ai)
#pragma unroll
            for (int m = 0; m < 4; ++m) {
                const unsigned char* gb_r = gb_t + (size_t)(ai * 128 + m * 16) * 2048; char* mr = mt + (size_t)(ai * 128 + m * 16) * 4096;
#pragma unroll
                for (int bj = 0; bj < 2; ++bj) { f32x4 gb0, gb1; ld_u8x8(gb_r + (lane_off >> 1) + bj * 128, gb0, gb1); store_bf16x8(mr + lane_off + bj * 256, acc[ai][bj][m][0] * (gb0 * (1.0f / 255.0f)), acc[ai][bj][m][1] * (gb1 * (1.0f / 255.0f))); }
            }
    }
};
struct EpiOut {
    static constexpr bool PERM = false;
    const float* X; bf16* X1B; float* rowsq2;
    __device__ __forceinline__ void operator()(pg8::Acc& acc, const pg8::Unit& u, int wr, int wc, int fr, int fq, LAS unsigned char*) const {
        const int row0 = u.pm * 256 + wr * 64 + fr;
        unsigned lo = (unsigned)((wr * 64 + fr) * 2048 + wc * 32 + fq * 4) * 4u; asm volatile("" : "+v"(lo));
        const size_t tile = ((size_t)u.pm * 256 * 2048 + (size_t)u.pn * 256) * 4;
        const char* xt = (const char*)X + tile; char* bt = (char*)X1B + tile / 2;
#pragma unroll
        for (int ai = 0; ai < 2; ++ai)
#pragma unroll
            for (int m = 0; m < 4; ++m) {
                const size_t ro = (size_t)(ai * 128 + m * 16) * 8192;
                float ss = 0.f;
#pragma unroll
                for (int bj = 0; bj < 2; ++bj)
#pragma unroll
                    for (int n = 0; n < 2; ++n) {
                        const f32x4 v = __builtin_nontemporal_load((const f32x4*)(xt + ro + lo + bj * 512 + n * 64)) + acc[ai][bj][m][n];
                        ss += (v[0] * v[0] + v[1] * v[1]) + (v[2] * v[2] + v[3] * v[3]);
                        store_bf16x4((bf16*)(bt + ro / 2 + (lo >> 1) + bj * 256 + n * 32), v);
                    }
                ss += __shfl_xor(ss, 16); ss += __shfl_xor(ss, 32);
                if (fq == 0) unsafeAtomicAdd(rowsq2 + row0 + ai * 128 + m * 16, ss);
            }
    }
};
__device__ __forceinline__ void ffn_up_store(pg8::Acc& acc, const float* rowsq2, bf16* ACT, int pm, int pnc, int wr, int wc, int fr, int fq) {
    const int row0 = pm * 256 + wr * 64 + fr;
    unsigned lane_off = (unsigned)((wr * 64 + fr) * DFF + wc * 32 + fq * 8) * 2u; asm volatile("" : "+v"(lane_off));
    const bool f8 = pnc < FFN_T8;
    char* at = (char*)ACT + (size_t)pm * 256 * DFF * 2 + (size_t)pnc * 128 * (f8 ? 1 : 2);
    if (f8) { lane_off = (unsigned)((wr * 64 + fr) * DFF * 2 + wc * 32 + fq * 8); asm volatile("" : "+v"(lane_off)); }
#pragma unroll
    for (int ai = 0; ai < 2; ++ai)
#pragma unroll
        for (int m = 0; m < 4; ++m) {
            const int row = row0 + ai * 128 + m * 16;
            const float rs = __builtin_amdgcn_rsqf(rowsq2[row] * (1.0f / (2048.0f * NREP(5))) + EPS);
            f32x4 o[2];
#pragma unroll
            for (int n = 0; n < 2; ++n) {
                const f32x4 gt = acc[ai][0][m][n] * rs, up = acc[ai][1][m][n] * rs;
#pragma unroll
                for (int e = 0; e < 4; ++e) o[n][e] = gt[e] * sigmoidf_(gt[e]) * up[e];
            }
            if (f8) { u32x2 w; w.x = pk4_fp8(o[0][0], o[0][1], o[0][2], o[0][3]); w.y = pk4_fp8(o[1][0], o[1][1], o[1][2], o[1][3]); *(u32x2*)(at + (size_t)(ai * 128 + m * 16) * (DFF * 2) + lane_off) = w; }
            else store_bf16x8(at + (size_t)(ai * 128 + m * 16) * (DFF * 2) + lane_off, o[0], o[1]);
        }
}
struct EpiFfnUp {
    static constexpr bool PERM = true;
    const float* rowsq2; bf16* ACT; int pn_off;
    __device__ __forceinline__ void operator()(pg8::Acc& acc, const pg8::Unit& u, int wr, int wc, int fr, int fq, LAS unsigned char*) const { ffn_up_store(acc, rowsq2, ACT, u.pm, u.pn + pn_off, wr, wc, fr, fq); }
};
struct EpiFfnUpPair {
    static constexpr bool PERM = true;
    const float* rowsq2; bf16* ACT; int pn_off; int half; float* slab; unsigned* flag;
    __device__ __forceinline__ void operator()(pg8::Acc& acc, const pg8::Unit& u, int wr, int wc, int fr, int fq, LAS unsigned char*) const {
        const int tid = threadIdx.x;
        unsigned so = (unsigned)tid * 16u; asm volatile("" : "+v"(so));
        char* sb = (char*)slab;
        if (half) {
#pragma unroll
            for (int ai = 0; ai < 2; ++ai)
#pragma unroll
                for (int bj = 0; bj < 2; ++bj)
#pragma unroll
                    for (int m = 0; m < 4; ++m)
#pragma unroll
                        for (int n = 0; n < 2; ++n) *(f32x4*)(sb + (size_t)((((ai * 2 + bj) * 4 + m) * 2 + n) * 8192) + so) = acc[ai][bj][m][n];
            asm volatile("s_waitcnt vmcnt(0)" ::: "memory");
            __builtin_amdgcn_s_barrier(); asm volatile("" ::: "memory");
            if (tid == 0) { __builtin_amdgcn_fence(__ATOMIC_RELEASE, "agent"); asm volatile("s_waitcnt vmcnt(0)" ::: "memory"); __hip_atomic_store(flag, 1u, __ATOMIC_RELAXED, __HIP_MEMORY_SCOPE_AGENT); }
        } else {
            if (tid < 64) {
                unsigned spins = 0;
                while ((unsigned)__builtin_amdgcn_readfirstlane(__hip_atomic_load(flag, __ATOMIC_RELAXED, __HIP_MEMORY_SCOPE_AGENT)) == 0u) { __builtin_amdgcn_s_sleep(2); if (++spins > (1u << 24)) break; }
                __builtin_amdgcn_fence(__ATOMIC_ACQUIRE, "agent");
                asm volatile("s_waitcnt vmcnt(0)" ::: "memory");
            }
            asm volatile("" ::: "memory"); __builtin_amdgcn_s_barrier(); asm volatile("" ::: "memory");
#pragma unroll
            for (int ai = 0; ai < 2; ++ai)
#pragma unroll
                for (int bj = 0; bj < 2; ++bj)
#pragma unroll
                    for (int m = 0; m < 4; ++m) {
#pragma unroll
                        for (int n = 0; n < 2; ++n) acc[ai][bj][m][n] += *(const f32x4*)(sb + (size_t)((((ai * 2 + bj) * 4 + m) * 2 + n) * 8192) + so);
                        asm volatile("" ::: "memory");
                    }
            ffn_up_store(acc, rowsq2, ACT, u.pm, u.pn + pn_off, wr, wc, fr, fq);
        }
    }
};
struct EpiFfnDown {
    static constexpr bool PERM = false;
    const bf16* X1B; float* OUT;
    __device__ __forceinline__ void operator()(pg8::Acc& acc, const pg8::Unit& u, int wr, int wc, int fr, int fq, LAS unsigned char*) const {
        unsigned lo = (unsigned)((wr * 64 + fr) * 2048 + wc * 32 + fq * 4) * 4u; asm volatile("" : "+v"(lo));
        const size_t tile = ((size_t)u.pm * 256 * 2048 + (size_t)u.pn * 256) * 4;
        const char* st = (const char*)X1B + tile / 2; char* ot = (char*)OUT + tile;
#pragma unroll
        for (int ai = 0; ai < 2; ++ai)
#pragma unroll
            for (int m = 0; m < 4; ++m) {
                const size_t ro = (size_t)(ai * 128 + m * 16) * 8192;
#pragma unroll
                for (int bj = 0; bj < 2; ++bj)
#pragma unroll
                    for (int n = 0; n < 2; ++n) __builtin_nontemporal_store(ld_bf16x4((const bf16*)(st + ro / 2 + (lo >> 1) + bj * 256 + n * 32)) + acc[ai][bj][m][n], (f32x4*)(ot + ro + lo + bj * 512 + n * 64));
            }
    }
};

__device__ __forceinline__ void kiwi_issue(const bf16* H1r, const bf16* Wr, int kc, LAS unsigned char* buf, int wave, int lane) {
    const int sub = lane >> 4, pos = lane & 15;
#pragma unroll
    for (int j = 0; j < 4; ++j) {
        const int rowi = 4 * (wave + 8 * j) + sub;
        const bf16* base = (j == 0) ? H1r + (size_t)rowi * 2048 : Wr + (size_t)(rowi - 32) * 2048;
        __builtin_amdgcn_global_load_lds((const unsigned*)(base + kc * 128 + ((pos ^ (rowi & 15)) * 8)), (LAS unsigned*)(buf + (wave + 8 * j) * 1024), 16, 0, 0);
    }
}
__device__ __forceinline__ void kiwi_unit(int rb, const bf16* H1, const bf16* WIN, const float* gki, bf16* KI, float* WI, LAS unsigned char* lds, int wave, int lane) {
    const int r = lane & 31, hs = lane >> 5;
    const bf16* H1r = H1 + (size_t)(rb * 32) * 2048; const bf16* Wr = WIN + (size_t)10240 * 2048;
    f32x16 acc[3];
#pragma unroll
    for (int cb = 0; cb < 3; ++cb)
#pragma unroll
        for (int i = 0; i < 16; ++i) acc[cb][i] = 0.f;
    kiwi_issue(H1r, Wr, 0, lds, wave, lane); kiwi_issue(H1r, Wr, 1, lds + 32768, wave, lane); kiwi_issue(H1r, Wr, 2, lds + 65536, wave, lane);
    asm volatile("s_waitcnt vmcnt(8)" ::: "memory"); LDS_BARRIER();
    const unsigned fbase = (unsigned)(r * 256 + (((2 * wave + hs) ^ (r & 15)) << 4));
#pragma unroll 1
    for (int kc = 0; kc < 16; ++kc) {
        LAS unsigned char* cur = lds + (kc & 3) * 32768;
        if (kc + 3 < 16) kiwi_issue(H1r, Wr, kc + 3, lds + ((kc + 3) & 3) * 32768, wave, lane);
        const bf16x8 a = *(const LAS bf16x8*)(cur + fbase);
#pragma unroll
        for (int cb = 0; cb < 3; ++cb) { const bf16x8 bfr = *(const LAS bf16x8*)(cur + (32 + 32 * cb) * 256 + fbase); acc[cb] = __builtin_amdgcn_mfma_f32_32x32x16_bf16(a, bfr, acc[cb], 0, 0, 0); }
        if (kc + 3 < 16) asm volatile("s_waitcnt vmcnt(8)" ::: "memory"); else if (kc + 2 < 16) asm volatile("s_waitcnt vmcnt(4)" ::: "memory"); else asm volatile("s_waitcnt vmcnt(0)" ::: "memory");
        LDS_BARRIER();
    }
    LAS float* part = (LAS float*)lds;
#pragma unroll
    for (int cb = 0; cb < 3; ++cb)
#pragma unroll
        for (int i = 0; i < 16; ++i) part[(wave * 48 + cb * 16 + i) * 64 + lane] = acc[cb][i];
    LDS_BARRIER();
#pragma unroll
    for (int ii = 0; ii < 2; ++ii) {
        const int i = 2 * wave + ii; float v[3];
#pragma unroll
        for (int cb = 0; cb < 3; ++cb) { float s = 0.f;
#pragma unroll
            for (int w = 0; w < 8; ++w) s += part[(w * 48 + cb * 16 + i) * 64 + lane];
            v[cb] = s; }
        float ss = v[0] * v[0] + v[1] * v[1];
        ss += __shfl_xor(ss, 1); ss += __shfl_xor(ss, 2); ss += __shfl_xor(ss, 4); ss += __shfl_xor(ss, 8); ss += __shfl_xor(ss, 16);
        const float rs = 1.0f / sqrtf(ss * (1.0f / 64.0f) + EPS);
        const size_t row = (size_t)(rb * 32 + rowoff16(i) + 4 * hs);
        KI[row * 64 + r] = (bf16)f2bf(v[0] * rs * gki[r]); KI[row * 64 + 32 + r] = (bf16)f2bf(v[1] * rs * gki[32 + r]);
        if (r < 16) WI[row * 16 + r] = v[2];
    }
    LDS_BARRIER();
}

constexpr int W8_FLAG = 0x10000;
__device__ __forceinline__ int rowmap(int mode, int n) {
    if (mode == 1) {
        if (n < 2048) return FP8_QK ? (W8_FLAG | (6144 + n)) : n;
        if (n < 3072) return W8_FLAG | (4096 + (n - 2048));
        if (n < 4096) return (FP8_QK ? 0 : 2048) + (n - 3072);
        if (n < 4160) return 10240 + (n - 4096); if (n < 4176) return 10240 + 64 + (n - 4160);
        if (n < 5200) return (FP8_QK ? 1024 : 3072) + (n - 4176);
        if (n < 6224) return W8_FLAG | (5120 + (n - 5200));
        const int j = n - 6224, gb = j >> 11, c = j & 2047; return W8_FLAG | ((c >> 7) * 256 + gb * 128 + (c & 127)); }
    if (mode == 4) return W8_FLAG | n;
    if (mode == 2) return (n >> 7) * 256 + (n & 127);
    if (mode == 3) return (n >> 7) * 256 + 128 + (n & 127);
    return n;
}
constexpr int P0_PITCH = 68, P0_WAVE_BYTES = 64 * P0_PITCH * 4;
__device__ __forceinline__ void p0_transpose_item(const float* W, int N, bf16* WT, int ldk, int koff, int mode, const float* kscale, LAS float* scr, int item, int lane, unsigned char* W8 = nullptr, int pitch8 = 2048) {
    const int nblk = (N + 63) / 64, kb = item / nblk, nb = item % nblk, k0 = 64 * kb, n0 = 64 * nb;
    const int kr = lane >> 4, nc = lane & 15; const bool ok = (n0 + 4 * nc) < N;
    const float* wp = W + (size_t)(k0 + kr) * N + n0 + 4 * nc;
    f32x4 v[16];
#pragma unroll
    for (int i = 0; i < 16; ++i) v[i] = ok ? __builtin_nontemporal_load((const f32x4*)(wp + (size_t)(4 * i) * N)) : (f32x4){0.f, 0.f, 0.f, 0.f};
#pragma unroll
    for (int i = 0; i < 16; ++i) *(LAS f32x4*)(scr + (4 * i + kr) * P0_PITCH + 4 * nc) = v[i];
    LDS_WAIT(); asm volatile("" ::: "memory");
    const int c = lane & 7, ng = lane >> 3;
    f32x4 ks0 = (f32x4){1.f, 1.f, 1.f, 1.f}, ks1 = ks0;
    if (kscale) { ks0 = *(const f32x4*)(kscale + k0 + 8 * c); ks1 = *(const f32x4*)(kscale + k0 + 8 * c + 4); }
#pragma unroll
    for (int j = 0; j < 2; ++j) {
        const int nn = 4 * (ng + 8 * j);
        f32x4 r[8];
#pragma unroll
        for (int kk = 0; kk < 8; ++kk) r[kk] = *(const LAS f32x4*)(scr + (8 * c + kk) * P0_PITCH + nn) * (kk < 4 ? ks0[kk] : ks1[kk - 4]);
        const int rm = (n0 + nn < N) ? rowmap(mode, n0 + nn) : 0;
        if (((mode == 1 || mode == 4) && (rm & W8_FLAG)) || (mode == 5 && k0 < FFN_KF)) {
            {
                unsigned char* op8 = W8 + (size_t)(rm & (W8_FLAG - 1)) * pitch8 + k0 + 8 * c;
#pragma unroll
                for (int e = 0; e < 4; ++e) { u32x2 o; o.x = pk4_fp8(r[0][e] * GATE_WSCALE, r[1][e] * GATE_WSCALE, r[2][e] * GATE_WSCALE, r[3][e] * GATE_WSCALE); o.y = pk4_fp8(r[4][e] * GATE_WSCALE, r[5][e] * GATE_WSCALE, r[6][e] * GATE_WSCALE, r[7][e] * GATE_WSCALE); __builtin_nontemporal_store(o, (u32x2*)(op8 + (size_t)e * pitch8)); }
            }
        } else if (n0 + nn < N) {
            bf16* op = WT + (size_t)rm * ldk + koff + k0 + 8 * c;
#pragma unroll
            for (int e = 0; e < 4; ++e) { u32x4 o; o.x = pk2(r[0][e], r[1][e]); o.y = pk2(r[2][e], r[3][e]); o.z = pk2(r[4][e], r[5][e]); o.w = pk2(r[6][e], r[7][e]); __builtin_nontemporal_store(o, (u32x4*)(op + (size_t)e * ldk)); }
        }
    }
    LDS_WAIT(); asm volatile("" ::: "memory");
}
__device__ __forceinline__ void p0_prologue(const Ptrs& P, LAS unsigned char* lds, int vcu, int G) {
    const int tid = threadIdx.x, lane = tid & 63, wave = __builtin_amdgcn_readfirstlane(tid >> 6);
    unsigned char* ws = P.ws;
    LAS float* scr = (LAS float*)(lds + wave * P0_WAVE_BYTES);
    const int gw = vcu * 8 + wave, NGW = G * 8;
    bf16* WIN = (bf16*)(ws + WS_WIN); bf16* WAB = (bf16*)(ws + WS_WAB); bf16* WOUT = (bf16*)(ws + WS_WOUT); bf16* W1 = (bf16*)(ws + WS_W1); bf16* W2 = (bf16*)(ws + WS_W2);
    unsigned char* H1F8 = (unsigned char*)P.out + OUT_H1F8; unsigned char* W8 = (unsigned char*)P.out + OUT_W8;
    constexpr int I_IN = 32 * 162, I_A = 16 * 32, I_O = 32 * 32, I_G = 32 * 88, I_D = 88 * 32;
    constexpr int NITEMS = I_IN + 2 * I_A + I_O + 2 * I_G + I_D;
    for (int it = gw; it < NITEMS; it += NGW) {
        int r = it;
        if (r < I_IN) { p0_transpose_item(P.w_in, DIN, WIN, 2048, 0, 1, nullptr, scr, r, lane, W8); continue; } r -= I_IN;
        if (r < I_A) { p0_transpose_item(P.w_proj_a, 2048, WAB, 2048, 0, 4, nullptr, scr, r, lane, (unsigned char*)WAB, 4096); continue; } r -= I_A;
        if (r < I_A) { p0_transpose_item(P.w_proj_b, 2048, WAB, 2048, 1024, 0, nullptr, scr, r, lane); continue; } r -= I_A;
        if (r < I_O) { p0_transpose_item(P.w_out, 2048, WOUT, 2048, 0, 0, nullptr, scr, r, lane); continue; } r -= I_O;
        if (r < I_G) { p0_transpose_item(P.w_gate, DFF, W1, 2048, 0, 2, P.norm2_g, scr, r, lane); continue; } r -= I_G;
        if (r < I_G) { p0_transpose_item(P.w_up, DFF, W1, 2048, 0, 3, P.norm2_g, scr, r, lane); continue; } r -= I_G;
        p0_transpose_item(P.w_down, 2048, W2, DFF, 0, 5, nullptr, scr, r, lane, (unsigned char*)W2, DFF * 2);
    }
    for (int rr = DIN + gw; rr < NIN; rr += NGW) { u32x4* p = (u32x4*)(WIN + (size_t)rr * 2048); for (int j = lane; j < 256; j += 64) p[j] = (u32x4){0u, 0u, 0u, 0u}; }
    bf16* H1 = (bf16*)(ws + WS_H1);
    for (int m = gw; m < MTOK; m += NGW) {
        const f32x4* xr = (const f32x4*)(P.x + (size_t)m * DM) + lane; const f32x4* gr = (const f32x4*)P.norm1_g + lane;
        f32x4 v[8]; float s = 0.f;
#pragma unroll
        for (int j = 0; j < 8; ++j) { v[j] = __builtin_nontemporal_load(xr + 64 * j); s += (v[j][0] * v[j][0] + v[j][1] * v[j][1]) + (v[j][2] * v[j][2] + v[j][3] * v[j][3]); }
        const float rs = 1.0f / sqrtf(wave_sum(s) * (1.0f / DM) + EPS);
        u32x2* o = (u32x2*)(H1 + (size_t)m * DM) + lane; unsigned* o8 = (unsigned*)(H1F8 + (size_t)m * DM) + lane;
#pragma unroll
        for (int j = 0; j < 8; ++j) { const f32x4 gg = gr[64 * j]; const float h0 = v[j][0] * rs * gg[0], h1 = v[j][1] * rs * gg[1], h2 = v[j][2] * rs * gg[2], h3 = v[j][3] * rs * gg[3];
            u32x2 w; w.x = pk2(h0, h1); w.y = pk2(h2, h3); __builtin_nontemporal_store(w, o + 64 * j); __builtin_nontemporal_store(pk4_fp8(h0, h1, h2, h3), o8 + 64 * j); }
    }
    const int gt = vcu * 512 + tid, NGT = G * 512;
    bf16* WSP = (bf16*)(ws + WS_WSP); float* TBL = (float*)(ws + WS_TBL);
    for (int i = gt; i < NG * CHUNK * CHUNK; i += NGT) { const int s = i & 127, t = (i >> 7) & 127; WSP[i] = (bf16)f2bf(s <= t ? P.w_spatial[i] : 0.f); }
    for (int i = gt; i < NH * 132; i += NGT) { const int h = i / 132, d = i % 132; const int bk = d < 128 ? (int)T5_BUCKET[d] : 31; TBL[i] = P.rel_bias[bk * NH + h] * LOG2E; }
}

constexpr int IDX_ROW = 2048, IDX_WAVE_BYTES = 2 * IDX_ROW * 4;
__device__ __forceinline__ float half_min(float v) { v = fminf(v, __shfl_xor(v, 1)); v = fminf(v, __shfl_xor(v, 2)); v = fminf(v, __shfl_xor(v, 4)); v = fminf(v, __shfl_xor(v, 8)); return fminf(v, __shfl_xor(v, 16)); }
__device__ __forceinline__ float half_max(float v) { v = fmaxf(v, __shfl_xor(v, 1)); v = fmaxf(v, __shfl_xor(v, 2)); v = fmaxf(v, __shfl_xor(v, 4)); v = fmaxf(v, __shfl_xor(v, 8)); return fmaxf(v, __shfl_xor(v, 16)); }
__device__ __forceinline__ void indexer_unit(int b, int tb, const bf16* QI, const bf16* KI, const float* WI, unsigned* MASK, LAS unsigned char* lds, int wave, int lane, int mode = 0) {
    const int r = lane & 31, hs = lane >> 5;
    const int qa = tb * 16 + 2 * wave;
    const int cmax = (qa + 1) >> 5;
    const int aq = qa + ((r >> 2) & 1), ah = (r & 3) + 4 * (r >> 3);
    const bf16* ap = QI + ((size_t)(b * SEQ + aq)) * 1024 + ah * 64 + 8 * hs;
    bf16x8 af[4];
#pragma unroll
    for (int kk = 0; kk < 4; ++kk) af[kk] = *(const bf16x8*)(ap + 16 * kk);
    const int myq = qa + hs;
    const f32x4* wp = (const f32x4*)(WI + (size_t)(b * SEQ + myq) * 16);
    float wg[16];
#pragma unroll
    for (int j = 0; j < 4; ++j) { const f32x4 t = wp[j]; wg[4 * j] = t[0]; wg[4 * j + 1] = t[1]; wg[4 * j + 2] = t[2]; wg[4 * j + 3] = t[3]; }
    const bf16* kib = KI + (size_t)(b * SEQ) * 64;
    const unsigned kio = (unsigned)((8 * wave + (lane >> 3)) * 64 + (((lane & 7) ^ (((8 * wave + (lane >> 3)) >> 1) & 7)) * 8)) * 2u;
#define IDX_ISSUE(ch, buf) do { _Pragma("unroll") for (int _j = 0; _j < 4; ++_j) \
        __builtin_amdgcn_global_load_lds((const unsigned*)((const char*)kib + (size_t)(ch) * 32768 + (size_t)_j * 8192 + kio), (LAS unsigned*)((buf) + (wave + 8 * _j) * 1024), 16, 0, 0); } while (0)
    const unsigned fb = (unsigned)(r * 128 + ((((r >> 1) & 7) ^ hs) << 4));
    float u[64];
    float mn4[4] = {INFINITY, INFINITY, INFINITY, INFINITY}, mx4[4] = {-INFINITY, -INFINITY, -INFINITY, -INFINITY};
    if (mode != 2) {
        IDX_ISSUE(0, lds);
        if (8 <= cmax) { IDX_ISSUE(1, lds + 32768); asm volatile("s_waitcnt vmcnt(4)" ::: "memory"); } else asm volatile("s_waitcnt vmcnt(0)" ::: "memory");
        LDS_BARRIER();
    }
#pragma unroll
    for (int ch = 0; ch < 8; ++ch) {
        if (8 * ch <= cmax && mode != 2) {
            LAS unsigned char* cur = lds + (ch % 3) * 32768;
            const bool ahead = (ch + 2 < 8) && (8 * (ch + 2) <= cmax);
            if (ahead) IDX_ISSUE(ch + 2, lds + ((ch + 2) % 3) * 32768);
#pragma unroll
            for (int j = 0; j < 8; ++j) {
                const int c = 8 * ch + j;
                {
                    f32x16 acc;
#pragma unroll
                    for (int i = 0; i < 16; ++i) acc[i] = 0.f;
#pragma unroll
                    for (int kk = 0; kk < 4; ++kk) { const bf16x8 kf = *(const LAS bf16x8*)(cur + j * 4096 + (fb ^ (unsigned)(kk << 5))); acc = __builtin_amdgcn_mfma_f32_32x32x16_bf16(af[kk], kf, acc, 0, 0, 0); }
                    float s4[4] = {0.f, 0.f, 0.f, 0.f};
#pragma unroll
                    for (int i = 0; i < 16; ++i) { const float av = acc[i]; const int rb = __float_as_int(av); s4[i & 3] += wg[i] * __int_as_float(rb > 0 ? rb : 0); }
                    const float sv = (s4[0] + s4[1]) + (s4[2] + s4[3]); const bool ok = (32 * c + r <= myq);
                    u[c] = ok ? sv : -INFINITY; mx4[j & 3] = fmaxf(mx4[j & 3], ok ? sv : -INFINITY); mn4[j & 3] = fminf(mn4[j & 3], ok ? sv : INFINITY);
                }
            }
            if (ahead) asm volatile("s_waitcnt vmcnt(4)" ::: "memory"); else asm volatile("s_waitcnt vmcnt(0)" ::: "memory");
            LDS_BARRIER();
        } else {
#pragma unroll
            for (int j = 0; j < 8; ++j) u[8 * ch + j] = -INFINITY;
        }
    }
#undef IDX_ISSUE
    if (mode == 1) return;
    float T = -3.0e38f;
    if (qa >= 256) {
        float L = half_min(fminf(fminf(mn4[0], mn4[1]), fminf(mn4[2], mn4[3]))), H = half_max(fmaxf(fmaxf(mx4[0], mx4[1]), fmaxf(mx4[2], mx4[3])));
        bool done0 = false, done1 = false;
        for (int it = 0; it < 48; ++it) {
            const float mid = 0.5f * L + 0.5f * H;
            int cn4[4] = {0, 0, 0, 0};
#pragma unroll
            for (int g = 0; g < 8; ++g)
                if (8 * g <= cmax) {
#pragma unroll
                    for (int j = 0; j < 8; ++j) cn4[j & 3] += (u[8 * g + j] >= mid) ? 1 : 0;
                }
            int cnt = (cn4[0] + cn4[1]) + (cn4[2] + cn4[3]);
            cnt += __builtin_amdgcn_update_dpp(0, cnt, 0xB1, 0xF, 0xF, true);
            cnt += __builtin_amdgcn_update_dpp(0, cnt, 0x4E, 0xF, 0xF, true);
            cnt += __builtin_amdgcn_update_dpp(0, cnt, 0x141, 0xF, 0xF, true);
            cnt += __builtin_amdgcn_update_dpp(0, cnt, 0x140, 0xF, 0xF, true);
            const int c0 = __builtin_amdgcn_readlane(cnt, 0) + __builtin_amdgcn_readlane(cnt, 16);
            const int c1 = __builtin_amdgcn_readlane(cnt, 32) + __builtin_amdgcn_readlane(cnt, 48);
            const int mine = hs ? c1 : c0; const bool mydone = hs ? done1 : done0;
            if (!mydone) { if (mine == 256) T = mid; else if (mine > 256) L = mid; else H = mid; }
            done0 |= (c0 == 256); done1 |= (c1 == 256);
            if (done0 && done1) break;
        }
        if (!(hs ? done1 : done0)) T = L;
    }
    unsigned wl4[4] = {0u, 0u, 0u, 0u}, wh4[4] = {0u, 0u, 0u, 0u};
#pragma unroll
    for (int g = 0; g < 8; ++g)
        if (8 * g <= cmax) {
#pragma unroll
            for (int j = 0; j < 8; ++j) {
                const int c = 8 * g + j;
                const unsigned long long bal = __ballot(u[c] >= T);
                const unsigned blo = (unsigned)bal, bhi = (unsigned)(bal >> 32);
                asm volatile("s_nop 3\n\tv_writelane_b32 %0, %2, %4\n\tv_writelane_b32 %1, %3, %4" : "+v"(wl4[j & 3]), "+v"(wh4[j & 3]) : "s"(blo), "s"(bhi), "i"(c));
            }
            __builtin_amdgcn_sched_barrier(0);
        }
    const unsigned wlo = (wl4[0] | wl4[1]) | (wl4[2] | wl4[3]), whi = (wh4[0] | wh4[1]) | (wh4[2] | wh4[3]);
    MASK[(size_t)(b * SEQ + qa) * 64 + lane] = wlo; MASK[(size_t)(b * SEQ + qa + 1) * 64 + lane] = whi;
    LDS_WAIT();
}

__device__ __forceinline__ void sgu_unit(int b, int c, int g, const bf16* WSP, const bf16* VBT, const bf16* U, const float* rowsq_vb, float vbscale, const float* sgu_g, const float* bsp, bf16* OAB, LAS float* rsl, int wave, int lane) {
    const int tb = (wave >> 1) * 32, dblk = (wave & 1) * 64, r = lane & 31, hs = lane >> 5;
    LAS float* rw = rsl + wave * 128;
    const float q0 = rowsq_vb[b * SEQ + c * CHUNK + lane], q1 = rowsq_vb[b * SEQ + c * CHUNK + 64 + lane];
    f32x16 acc[2];
#pragma unroll
    for (int i = 0; i < 16; ++i) { acc[0][i] = 0.f; acc[1][i] = 0.f; }
    const int kkmax = 2 * (wave >> 1) + 1;
    u32x4 raw[8]; bf16x8 vfr[8][2];
#pragma unroll
    for (int kk = 0; kk < 8; ++kk)
        if (kk <= kkmax) {
            raw[kk] = *(const u32x4*)(WSP + (size_t)(g * CHUNK + tb + r) * CHUNK + 16 * kk + 8 * hs);
#pragma unroll
            for (int j2 = 0; j2 < 2; ++j2) vfr[kk][j2] = *(const bf16x8*)(VBT + ((size_t)(b * 1024 + g * 128 + dblk + 32 * j2 + r)) * 2048 + c * CHUNK + 16 * kk + 8 * hs);
        }
    const int t = tb + r; const size_t row = (size_t)(b * SEQ + c * CHUNK + t); const float bt = bsp[g * CHUNK + t];
    u32x2 uraw[2][4];
#pragma unroll
    for (int j2 = 0; j2 < 2; ++j2)
#pragma unroll
        for (int q4 = 0; q4 < 4; ++q4) uraw[j2][q4] = *(const u32x2*)(U + row * 1024 + g * 128 + dblk + 32 * j2 + 8 * q4 + 4 * hs);
    rw[lane] = 1.0f / sqrtf(q0 * vbscale + EPS); rw[64 + lane] = 1.0f / sqrtf(q1 * vbscale + EPS);
    LDS_WAIT();
#pragma unroll
    for (int kk = 0; kk < 8; ++kk)
        if (kk <= kkmax) {
            const LAS float* rp = rw + 16 * kk + 8 * hs;
            u32x4 sc;
            sc.x = pk2(bf2f(raw[kk].x & 0xffffu) * rp[0], bf2f(raw[kk].x >> 16) * rp[1]); sc.y = pk2(bf2f(raw[kk].y & 0xffffu) * rp[2], bf2f(raw[kk].y >> 16) * rp[3]);
            sc.z = pk2(bf2f(raw[kk].z & 0xffffu) * rp[4], bf2f(raw[kk].z >> 16) * rp[5]); sc.w = pk2(bf2f(raw[kk].w & 0xffffu) * rp[6], bf2f(raw[kk].w >> 16) * rp[7]);
            const bf16x8 wfr = __builtin_bit_cast(bf16x8, sc);
#pragma unroll
            for (int j2 = 0; j2 < 2; ++j2) acc[j2] = __builtin_amdgcn_mfma_f32_32x32x16_bf16(vfr[kk][j2], wfr, acc[j2], 0, 0, 0);
        }
#pragma unroll
    for (int j2 = 0; j2 < 2; ++j2)
#pragma unroll
        for (int q4 = 0; q4 < 4; ++q4) {
            const int d = g * 128 + dblk + 32 * j2 + 8 * q4 + 4 * hs;
            const f32x4 gd = *(const f32x4*)(sgu_g + d); const u32x2 uw = uraw[j2][q4]; f32x4 uv, o;
            uv[0] = bf2f(uw.x & 0xffffu); uv[1] = bf2f(uw.x >> 16); uv[2] = bf2f(uw.y & 0xffffu); uv[3] = bf2f(uw.y >> 16);
#pragma unroll
            for (int e = 0; e < 4; ++e) o[e] = uv[e] * (acc[j2][4 * q4 + e] * gd[e] + bt);
            store_bf16x4(OAB + row * 2048 + 1024 + d, o);
        }
    LDS_WAIT();
}

constexpr int AT_TILE = 16384, AT_BUF = 65536;
__device__ __forceinline__ void attn_issue(const bf16* Kg, const bf16* Vg, int s, LAS unsigned char* buf, int wave, unsigned voffK, unsigned voffV) {
#pragma unroll
    for (int tt = 0; tt < 2; ++tt)
#pragma unroll
        for (int j = 0; j < 2; ++j) {
            const int blk = wave + 8 * j;
            __builtin_amdgcn_global_load_lds((const unsigned*)((const char*)Kg + (size_t)(2 * s + tt) * 131072 + (size_t)j * 65536 + voffK), (LAS unsigned*)(buf + tt * AT_TILE + blk * 1024), 16, 0, 0);
            __builtin_amdgcn_global_load_lds((const unsigned*)((const char*)Vg + (size_t)(2 * s + tt) * 128 + (size_t)j * 262144 + voffV), (LAS unsigned*)(buf + 2 * AT_TILE + tt * AT_TILE + blk * 1024), 16, 0, 0);
        }
}
__device__ __forceinline__ void attn_unit(int b, int h, int iq, const bf16* Q, const bf16* K, const bf16* VT, const unsigned* MASK, const LAS float* tbl, bf16* OAB, LAS unsigned char* lds, int wave, int lane, int par, bool have_tile0, bool prefetch_next) {
    const int tid = threadIdx.x, qg = wave & 3, kg = wave >> 2, r = lane & 31, hs = lane >> 5;
    const int qw = 128 * iq + 32 * qg;
    const size_t qrow = (size_t)(b * SEQ + qw + r);
    const bf16* Kg = K + (size_t)(b * SEQ) * 1024 + h * HD;
    const bf16* Vg = VT + (size_t)(b * 1024 + h * HD) * 2048;
    const int nsteps = iq + 1;
    const int rq = 4 * wave + (lane >> 4);
    const unsigned voffK = (unsigned)(rq * 1024 + (((lane & 15) ^ (rq & 15)) * 8)) * 2u;
    const unsigned voffV = (unsigned)((8 * wave + (lane >> 3)) * 2048 + (((lane & 7) ^ (rq & 7)) * 8)) * 2u;
    if (!have_tile0) attn_issue(Kg, Vg, 0, lds + (par & 1) * AT_BUF, wave, voffK, voffV);
    bf16x8 qf[8];
#pragma unroll
    for (int kk = 0; kk < 8; ++kk) qf[kk] = *(const bf16x8*)(Q + qrow * 1024 + h * HD + 16 * kk + 8 * hs);
    u32x2 mw = *(const u32x2*)(MASK + qrow * 64 + 2 * kg);
    f32x16 o[4];
#pragma unroll
    for (int db = 0; db < 4; ++db)
#pragma unroll
        for (int i = 0; i < 16; ++i) o[db][i] = 0.f;
    float mref = 0.f, lrun = 0.f;
    const float c31 = tbl[128];
    const unsigned kbase = (unsigned)(r * 256 + (((r & 15) ^ hs) << 4));
    const unsigned vbase = (unsigned)(r * 128 + ((((r >> 1) & 7) ^ hs) << 4));
    AT_WAIT_BARRIER();
    for (int s = 0; s < nsteps; ++s) {
        LAS unsigned char* cur = lds + ((s + par) & 1) * AT_BUF; LAS unsigned char* nxt = lds + ((s + 1 + par) & 1) * AT_BUF;
        const bool more = (s + 1 < nsteps);
        if (more) attn_issue(Kg, Vg, s + 1, nxt, wave, voffK, voffV);
        else if (prefetch_next) attn_issue(Kg, Vg, 0, nxt, wave, voffK, voffV);
        const int t = 2 * s + kg;
        u32x2 mwn = mw;
        if (more) mwn = *(const u32x2*)(MASK + qrow * 64 + 2 * (t + 2));
        f32x16 p[2];
        const LAS unsigned char* Kt = cur + kg * AT_TILE;
        unsigned kofs = kbase; asm volatile("" : "+v"(kofs));
        const bool far = (qw - (64 * t + 63)) >= 113;
        if (far) {
            const int cb = __float_as_int(c31 - mref);
#pragma unroll
            for (int kb = 0; kb < 2; ++kb) {
                const int word = (int)((kb == 0 ? mw.x : mw.y) >> (4 * hs));
#pragma unroll
                for (int i = 0; i < 16; ++i) { const int tmask = __builtin_amdgcn_sbfe(word, rowoff16(i), 1); int rr; asm("v_bfi_b32 %0, %1, %2, %3" : "=v"(rr) : "v"(tmask), "v"(cb), "v"((int)0xFF800000)); p[kb][i] = __int_as_float(rr); }
            }
        } else {
            const int dist0 = (qw + r) - (64 * t + 4 * hs);
#pragma unroll
            for (int kb = 0; kb < 2; ++kb) {
                const int word = (int)((kb == 0 ? mw.x : mw.y) >> (4 * hs));
#pragma unroll
                for (int i = 0; i < 16; ++i) {
                    int di = dist0 - 32 * kb - rowoff16(i); di = di < 0 ? 0 : (di > 128 ? 128 : di);
                    const int cb = __float_as_int(tbl[di] - mref); const int tmask = __builtin_amdgcn_sbfe(word, rowoff16(i), 1); int rr;
                    asm("v_bfi_b32 %0, %1, %2, %3" : "=v"(rr) : "v"(tmask), "v"(cb), "v"((int)0xFF800000)); p[kb][i] = __int_as_float(rr);
                }
            }
        }
#pragma unroll
        for (int kb = 0; kb < 2; ++kb)
#pragma unroll
            for (int kk = 0; kk < 8; ++kk) {
                const bf16x8 kf = *(const LAS bf16x8*)(Kt + kb * 8192 + (kofs ^ (unsigned)(kk << 5)));
                p[kb] = __builtin_amdgcn_mfma_f32_32x32x16_bf16(kf, qf[kk], p[kb], 0, 0, 0);
            }
        float mx4[4] = {-INFINITY, -INFINITY, -INFINITY, -INFINITY};
#pragma unroll
        for (int kb = 0; kb < 2; ++kb)
#pragma unroll
            for (int i = 0; i < 16; ++i) { const float v = p[kb][i]; mx4[i & 3] = fmaxf(mx4[i & 3], v); }
        float mx = fmaxf(fmaxf(mx4[0], mx4[1]), fmaxf(mx4[2], mx4[3]));
        mx = fmaxf(mx, __shfl_xor(mx, 32));
        if (__any(mx > 8.0f)) {
            const float d = fmaxf(mx, 0.f), f = __builtin_amdgcn_exp2f(-d);
            mref += d; lrun *= f;
#pragma unroll
            for (int kb = 0; kb < 2; ++kb)
#pragma unroll
                for (int i = 0; i < 16; ++i) p[kb][i] -= d;
#pragma unroll
            for (int db = 0; db < 4; ++db)
#pragma unroll
                for (int i = 0; i < 16; ++i) o[db][i] *= f;
        }
        float ls4[4] = {0.f, 0.f, 0.f, 0.f};
#pragma unroll
        for (int kb = 0; kb < 2; ++kb)
#pragma unroll
            for (int i = 0; i < 16; ++i) { const float pv = p[kb][i]; const float e = __builtin_amdgcn_exp2f(pv); p[kb][i] = e; ls4[i & 3] += e; }
        lrun += (ls4[0] + ls4[1]) + (ls4[2] + ls4[3]);
        const LAS unsigned char* Vt = cur + 2 * AT_TILE + kg * AT_TILE;
        unsigned vofs = vbase; asm volatile("" : "+v"(vofs));
#pragma unroll
        for (int s4 = 0; s4 < 4; ++s4) {
            const int kb = s4 >> 1, e0 = 8 * (s4 & 1);
            u32x4 w; w.x = pk2(p[kb][e0], p[kb][e0 + 1]); w.y = pk2(p[kb][e0 + 2], p[kb][e0 + 3]); w.z = pk2(p[kb][e0 + 4], p[kb][e0 + 5]); w.w = pk2(p[kb][e0 + 6], p[kb][e0 + 7]);
            const bf16x8 pf = __builtin_bit_cast(bf16x8, w);
#pragma unroll
            for (int db = 0; db < 4; ++db) {
                const bf16x8 vf = *(const LAS bf16x8*)(Vt + db * 4096 + (vofs ^ (unsigned)((2 * s4) << 4)));
                o[db] = __builtin_amdgcn_mfma_f32_32x32x16_bf16(vf, pf, o[db], 0, 0, 0);
            }
        }
        mw = mwn;
        AT_WAIT_BARRIER();
    }
    lrun += __shfl_xor(lrun, 32);
    LAS unsigned char* ebase = lds + ((nsteps - 1 + par) & 1) * AT_BUF;
    LAS unsigned* comb = (LAS unsigned*)(ebase + qg * 8704); LAS float* combf = (LAS float*)(ebase + qg * 8704 + 8192);
    if (kg == 1) {
#pragma unroll
        for (int db = 0; db < 4; ++db)
#pragma unroll
            for (int i2 = 0; i2 < 8; ++i2) comb[(db * 8 + i2) * 64 + lane] = pk2(o[db][2 * i2], o[db][2 * i2 + 1]);
        combf[lane] = mref; combf[64 + lane] = lrun;
    }
    LDS_BARRIER();
    if (kg == 0) {
        const float m1 = combf[lane], l1 = combf[64 + lane];
        const float mm = fmaxf(mref, m1);
        const float a0 = __builtin_amdgcn_exp2f(mref - mm), a1 = __builtin_amdgcn_exp2f(m1 - mm);
        const float inv = 1.0f / (lrun * a0 + l1 * a1);
        const float s0 = a0 * inv, s1 = a1 * inv;
        LAS unsigned char* stg = ebase + 34816 + qg * 4608;
#pragma unroll
        for (int db = 0; db < 4; ++db)
#pragma unroll
            for (int i4 = 0; i4 < 4; ++i4) {
                float v[4];
                const unsigned c01 = comb[(db * 8 + 2 * i4) * 64 + lane], c23 = comb[(db * 8 + 2 * i4 + 1) * 64 + lane];
                v[0] = o[db][4 * i4] * s0 + bf2f(c01 & 0xffffu) * s1; v[1] = o[db][4 * i4 + 1] * s0 + bf2f(c01 >> 16) * s1;
                v[2] = o[db][4 * i4 + 2] * s0 + bf2f(c23 & 0xffffu) * s1; v[3] = o[db][4 * i4 + 3] * s0 + bf2f(c23 >> 16) * s1;
                *(LAS unsigned*)(stg + r * 144 + (32 * db + 8 * i4 + 4 * hs)) = pk4_fp8(v[0] * OA_SCALE, v[1] * OA_SCALE, v[2] * OA_SCALE, v[3] * OA_SCALE);
            }
        LDS_WAIT();
#pragma unroll
        for (int j = 0; j < 4; ++j) {
            const int cid = lane + 64 * j, row = cid >> 3, ch = cid & 7;
            const u32x4 v = *(const LAS u32x4*)(stg + row * 144 + ch * 16);
            *(u32x4*)((unsigned char*)OAB + ((size_t)(b * SEQ + qw + row)) * 4096 + h * HD + ch * 16) = v;
        }
    }
    LDS_BARRIER();
}

#define XB_TMO      128
#define XB_XCNT(j)  (256  + 64 * (j))
#define XB_XSUB(j)  (1280 + 64 * (j))
#define XB_XGEN(j)  (2304 + 64 * (j))
#define XB_TOP      3328
#define XB_TOPGEN   3392
#define XCD_BAR_WORDS 3456
#define XB_SPIN_CAP (1u << 22)
__device__ __forceinline__ unsigned xb_ld(unsigned* p)              { return __hip_atomic_load(p, __ATOMIC_RELAXED, __HIP_MEMORY_SCOPE_AGENT); }
__device__ __forceinline__ unsigned xb_add(unsigned* p, unsigned v) { return __hip_atomic_fetch_add(p, v, __ATOMIC_RELAXED, __HIP_MEMORY_SCOPE_AGENT); }
__device__ __forceinline__ unsigned xb_xcc_id() { return (unsigned)__builtin_amdgcn_s_getreg((3 << 11) | 20) & 0xFu; }
#define XB_SPIN(cond, bar) do { unsigned _sp = 0; while (cond) { __builtin_amdgcn_s_sleep(1); \
    if ((++_sp & 255u) == 0u) { if (xb_ld(&(bar)[XB_TMO])) break; if (_sp > XB_SPIN_CAP) { atomicAdd(&(bar)[XB_TMO], 1u); break; } } } } while (0)
struct XcdBarrier { unsigned* bar; unsigned x; volatile LAS unsigned* st; };
__device__ __forceinline__ XcdBarrier xcd_barrier_post(unsigned* bar, volatile LAS unsigned* st) {
    XcdBarrier b; b.bar = bar; b.x = xb_xcc_id(); b.st = st;
    if (threadIdx.x == 0) (void)xb_add(&bar[XB_XCNT(b.x)], 1u);
    return b;
}
__device__ __forceinline__ void xcd_barrier_complete(unsigned* bar, unsigned x, unsigned& nloc, unsigned& nx) {
    const unsigned G = gridDim.x * gridDim.y * gridDim.z;
    unsigned sum, cnt, mine, sp = 0u;
    for (;;) {
        sum = 0u; cnt = 0u; mine = 0u;
#pragma unroll
        for (unsigned j = 0; j < 16; ++j) { const unsigned c = xb_ld(&bar[XB_XCNT(j)]); sum += c; cnt += (c > 0u) ? 1u : 0u; mine = (j == x) ? c : mine; }
        if (sum == G) break;
        __builtin_amdgcn_s_sleep(1);
        if ((++sp & 255u) == 0u) { if (xb_ld(&bar[XB_TMO])) break; if (sp > XB_SPIN_CAP) { atomicAdd(&bar[XB_TMO], 1u); break; } }
    }
    nloc = mine > 0u ? mine : 1u; nx = cnt > 0u ? cnt : 1u;
}
__device__ __forceinline__ void xcd_barrier(const XcdBarrier& b) {
    asm volatile("s_waitcnt vmcnt(0)" ::: "memory");
    __syncthreads();
    if (threadIdx.x == 0) {
        unsigned* bar = b.bar;
        __builtin_amdgcn_s_waitcnt(0);
        unsigned nloc = b.st[0], nx = b.st[1];
        if (nloc == 0u) { xcd_barrier_complete(bar, b.x, nloc, nx); b.st[0] = nloc; b.st[1] = nx; }
        const unsigned old = xb_add(&bar[XB_XSUB(b.x)], 1u);
        const unsigned gen = old / nloc;
        if (old + 1u == (gen + 1u) * nloc) {
            __builtin_amdgcn_fence(__ATOMIC_RELEASE, "agent");
            asm volatile("s_waitcnt vmcnt(0)" ::: "memory");
            const unsigned og = xb_add(&bar[XB_TOP], 1u);
            const unsigned tg = og / nx;
            if (og + 1u == (tg + 1u) * nx) xb_add(&bar[XB_TOPGEN], 1u);
            else XB_SPIN(xb_ld(&bar[XB_TOPGEN]) == tg, bar);
            __builtin_amdgcn_fence(__ATOMIC_ACQUIRE, "agent");
            xb_add(&bar[XB_XGEN(b.x)], 1u);
            asm volatile("s_waitcnt vmcnt(0)" ::: "memory");
        } else {
            XB_SPIN(xb_ld(&bar[XB_XGEN(b.x)]) == gen, bar);
            __builtin_amdgcn_fence(__ATOMIC_ACQUIRE, "agent");
            asm volatile("s_waitcnt vmcnt(0)" ::: "memory");
        }
    }
    __syncthreads();
}

struct Args { Ptrs p; int ph_lo, ph_hi, vbrep, mode; };
constexpr int NPHASE = 8;

__global__ void __launch_bounds__(512, 2) fwd(Args args) {
    extern __shared__ __attribute__((aligned(16))) unsigned char lds_raw[];
    LAS unsigned char* lds = (LAS unsigned char*)lds_raw;
    const Ptrs& P = args.p; unsigned char* ws = P.ws;
    const int tid = threadIdx.x, lane = tid & 63, wave = __builtin_amdgcn_readfirstlane(tid >> 6);
    const int G = gridDim.x, bx = blockIdx.x;
    const int vcu = (G % 8 == 0) ? (bx % 8) * (G / 8) + bx / 8 : bx;
    const int lo = args.ph_lo, hi = args.ph_hi;
#ifndef PHASE_MASK
#define PHASE_MASK 0xff
#endif
#define IN(k) (((PHASE_MASK >> (k)) & 1) && lo <= (k) && (k) < hi)
#if ONE_LAUNCH
    volatile LAS unsigned* bst = (volatile LAS unsigned*)(lds + LDS_BYTES - 64);
    if (tid < 16) bst[tid] = 0u;
    {
        unsigned* ctl = (unsigned*)(ws + WS_CTL);
        for (int i = bx * 512 + tid; i < (int)(CTL_BYTES / 4); i += G * 512) __hip_atomic_store(&ctl[i], 0u, __ATOMIC_RELAXED, __HIP_MEMORY_SCOPE_AGENT);
        asm volatile("s_waitcnt vmcnt(0)" ::: "memory");
    }
    __syncthreads();
    if (tid == 0) __builtin_amdgcn_fence(__ATOMIC_RELEASE, "agent");
    cg::this_grid().sync();
    XcdBarrier xbar = xcd_barrier_post((unsigned*)(ws + WS_CTL + CTL_BAR), bst);
#define SEAM(k) do { if (IN(k) && IN((k) + 1)) { xcd_barrier(xbar); if (NREP(13) == 2) xcd_barrier(xbar); } } while (0)
#else
#define SEAM(k) do { } while (0)
#endif
    bf16* WIN = (bf16*)(ws + WS_WIN); bf16* WAB = (bf16*)(ws + WS_WAB); bf16* WOUT = (bf16*)(ws + WS_WOUT); bf16* W1 = (bf16*)(ws + WS_W1); bf16* W2 = (bf16*)(ws + WS_W2);
    bf16* H1 = (bf16*)(ws + WS_H1); bf16* OAB = (bf16*)(ws + WS_OAB); bf16* ACT = (bf16*)(ws + WS_ACT);
    bf16* Qb = (bf16*)(ws + WS_Q); bf16* Kb = (bf16*)(ws + WS_K); bf16* VT = (bf16*)(ws + WS_VT); bf16* QI = (bf16*)(ws + WS_QI);
    bf16* Ub = (bf16*)(ws + WS_U); bf16* VBT = (bf16*)(ws + WS_VBT); bf16* X1B = (bf16*)(ws + WS_X1B); const unsigned char* GA = ws + WS_GA; const unsigned char* GB = ws + WS_GB;
    bf16* KI = (bf16*)(ws + WS_KI); float* WI = (float*)(ws + WS_WI); bf16* WSP = (bf16*)(ws + WS_WSP); float* TBL = (float*)(ws + WS_TBL);
    unsigned* MASK = (unsigned*)(ws + WS_MASK); bf16* MERGED = (bf16*)(ws + WS_MERGED);
    float* rowsq_vb = (float*)(ws + WS_CTL + CTL_ROWSQ_VB); float* rowsq2 = (float*)(ws + WS_CTL + CTL_ROWSQ2);

    if (IN(0)) for (int rep = 0; rep < NREP(0); ++rep) { p0_prologue(P, lds, vcu, G); }
    SEAM(0);
    if (IN(1)) for (int rep = 0; rep < NREP(1); ++rep) {
        { pg8::Gemm g{H1, WIN, MTOK, P1_NB16, DM, DM, DM}; pg8::StaticOrder S; S.init(MTOK, P1_NB16, G, bx);
          EpiIn<false> E{ws, P.q_norm_g, P.k_norm_g};
          pg8::gemm_phase<EpiIn<false>, pg8::NoMid, NREP(12)>(lds, g, S, E); }
        { pg8::Gemm g{(const pg8::bf16_t*)((const unsigned char*)P.out + OUT_H1F8), (const pg8::bf16_t*)((const unsigned char*)P.out + OUT_W8), MTOK, P1_NF8, DM / 2, DM / 2, DM / 2}; pg8::StaticOrder S; S.init(MTOK, P1_NF8, G, bx);
          EpiIn<true> E{ws, P.q_norm_g, P.k_norm_g};
          pg8::gemm_phase<EpiIn<true>, pg8::NoMid, 1, pg8::StaticOrder, true>(lds, g, S, E); }
        for (int rb = bx; rb < MTOK / 32; rb += G) kiwi_unit(rb, H1, WIN, P.idx_k_norm_g, KI, WI, lds, wave, lane);
    }
    SEAM(1);
    if (IN(2)) for (int rep = 0; rep < NREP(2); ++rep) {
        for (int r2 = 0; r2 < NREP(8); ++r2)
        for (int p = vcu; p < 256; p += G) { const int b = p >> 6, i = p & 63; indexer_unit(b, i, QI, KI, WI, MASK, lds, wave, lane, args.mode); indexer_unit(b, 127 - i, QI, KI, WI, MASK, lds, wave, lane, args.mode); }
        __syncthreads();
        if (args.mode == 0)
        for (int r2 = 0; r2 < NREP(9); ++r2)
        for (int un = vcu; un < 512; un += G) { const int b = un >> 7, c = (un >> 3) & 15, g = un & 7; sgu_unit(b, c, g, WSP, VBT, Ub, rowsq_vb, 1.0f / (float)(WBW * NREP(1) * NREP(12) * args.vbrep), P.sgu_norm_g, P.b_spatial, OAB, (LAS float*)(lds + SCR_OFF), wave, lane); }
    }
    SEAM(2);
    if (IN(3)) for (int rep = 0; rep < NREP(3); ++rep) {
        LAS float* tbl = (LAS float*)(lds + SCR_OFF);
        for (int p = vcu; p < 256; p += G) {
            const int b = p >> 6, h = (p >> 3) & 7, i = p & 7;
            __syncthreads();
            if (tid < 132) tbl[tid] = TBL[h * 132 + tid];
            __syncthreads();
            attn_unit(b, h, i, Qb, Kb, VT, MASK, tbl, OAB, lds, wave, lane, 0, false, true);
            attn_unit(b, h, 15 - i, Qb, Kb, VT, MASK, tbl, OAB, lds, wave, lane, (i + 1) & 1, true, false);
        }
    }
    SEAM(3);
    if (IN(4)) for (int rep = 0; rep < NREP(4); ++rep) {
        pg8::Gemm g{OAB, WAB, MTOK, DM, 1536, DM, DM, 8}; pg8::StaticOrder S; S.init(MTOK, DM, G, bx);
        EpiMerge E{GB, MERGED}; MidMerge H{GA, GB, 1.0f / (GATE_WSCALE * OA_SCALE)}; pg8::gemm_phase<EpiMerge, MidMerge, 1, pg8::StaticOrder, 2>(lds, g, S, E, H);
    }
    SEAM(4);
    if (IN(5)) for (int rep = 0; rep < NREP(5); ++rep) {
        pg8::Gemm g{MERGED, WOUT, MTOK, DM, DM, DM, DM}; pg8::StaticOrder S; S.init(MTOK, DM, G, bx);
        EpiOut E{P.x, X1B, rowsq2}; pg8::gemm_phase(lds, g, S, E);
    }
    SEAM(5);
    if (IN(6)) for (int rep = 0; rep < NREP(6); ++rep) {
        { pg8::Gemm g{X1B, W1, MTOK, 10240, DM, DM, DM}; pg8::StaticOrder S; S.init(MTOK, 10240, G, bx); EpiFfnUp E{rowsq2, ACT, 0}; pg8::gemm_phase(lds, g, S, E); }
        if (G == 256) {
            const int xcd = bx & 7, idx = bx >> 3, t = xcd * 16 + (idx >> 1), half = idx & 1;
            pg8::Gemm g{X1B + half * 1024, W1 + (size_t)10240 * 2048 + half * 1024, MTOK, 1024, 1024, DM, DM}; pg8::OneUnit S{t >> 2, t & 3};
            EpiFfnUpPair E{rowsq2, ACT, 40, half, (float*)(ws + WS_SLAB) + (size_t)t * 65536, (unsigned*)(ws + WS_CTL + CTL_PAIR) + t * 16};
            pg8::gemm_phase<EpiFfnUpPair, pg8::NoMid, 1, pg8::OneUnit>(lds, g, S, E);
        } else {
            pg8::Gemm g{X1B, W1 + (size_t)10240 * 2048, MTOK, 1024, DM, DM, DM}; pg8::StaticOrder S; S.init(MTOK, 1024, G, bx); EpiFfnUp E{rowsq2, ACT, 40}; pg8::gemm_phase(lds, g, S, E);
        }
    }
    SEAM(6);
    if (IN(7)) for (int rep = 0; rep < NREP(7); ++rep) {
        pg8::Gemm g{ACT, W2, MTOK, DM, FFN_T8 * 64 + (DFF - FFN_KF), DFF, DFF, FFN_T8}; pg8::StaticOrder S; S.init(MTOK, DM, G, bx);
        EpiFfnDown E{X1B, P.out}; MidScale H{1.0f / GATE_WSCALE}; pg8::gemm_phase<EpiFfnDown, MidScale, 1, pg8::StaticOrder, 2>(lds, g, S, E, H);
    }
#undef IN
#undef SEAM
}

extern "C" void kernel_launch(void* const* d_in, const int* in_sizes, int n_in, void* d_out, int out_size, void* d_ws, size_t ws_size, hipStream_t stream) {
    static int grid = 0;
    if (grid == 0) {
        if (n_in != 17 || in_sizes[0] != MTOK * DM || out_size != MTOK * DM || ws_size < WS_END) { fprintf(stderr, "kernel_launch: unexpected shapes (n_in %d, in0 %d, out %d, ws %zu < %zu); nothing launched\n", n_in, n_in > 0 ? in_sizes[0] : -1, out_size, ws_size, (size_t)WS_END); grid = -1; return; }
        int dev = 0, cus = 0;
        if (hipGetDevice(&dev) != hipSuccess || hipDeviceGetAttribute(&cus, hipDeviceAttributeMultiprocessorCount, dev) != hipSuccess) { grid = -1; return; }
        if (hipFuncSetAttribute((const void*)fwd, hipFuncAttributeMaxDynamicSharedMemorySize, LDS_BYTES) != hipSuccess) { fprintf(stderr, "kernel_launch: hipFuncSetAttribute failed\n"); grid = -1; return; }
        int per_cu = 0;
        if (hipOccupancyMaxActiveBlocksPerMultiprocessor(&per_cu, (const void*)fwd, 512, LDS_BYTES) != hipSuccess || per_cu < 1) { fprintf(stderr, "kernel_launch: occupancy query says %d blocks per CU\n", per_cu); (void)hipGetLastError(); grid = -1; return; }
        grid = cus;
    }
    if (grid < 0) return;
#if !ONE_LAUNCH
    (void)hipMemsetAsync((char*)d_ws + WS_CTL, 0, CTL_BYTES, stream);
#endif
    Args a{};
    const float** pp = (const float**)&a.p;
    for (int i = 0; i < 17; ++i) pp[i] = (const float*)d_in[i];
    a.p.out = (float*)d_out; a.p.ws = (unsigned char*)d_ws;
#if ONE_LAUNCH
    a.ph_lo = 0; a.ph_hi = NPHASE; a.vbrep = 1; a.mode = 0;
    void* kargs[] = {&a};
    hipError_t e = hipLaunchCooperativeKernel((const void*)fwd, dim3(grid), dim3(512), kargs, LDS_BYTES, stream);
    if (e != hipSuccess) fprintf(stderr, "cooperative launch failed: %s (grid %d)\n", hipGetErrorString(e), grid);
#else
#ifndef ML_REP_PHASE
#define ML_REP_PHASE -1
#endif
    a.vbrep = (ML_REP_PHASE == 1) ? 2 : 1; a.mode = 0;
#ifndef ML_P2_MODE
#define ML_P2_MODE 0
#endif
    for (int ph = 0; ph < NPHASE; ++ph) { a.ph_lo = ph; a.ph_hi = ph + 1; if (ph == 2 && ML_P2_MODE) { a.mode = ML_P2_MODE; hipLaunchKernelGGL(fwd, dim3(grid), dim3(512), LDS_BYTES, stream, a); a.mode = 0; }
        for (int k = 0; k < ((ph == ML_REP_PHASE) ? 2 : 1); ++k) hipLaunchKernelGGL(fwd, dim3(grid), dim3(512), LDS_BYTES, stream, a); }
#endif
}
```

```cpp
#include <hip/hip_runtime.h>
#include <hip/hip_cooperative_groups.h>
#include <cstdio>
#include <cstdint>
namespace cg = cooperative_groups;

#ifndef ONE_LAUNCH
#define ONE_LAUNCH 1
#endif
#ifndef REP_MASK
#define REP_MASK 0
#endif
#define NREP(k) (((REP_MASK >> (k)) & 1) ? 2 : 1)

#define LAS __attribute__((address_space(3)))
typedef unsigned short bf16;
typedef short bf16x8 __attribute__((ext_vector_type(8)));
typedef float f32x4 __attribute__((ext_vector_type(4)));
typedef float f32x16 __attribute__((ext_vector_type(16)));
typedef unsigned u32x4 __attribute__((ext_vector_type(4)));
typedef unsigned u32x2 __attribute__((ext_vector_type(2)));
typedef int i32x4 __attribute__((ext_vector_type(4)));
typedef int i32x8 __attribute__((ext_vector_type(8)));

constexpr int NB = 4, SEQ = 2048, DM = 2048, MTOK = NB * SEQ;
constexpr int WA = 1024, NH = 8, HD = 128, NIH = 16, IDXD = 64, WBW = 1024, NG = 8, CHUNK = 128;
constexpr int DFF = 5632, DIN = 10320, NIN = 10496;
constexpr float EPS = 1e-6f;
constexpr float LOG2E = 1.4426950408889634f;

constexpr size_t MiB = 1u << 20;
constexpr size_t WS_CTL = 0, CTL_BYTES = 144 * 1024;
constexpr size_t WS_KI = 1 * MiB;
constexpr size_t WS_WI = 2 * MiB;
constexpr size_t WS_WSP = 2 * MiB + 512 * 1024, WS_TBL = 2 * MiB + 768 * 1024;
constexpr size_t WS_MASK = 3 * MiB;
constexpr size_t WS_WIN = 5 * MiB;
constexpr size_t WS_MERGED = 5 * MiB;
constexpr size_t WS_SLAB = 5 * MiB;
constexpr size_t WS_WAB = 46 * MiB;
constexpr size_t WS_WOUT = 54 * MiB;
constexpr size_t WS_W1 = 62 * MiB;
constexpr size_t WS_W2 = 106 * MiB;
constexpr size_t WS_H1 = 128 * MiB;
constexpr size_t WS_OAB = 128 * MiB;
constexpr size_t WS_ACT = 128 * MiB;
constexpr size_t WS_Q = 160 * MiB, WS_K = 176 * MiB, WS_VT = 192 * MiB, WS_QI = 208 * MiB;
constexpr size_t WS_U = 224 * MiB, WS_VBT = 240 * MiB;
constexpr size_t WS_X1B = 224 * MiB;
constexpr size_t WS_GA = 256 * MiB, WS_GB = 288 * MiB;
constexpr size_t WS_END = 320 * MiB;
constexpr size_t OUT_H1F8 = 0, OUT_W8 = 16 * MiB;
constexpr size_t CTL_ROWSQ_VB = 0, CTL_ROWSQ2 = 32768, CTL_BAR = 65536, CTL_PAIR = 131072;

constexpr int RING_BYTES = 131072, SCR_OFF = RING_BYTES, LDS_BYTES = 147456;

__device__ const unsigned char T5_BUCKET[128] = {0, 1, 2, 3, 4, 5, 6, 7, 8, 9, 10, 11, 12, 13, 14, 15, 16, 16, 16, 17, 17, 18, 18, 18, 19, 19, 19, 20, 20, 20, 20, 21, 21, 21, 21, 22, 22, 22, 22, 22, 23, 23, 23, 23, 23, 23, 24, 24, 24, 24, 24, 24, 25, 25, 25, 25, 25, 25, 25, 26, 26, 26, 26, 26, 26, 26, 26, 27, 27, 27, 27, 27, 27, 27, 27, 27, 27, 28, 28, 28, 28, 28, 28, 28, 28, 28, 28, 29, 29, 29, 29, 29, 29, 29, 29, 29, 29, 29, 29, 30, 30, 30, 30, 30, 30, 30, 30, 30, 30, 30, 30, 30, 30, 31, 31, 31, 31, 31, 31, 31, 31, 31, 31, 31, 31, 31, 31, 31};

__device__ __forceinline__ unsigned f2bf(float f) { unsigned u = __builtin_bit_cast(unsigned, f); return (u + 0x7fffu + ((u >> 16) & 1u)) >> 16; }
typedef float f32x2_t __attribute__((ext_vector_type(2))); typedef __bf16 bf16x2_t __attribute__((ext_vector_type(2)));
__device__ __forceinline__ unsigned pk2(float lo, float hi) { f32x2_t v = {lo, hi}; bf16x2_t b = __builtin_convertvector(v, bf16x2_t); return __builtin_bit_cast(unsigned, b); }
__device__ __forceinline__ float bf2f(unsigned v) { return __builtin_bit_cast(float, v << 16); }
__device__ __forceinline__ float sigmoidf_(float x) { return __builtin_amdgcn_rcpf(1.0f + __builtin_amdgcn_exp2f(-x * LOG2E)); }
__device__ __forceinline__ float gelu_tanh(float x) { const float t = x * (1.0f + 0.044715f * x * x) * (2.0f * 0.7978845608028654f); return x * sigmoidf_(t); }
__device__ __forceinline__ float wave_sum(float v) {
#pragma unroll
    for (int o = 1; o < 64; o <<= 1) v += __shfl_xor(v, o);
    return v;
}
__device__ __forceinline__ int rowoff16(int i) { return (i & 3) + 8 * (i >> 2); }
#define LDS_WAIT() asm volatile("s_waitcnt lgkmcnt(0)" ::: "memory")
#define LDS_BARRIER() do { asm volatile("s_waitcnt lgkmcnt(0)" ::: "memory"); __builtin_amdgcn_s_barrier(); asm volatile("" ::: "memory"); } while (0)
#define AT_WAIT_BARRIER() do { asm volatile("s_waitcnt vmcnt(0) lgkmcnt(0)" ::: "memory"); __builtin_amdgcn_s_barrier(); asm volatile("" ::: "memory"); } while (0)

namespace pg8 {
#define PG8_LAS __attribute__((address_space(3)))
typedef unsigned short bf16_t;
constexpr int BM = 256, BK = 64, HALF = 128, HTB = HALF * BK * 2, STAGE_BYTES = 8 * HTB, NXCD = 8, WGM = 8;
__host__ __device__ __forceinline__ int lds_byte(int r, int c) { const int st = (r >> 4) * 2 + (c >> 5), rr = r & 15, cc = c & 31, ob = rr * 64 + cc * 2; return st * 1024 + (ob ^ (((ob >> 9) & 1) << 5)); }
__host__ __device__ __forceinline__ void stage_rc(int b, int& R, int& C) { const int st = b / 1024, sb = b % 1024, swz = sb ^ (((sb >> 9) & 1) << 5); R = (st >> 1) * 16 + swz / 64; C = (st & 1) * 32 + (swz % 64) / 2; }
__host__ __device__ __forceinline__ int perm32(int rho) { const int n = rho >> 4, i = rho & 15; return 8 * (i >> 2) + 4 * n + (i & 3); }
struct Unit { int pm, pn; };
struct Gemm { const bf16_t* A; const bf16_t* Bt; int M, N, K, lda, ldb, T8 = 0; };
struct StaticOrder {
    int nM, nN, nwg, G, c;
    __host__ __device__ void init(int M, int N, int G_, int c_) { nM = M / BM; nN = N / BM; nwg = nM * nN; G = G_; c = c_; }
    __host__ __device__ bool next(int i, Unit& u) const {
        const long L = (long)i * G + c; if (L >= nwg) return false;
        int wgid = (int)L; { const int q = nwg / NXCD, r = nwg % NXCD, xcd = wgid % NXCD, off = wgid / NXCD; wgid = (xcd < r ? xcd * (q + 1) : r * (q + 1) + (xcd - r) * q) + off; }
        const int nig = WGM * nN, gid = wgid / nig, fm = gid * WGM, gsz = (nM - fm) < WGM ? (nM - fm) : WGM;
        u.pm = fm + ((wgid % nig) % gsz); u.pn = (wgid % nig) / gsz; return true;
    }
};
typedef f32x4 Acc[2][2][4][2];

template <bool F8> struct Frag;
template <> struct Frag<false> { bf16x8 k[2]; };
template <> struct Frag<true>  { i32x8 v; };
__device__ __forceinline__ void frag_ld(Frag<false>& d, const PG8_LAS unsigned char* p) { d.k[0] = *(const PG8_LAS bf16x8*)p; d.k[1] = *(const PG8_LAS bf16x8*)(p + 1024); }
__device__ __forceinline__ void frag_ld(Frag<true>& d, const PG8_LAS unsigned char* p) { d.v.lo = *(const PG8_LAS i32x4*)p; d.v.hi = *(const PG8_LAS i32x4*)(p + 1024); }
template <bool ASM> __device__ __forceinline__ void frag_mma(f32x4& c, const Frag<false>& b, const Frag<false>& a) {
    if constexpr (ASM) { asm volatile("v_mfma_f32_16x16x32_bf16 %0, %1, %2, %0" : "+v"(c) : "v"(b.k[0]), "v"(a.k[0])); asm volatile("v_mfma_f32_16x16x32_bf16 %0, %1, %2, %0" : "+v"(c) : "v"(b.k[1]), "v"(a.k[1])); }
    else { c = __builtin_amdgcn_mfma_f32_16x16x32_bf16(b.k[0], a.k[0], c, 0, 0, 0); c = __builtin_amdgcn_mfma_f32_16x16x32_bf16(b.k[1], a.k[1], c, 0, 0, 0); }
}
template <bool ASM> __device__ __forceinline__ void frag_mma(f32x4& c, const Frag<true>& b, const Frag<true>& a) { asm volatile("v_mfma_f32_16x16x128_f8f6f4 %0, %1, %2, %0" : "+v"(c) : "v"(b.v), "v"(a.v)); }
struct NoMid { static constexpr bool ACTIVE = false; __device__ __forceinline__ void operator()(Acc&, const Unit&, int, int, int, int) const {} };
struct OneUnit { int pm, pn; __device__ __forceinline__ bool next(int i, Unit& u) const { if (i != 0) return false; u.pm = pm; u.pn = pn; return true; } };
template <class Epi, class Mid = NoMid, int EREP = 1, class Sched = StaticOrder, int MODE = 0>
__device__ __forceinline__ void gemm_phase(PG8_LAS unsigned char* lds, const Gemm g, const Sched& S, const Epi& E, const Mid& H = Mid()) {
    int tid_ = threadIdx.x; asm volatile("" : "+v"(tid_));
    const int tid = tid_, wid = __builtin_amdgcn_readfirstlane(tid >> 6), lane = tid & 63, wr = wid >> 2, wc = wid & 3, fr = lane & 15, fq = lane >> 4;
    constexpr bool FP8 = MODE != 0;
    const int K = g.K, nt = K / BK, T8 = MODE == 2 ? g.T8 : 0, th = MODE == 2 ? T8 : (nt >> 1);
    unsigned voffA[2], voffB[2];
#pragma unroll
    for (int i = 0; i < 2; ++i) { int R, C; stage_rc(tid * 16 + i * 8192, R, C); const int Rb = Epi::PERM ? ((R & ~31) + perm32(R & 31)) : R; voffA[i] = (unsigned)(R * g.lda + C) * 2u; voffB[i] = (unsigned)(Rb * g.ldb + C) * 2u; }
    const size_t kstep = (size_t)(BK * 2);
    const size_t hstepA = (size_t)HALF * g.lda * 2, hstepB = (size_t)HALF * g.ldb * 2;
    const size_t tstepA = 2 * hstepA, tstepB = 2 * hstepB;
    const unsigned ldsw = (unsigned)wid * 1024u;
    const int aoff = lds_byte(wr * 64 + fr, fq * 8), boff = lds_byte(wc * 32 + fr, fq * 8);
#define PG8_SA(b, h) (((b) * 2 + (h)) * HTB)
#define PG8_SB(b, h) ((4 + (b) * 2 + (h)) * HTB)
#define PG8_STAGE(bufoff, gbase, voff) do { _Pragma("unroll") for (int _i = 0; _i < 2; ++_i) \
        __builtin_amdgcn_global_load_lds((const unsigned*)((const char*)(gbase) + (voff)[_i]), (PG8_LAS unsigned*)(lds + (bufoff) + ldsw + _i * 8192), 16, 0, 0); } while (0)
#define PG8_LDF(dst, i, base) frag_ld(dst[i], lds + (base) + (i) * 2048)
#define PG8_LDA(dst, b, h) do { _Pragma("unroll") for (int m = 0; m < 4; ++m) PG8_LDF(dst, m, PG8_SA(b, h) + aoff); } while (0)
#define PG8_LDB(dst, b, h) do { _Pragma("unroll") for (int n = 0; n < 2; ++n) PG8_LDF(dst, n, PG8_SB(b, h) + boff); } while (0)
#define PG8_MMA(ai, bj, At, Bt) do { __builtin_amdgcn_s_setprio(1); _Pragma("unroll") for (int m = 0; m < 4; ++m) _Pragma("unroll") for (int n = 0; n < 2; ++n) frag_mma<MODE == 2>(acc[ai][bj][m][n], Bt[n], At[m]); \
        __builtin_amdgcn_s_setprio(0); } while (0)
#define PG8_WAIT_V(n) asm volatile("s_waitcnt vmcnt(" #n ")" ::: "memory")
#define PG8_WAIT_L(n) asm volatile("s_waitcnt lgkmcnt(" #n ")" ::: "memory")
#define PG8_BAR __builtin_amdgcn_s_barrier()
#define PG8_SCHED __builtin_amdgcn_sched_barrier(0)
    Unit cur, nxt; int ui = 0;
    if (!S.next(0, cur)) return;
    Acc acc;
#pragma unroll
    for (int a = 0; a < 2; ++a)
#pragma unroll
        for (int b = 0; b < 2; ++b)
#pragma unroll
            for (int m = 0; m < 4; ++m)
#pragma unroll
                for (int n = 0; n < 2; ++n) acc[a][b][m][n] = (f32x4){0.f, 0.f, 0.f, 0.f};
    Frag<false> Ab[4], Bb0[2], Bb1[2]; Frag<true> Af[4], Bf0[2], Bf1[2];
    const char* cA = (const char*)g.A + (size_t)cur.pm * tstepA; const char* cB = (const char*)g.Bt + (size_t)cur.pn * tstepB;
    PG8_STAGE(PG8_SB(0, 0), cB, voffB); PG8_STAGE(PG8_SB(0, 1), cB + hstepB, voffB); PG8_STAGE(PG8_SA(0, 0), cA, voffA); PG8_STAGE(PG8_SA(0, 1), cA + hstepA, voffA);
    if (wr == 1) PG8_BAR;
    PG8_WAIT_V(2); PG8_BAR;
    PG8_STAGE(PG8_SB(1, 0), cB + kstep, voffB); PG8_STAGE(PG8_SA(1, 0), cA + kstep, voffA); PG8_STAGE(PG8_SB(1, 1), cB + hstepB + kstep, voffB);
    PG8_WAIT_V(6); PG8_BAR;
    for (;;) {
        const bool has_next = S.next(ui + 1, nxt);
        const char* nA = has_next ? (const char*)g.A + (size_t)nxt.pm * tstepA : cA; const char* nB = has_next ? (const char*)g.Bt + (size_t)nxt.pn * tstepB : cB;
#define PG8_KOFF(t) ((size_t)(t) * kstep + ((MODE == 2 && (t) >= T8) ? (size_t)T8 * kstep : (size_t)0))
#define PG8_TRIP(At, B0, B1) do { \
            const bool last = (t == nt - 2); \
            const char* a1 = cA + PG8_KOFF(t + 1); \
            const char* a2 = last ? nA : cA + PG8_KOFF(t + 2); const char* b2 = last ? nB : cB + PG8_KOFF(t + 2); \
            const char* a3 = a2 + kstep; const char* b3 = b2 + kstep; \
            if constexpr (Mid::ACTIVE) { if (t == th) { if constexpr (MODE == 2) asm volatile("s_nop 15\n\ts_nop 15" ::: "memory"); H(acc, cur, wr, wc, fr, fq); } } \
            PG8_LDB(B0, 0, 0); PG8_LDB(B1, 0, 1); PG8_SCHED; PG8_LDA(At, 0, 0); PG8_STAGE(PG8_SA(1, 1), a1 + hstepA, voffA); \
            PG8_WAIT_V(8); PG8_WAIT_L(0); PG8_BAR; PG8_MMA(0, 0, At, B0); PG8_MMA(0, 1, At, B1); PG8_BAR; PG8_SCHED; \
            PG8_LDA(At, 0, 1); PG8_STAGE(PG8_SB(0, 0), b2, voffB); PG8_STAGE(PG8_SB(0, 1), b2 + hstepB, voffB); PG8_STAGE(PG8_SA(0, 0), a2, voffA); \
            PG8_WAIT_V(8); PG8_WAIT_L(0); PG8_BAR; PG8_MMA(1, 0, At, B0); PG8_MMA(1, 1, At, B1); PG8_BAR; PG8_SCHED; \
            PG8_LDB(B0, 1, 0); PG8_LDB(B1, 1, 1); PG8_SCHED; PG8_LDA(At, 1, 0); PG8_STAGE(PG8_SA(0, 1), a2 + hstepA, voffA); \
            PG8_WAIT_V(8); PG8_WAIT_L(0); PG8_BAR; PG8_MMA(0, 0, At, B0); PG8_MMA(0, 1, At, B1); PG8_BAR; PG8_SCHED; \
            PG8_LDA(At, 1, 1); PG8_STAGE(PG8_SB(1, 0), b3, voffB); PG8_STAGE(PG8_SB(1, 1), b3 + hstepB, voffB); PG8_STAGE(PG8_SA(1, 0), a3, voffA); \
            PG8_WAIT_V(8); PG8_WAIT_L(0); PG8_BAR; PG8_MMA(1, 0, At, B0); PG8_MMA(1, 1, At, B1); PG8_BAR; PG8_SCHED; \
        } while (0)
        if constexpr (MODE == 2) {
            for (int t = 0; t < T8; t += 2) PG8_TRIP(Af, Bf0, Bf1);
            for (int t = T8; t < nt; t += 2) PG8_TRIP(Ab, Bb0, Bb1);
        } else if constexpr (MODE == 1) {
            for (int t = 0; t < nt; t += 2) PG8_TRIP(Af, Bf0, Bf1);
        } else {
            for (int t = 0; t < nt; t += 2) PG8_TRIP(Ab, Bb0, Bb1);
        }
        if constexpr (FP8) asm volatile("s_nop 15\n\ts_nop 15" ::: "memory");
        if (wr == 0) PG8_BAR;
        E(acc, cur, wr, wc, fr, fq, lds + STAGE_BYTES);
        if constexpr (EREP == 2) { asm volatile("" ::: "memory"); E(acc, cur, wr, wc, fr, fq, lds + STAGE_BYTES); }
        if (!has_next) break;
#pragma unroll
        for (int a = 0; a < 2; ++a)
#pragma unroll
            for (int b = 0; b < 2; ++b)
#pragma unroll
                for (int m = 0; m < 4; ++m)
#pragma unroll
                    for (int n = 0; n < 2; ++n) acc[a][b][m][n] = (f32x4){0.f, 0.f, 0.f, 0.f};
        cur = nxt; cA = nA; cB = nB; ++ui;
        if (wr == 1) PG8_BAR;
    }
    PG8_WAIT_V(0);
    PG8_BAR;
#undef PG8_SA
#undef PG8_SB
#undef PG8_STAGE
#undef PG8_LDA
#undef PG8_LDB
#undef PG8_MMA
#undef PG8_LDF
#undef PG8_TRIP
#undef PG8_KOFF
#undef PG8_WAIT_V
#undef PG8_WAIT_L
#undef PG8_BAR
#undef PG8_SCHED
}
}

struct Ptrs {
    const float *x, *norm1_g, *w_in, *q_norm_g, *k_norm_g, *idx_k_norm_g, *sgu_norm_g, *w_spatial, *b_spatial, *w_proj_a, *w_proj_b, *w_out, *norm2_g, *w_gate, *w_up, *w_down, *rel_bias;
    float* out; unsigned char* ws;
};

__device__ __forceinline__ unsigned pk4_fp8(float a, float b, float c, float d) { int w = __builtin_amdgcn_cvt_pk_fp8_f32(a, b, 0, false); w = __builtin_amdgcn_cvt_pk_fp8_f32(c, d, w, true); return (unsigned)w; }
__device__ __forceinline__ f32x4 ld_bf16x4(const bf16* p) { const u32x2 w = *(const u32x2*)p; f32x4 r; r[0] = bf2f(w.x & 0xffffu); r[1] = bf2f(w.x >> 16); r[2] = bf2f(w.y & 0xffffu); r[3] = bf2f(w.y >> 16); return r; }
__device__ __forceinline__ void store_bf16x4(bf16* p, f32x4 v) { u32x2 w; w.x = pk2(v[0], v[1]); w.y = pk2(v[2], v[3]); *(u32x2*)p = w; }

__device__ __forceinline__ void store_bf16x8(void* p, f32x4 a, f32x4 b) { u32x4 w; w.x = pk2(a[0], a[1]); w.y = pk2(a[2], a[3]); w.z = pk2(b[0], b[1]); w.w = pk2(b[2], b[3]); *(u32x4*)p = w; }
template <int ACT> __device__ __forceinline__ f32x4 act4(f32x4 v) {
    if (ACT == 1) { v[0] = gelu_tanh(v[0]); v[1] = gelu_tanh(v[1]); v[2] = gelu_tanh(v[2]); v[3] = gelu_tanh(v[3]); }
    if (ACT == 2) { v[0] = sigmoidf_(v[0]); v[1] = sigmoidf_(v[1]); v[2] = sigmoidf_(v[2]); v[3] = sigmoidf_(v[3]); }
    return v;
}
template <int ACT> __device__ __forceinline__ void epi_rowmajor(pg8::Acc& acc, char* dt, int rowb, unsigned lo) {
#pragma unroll
    for (int ai = 0; ai < 2; ++ai)
#pragma unroll
        for (int m = 0; m < 4; ++m) { char* dr = dt + (size_t)(ai * 128 + m * 16) * rowb;
#pragma unroll
            for (int bj = 0; bj < 2; ++bj) store_bf16x8(dr + lo + bj * 256, act4<ACT>(acc[ai][bj][m][0]), act4<ACT>(acc[ai][bj][m][1])); }
}
#ifndef FP8_QK
#define FP8_QK 1
#endif
constexpr int P1_NB16 = FP8_QK ? 2048 : 4096, P1_NF8 = FP8_QK ? 8192 : 6144;
constexpr int FFN_T8 = 12, FFN_KF = 128 * FFN_T8;
constexpr float OA_SCALE = 4.0f;
constexpr float GATE_WSCALE = 32.0f;
template <bool F8>
struct EpiIn {
    static constexpr bool PERM = true;
    unsigned char* ws; const float *gq, *gk;
    __device__ __forceinline__ void operator()(pg8::Acc& acc, const pg8::Unit& u, int wr, int wc, int fr, int fq, LAS unsigned char* scr) const {
        constexpr float SC = F8 ? 1.0f / GATE_WSCALE : 1.0f;
        const int rt0 = wr * 64 + fr; const int row0 = u.pm * 256 + rt0;
        if constexpr (F8) if (u.pn < 16) {
            unsigned char* ga_ = ws + WS_GA + (size_t)u.pm * 256 * 2048 + u.pn * 128; unsigned char* gb_ = ws + WS_GB + (size_t)u.pm * 256 * 2048 + u.pn * 128;
            unsigned lo = (unsigned)(rt0 * 2048 + wc * 32 + 8 * fq); asm volatile("" : "+v"(lo));
            constexpr float NS = -LOG2E * SC;
#pragma unroll
            for (int ai = 0; ai < 2; ++ai)
#pragma unroll
                for (int m = 0; m < 4; ++m) {
                    u32x2 wa, wb; wa.x = wa.y = wb.x = wb.y = 0u;
#pragma unroll
                    for (int n = 0; n < 2; ++n)
#pragma unroll
                        for (int e = 0; e < 4; ++e) {
                            const float ea = __builtin_amdgcn_exp2f(acc[ai][0][m][n][e] * NS), eb = __builtin_amdgcn_exp2f(acc[ai][1][m][n][e] * NS);
                            const float sa = 255.0f * __builtin_amdgcn_rcpf(1.0f + ea), sb = fmaxf(255.0f * __builtin_amdgcn_rcpf(1.0f + eb), 1.0f);
                            if (n == 0) { wa.x = __builtin_amdgcn_cvt_pk_u8_f32(sa, e, wa.x); wb.x = __builtin_amdgcn_cvt_pk_u8_f32(sb, e, wb.x); }
                            else        { wa.y = __builtin_amdgcn_cvt_pk_u8_f32(sa, e, wa.y); wb.y = __builtin_amdgcn_cvt_pk_u8_f32(sb, e, wb.y); }
                        }
                    *(u32x2*)(ga_ + (size_t)(ai * 128 + m * 16) * 2048 + lo) = wa; *(u32x2*)(gb_ + (size_t)(ai * 128 + m * 16) * 2048 + lo) = wb;
                }
            return;
        }
        const int pn = F8 ? (u.pn < 20 ? u.pn - 8 : (u.pn < 24 ? u.pn : u.pn - 24)) : (FP8_QK ? u.pn + 12 : (u.pn < 8 ? u.pn : u.pn + 4));
        LAS float* P = (LAS float*)scr;
        if (pn < 8) {
            const bool isq = pn < 4; const float* g = isq ? gq : gk;
            const float osc = (isq ? (0.08838834764831845f * LOG2E) : 1.0f) * SC;
#pragma unroll
            for (int ai = 0; ai < 2; ++ai)
#pragma unroll
                for (int m = 0; m < 4; ++m)
#pragma unroll
                    for (int bj = 0; bj < 2; ++bj) {
                        float s = 0.f;
#pragma unroll
                        for (int n = 0; n < 2; ++n) { const f32x4 v = acc[ai][bj][m][n]; s += (v[0] * v[0] + v[1] * v[1]) + (v[2] * v[2] + v[3] * v[3]); }
                        s += __shfl_xor(s, 16); s += __shfl_xor(s, 32);
                        if (fq == 0) P[(ai * 128 + rt0 + m * 16) * 8 + bj * 4 + wc] = s;
                    }
            LDS_BARRIER();
            f32x4 gv[2];
#pragma unroll
            for (int n = 0; n < 2; ++n) gv[n] = *(const f32x4*)(g + wc * 32 + 8 * fq + 4 * n) * osc;
            char* dt = (char*)ws + (isq ? WS_Q : WS_K) + ((size_t)u.pm * 256 * 1024 + (pn & 3) * 256) * 2;
            unsigned lo = (unsigned)(rt0 * 1024 + wc * 32 + 8 * fq) * 2u; asm volatile("" : "+v"(lo));
#pragma unroll
            for (int ai = 0; ai < 2; ++ai)
#pragma unroll
                for (int m = 0; m < 4; ++m) { char* dr = dt + (size_t)(ai * 128 + m * 16) * 2048;
#pragma unroll
                    for (int bj = 0; bj < 2; ++bj) {
                        const f32x4 pp = *(const LAS f32x4*)(P + (ai * 128 + rt0 + m * 16) * 8 + bj * 4);
                        const float rs = __builtin_amdgcn_rsqf(((pp[0] + pp[1]) + (pp[2] + pp[3])) * (SC * SC / 128.0f) + EPS);
                        store_bf16x8(dr + lo + bj * 256, acc[ai][bj][m][0] * rs * gv[0], acc[ai][bj][m][1] * rs * gv[1]);
                    } }
        } else if (pn < 12 || (pn >= 20 && pn < 24)) {
            const bool isv = pn < 12; bf16* dst = (bf16*)(ws + (isv ? WS_VT : WS_VBT)); const int chbase = ((isv ? pn - 8 : pn - 20)) * 256; float* rowsq_vb = (float*)(ws + WS_CTL + CTL_ROWSQ_VB);
            const int frp = isv ? (8 * ((fr >> 2) & 1) + 4 * (fr >> 3) + (fr & 3)) : fr;
            const int b = u.pm >> 3, s0 = (u.pm & 7) * 256 + wr * 64 + frp;
#pragma unroll
            for (int ai = 0; ai < 2; ++ai)
#pragma unroll
                for (int m = 0; m < 4; ++m) {
                    float ss = 0.f;
#pragma unroll
                    for (int bj = 0; bj < 2; ++bj)
#pragma unroll
                        for (int n = 0; n < 2; ++n) {
                            f32x4 v = acc[ai][bj][m][n];
                            if constexpr (F8) v = v * SC;
                            if (!isv) { v = act4<1>(v); ss += (v[0] * v[0] + v[1] * v[1]) + (v[2] * v[2] + v[3] * v[3]); }
                            const int ch = chbase + bj * 128 + wc * 32 + 8 * fq + 4 * n;
                            bf16* p = dst + ((size_t)(b * 1024 + ch)) * 2048 + s0 + ai * 128 + m * 16;
                            const unsigned w01 = pk2(v[0], v[1]), w23 = pk2(v[2], v[3]);
                            p[0] = (bf16)(w01 & 0xffffu); p[2048] = (bf16)(w01 >> 16); p[4096] = (bf16)(w23 & 0xffffu); p[6144] = (bf16)(w23 >> 16);
                        }
                    if (!isv) { ss += __shfl_xor(ss, 16); ss += __shfl_xor(ss, 32); if (fq == 0) unsafeAtomicAdd(rowsq_vb + row0 + ai * 128 + m * 16, ss); }
                }
        } else if constexpr (!F8) {
            const size_t doff = pn < 16 ? WS_QI : WS_U; const int colbase = (pn & 3) * 256;
            char* dt = (char*)ws + doff + ((size_t)u.pm * 256 * 1024 + colbase) * 2;
            unsigned lo = (unsigned)(rt0 * 1024 + wc * 32 + 8 * fq) * 2u; asm volatile("" : "+v"(lo));
            if (pn < 16) epi_rowmajor<0>(acc, dt, 2048, lo); else epi_rowmajor<1>(acc, dt, 2048, lo);
        }
    }
};

__device__ __forceinline__ void ld_bf16x8(const void* p, f32x4& a, f32x4& b) { const u32x4 w = *(const u32x4*)p; a[0] = bf2f(w.x & 0xffffu); a[1] = bf2f(w.x >> 16); a[2] = bf2f(w.y & 0xffffu); a[3] = bf2f(w.y >> 16); b[0] = bf2f(w.z & 0xffffu); b[1] = bf2f(w.z >> 16); b[2] = bf2f(w.w & 0xffffu); b[3] = bf2f(w.w >> 16); }
struct MidScale {
    static constexpr bool ACTIVE = true; float sc;
    __device__ __forceinline__ void operator()(pg8::Acc& acc, const pg8::Unit&, int, int, int, int) const {
#pragma unroll
        for (int ai = 0; ai < 2; ++ai)
#pragma unroll
            for (int bj = 0; bj < 2; ++bj)
#pragma unroll
                for (int m = 0; m < 4; ++m)
#pragma unroll
                    for (int n = 0; n < 2; ++n) acc[ai][bj][m][n] *= sc;
    }
};
__device__ __forceinline__ void ld_u8x8(const void* p, f32x4& a, f32x4& b) { const u32x2 w = *(const u32x2*)p;
    a[0] = (float)(w.x & 0xffu); a[1] = (float)((w.x >> 8) & 0xffu); a[2] = (float)((w.x >> 16) & 0xffu); a[3] = (float)(w.x >> 24);
    b[0] = (float)(w.y & 0xffu); b[1] = (float)((w.y >> 8) & 0xffu); b[2] = (float)((w.y >> 16) & 0xffu); b[3] = (float)(w.y >> 24); }
struct MidMerge {
    static constexpr bool ACTIVE = true;
    const unsigned char *GA, *GB; float sc;
    __device__ __forceinline__ void operator()(pg8::Acc& acc, const pg8::Unit& u, int wr, int wc, int fr, int fq) const {
        unsigned lane_off = (unsigned)((wr * 64 + fr) * 2048 + wc * 32 + fq * 8); asm volatile("" : "+v"(lane_off));
        const size_t tile = (size_t)u.pm * 256 * 2048 + (size_t)u.pn * 256;
        const unsigned char* ga_t = GA + tile; const unsigned char* gb_t = GB + tile;
#pragma unroll
        for (int ai = 0; ai < 2; ++ai)
#pragma unroll
            for (int m = 0; m < 4; ++m) {
                const unsigned char* ga_r = ga_t + (size_t)(ai * 128 + m * 16) * 2048; const unsigned char* gb_r = gb_t + (size_t)(ai * 128 + m * 16) * 2048;
#pragma unroll
                for (int bj = 0; bj < 2; ++bj) {
                    f32x4 a0, a1, b0, b1; ld_u8x8(ga_r + lane_off + bj * 128, a0, a1); ld_u8x8(gb_r + lane_off + bj * 128, b0, b1);
#pragma unroll
                    for (int e = 0; e < 4; ++e) { acc[ai][bj][m][0][e] *= a0[e] * __builtin_amdgcn_rcpf(b0[e]) * sc; acc[ai][bj][m][1][e] *= a1[e] * __builtin_amdgcn_rcpf(b1[e]) * sc; }
                }
                asm volatile("" ::: "memory");
            }
    }
};
struct EpiMerge {
    static constexpr bool PERM = true;
    const unsigned char* GB; bf16* MERGED;
    __device__ __forceinline__ void operator()(pg8::Acc& acc, const pg8::Unit& u, int wr, int wc, int fr, int fq, LAS unsigned char*) const {
        unsigned lane_off = (unsigned)((wr * 64 + fr) * 2048 + wc * 32 + fq * 8) * 2u; asm volatile("" : "+v"(lane_off));
        const size_t tile = ((size_t)u.pm * 256 * 2048 + (size_t)u.pn * 256) * 2;
        const unsigned char* gb_t = GB + (tile >> 1); char* mt = (char*)MERGED + tile;
#pragma unroll
        for (int ai = 0; ai < 2; ++ai)
#pragma unroll
            for (int m = 0; m < 4; ++m) {
                const unsigned char* gb_r = gb_t + (size_t)(ai * 128 + m * 16) * 2048; char* mr = mt + (size_t)(ai * 128 + m * 16) * 4096;
#pragma unroll
                for (int bj = 0; bj < 2; ++bj) { f32x4 gb0, gb1; ld_u8x8(gb_r + (lane_off >> 1) + bj * 128, gb0, gb1); store_bf16x8(mr + lane_off + bj * 256, acc[ai][bj][m][0] * (gb0 * (1.0f / 255.0f)), acc[ai][bj][m][1] * (gb1 * (1.0f / 255.0f))); }
            }
    }
};
struct EpiOut {
    static constexpr bool PERM = false;
    const float* X; bf16* X1B; float* rowsq2;
    __device__ __forceinline__ void operator()(pg8::Acc& acc, const pg8::Unit& u, int wr, int wc, int fr, int fq, LAS unsigned char*) const {
        const int row0 = u.pm * 256 + wr * 64 + fr;
        unsigned lo = (unsigned)((wr * 64 + fr) * 2048 + wc * 32 + fq * 4) * 4u; asm volatile("" : "+v"(lo));
        const size_t tile = ((size_t)u.pm * 256 * 2048 + (size_t)u.pn * 256) * 4;
        const char* xt = (const char*)X + tile; char* bt = (char*)X1B + tile / 2;
#pragma unroll
        for (int ai = 0; ai < 2; ++ai)
#pragma unroll
            for (int m = 0; m < 4; ++m) {
                const size_t ro = (size_t)(ai * 128 + m * 16) * 8192;
                float ss = 0.f;
#pragma unroll
                for (int bj = 0; bj < 2; ++bj)
#pragma unroll
                    for (int n = 0; n < 2; ++n) {
                        const f32x4 v = __builtin_nontemporal_load((const f32x4*)(xt + ro + lo + bj * 512 + n * 64)) + acc[ai][bj][m][n];
                        ss += (v[0] * v[0] + v[1] * v[1]) + (v[2] * v[2] + v[3] * v[3]);
                        store_bf16x4((bf16*)(bt + ro / 2 + (lo >> 1) + bj * 256 + n * 32), v);
                    }
                ss += __shfl_xor(ss, 16); ss += __shfl_xor(ss, 32);
                if (fq == 0) unsafeAtomicAdd(rowsq2 + row0 + ai * 128 + m * 16, ss);
            }
    }
};
__device__ __forceinline__ void ffn_up_store(pg8::Acc& acc, const float* rowsq2, bf16* ACT, int pm, int pnc, int wr, int wc, int fr, int fq) {
    const int row0 = pm * 256 + wr * 64 + fr;
    unsigned lane_off = (unsigned)((wr * 64 + fr) * DFF + wc * 32 + fq * 8) * 2u; asm volatile("" : "+v"(lane_off));
    const bool f8 = pnc < FFN_T8;
    char* at = (char*)ACT + (size_t)pm * 256 * DFF * 2 + (size_t)pnc * 128 * (f8 ? 1 : 2);
    if (f8) { lane_off = (unsigned)((wr * 64 + fr) * DFF * 2 + wc * 32 + fq * 8); asm volatile("" : "+v"(lane_off)); }
#pragma unroll
    for (int ai = 0; ai < 2; ++ai)
#pragma unroll
        for (int m = 0; m < 4; ++m) {
            const int row = row0 + ai * 128 + m * 16;
            const float rs = __builtin_amdgcn_rsqf(rowsq2[row] * (1.0f / (2048.0f * NREP(5))) + EPS);
            f32x4 o[2];
#pragma unroll
            for (int n = 0; n < 2; ++n) {
                const f32x4 gt = acc[ai][0][m][n] * rs, up = acc[ai][1][m][n] * rs;
#pragma unroll
                for (int e = 0; e < 4; ++e) o[n][e] = gt[e] * sigmoidf_(gt[e]) * up[e];
            }
            if (f8) { u32x2 w; w.x = pk4_fp8(o[0][0], o[0][1], o[0][2], o[0][3]); w.y = pk4_fp8(o[1][0], o[1][1], o[1][2], o[1][3]); *(u32x2*)(at + (size_t)(ai * 128 + m * 16) * (DFF * 2) + lane_off) = w; }
            else store_bf16x8(at + (size_t)(ai * 128 + m * 16) * (DFF * 2) + lane_off, o[0], o[1]);
        }
}
struct EpiFfnUp {
    static constexpr bool PERM = true;
    const float* rowsq2; bf16* ACT; int pn_off;
    __device__ __forceinline__ void operator()(pg8::Acc& acc, const pg8::Unit& u, int wr, int wc, int fr, int fq, LAS unsigned char*) const { ffn_up_store(acc, rowsq2, ACT, u.pm, u.pn + pn_off, wr, wc, fr, fq); }
};
struct EpiFfnUpPair {
    static constexpr bool PERM = true;
    const float* rowsq2; bf16* ACT; int pn_off; int half; float* slab; unsigned* flag;
    __device__ __forceinline__ void operator()(pg8::Acc& acc, const pg8::Unit& u, int wr, int wc, int fr, int fq, LAS unsigned char*) const {
        const int tid = threadIdx.x;
        unsigned so = (unsigned)tid * 16u; asm volatile("" : "+v"(so));
        char* sb = (char*)slab;
        if (half) {
#pragma unroll
            for (int ai = 0; ai < 2; ++ai)
#pragma unroll
                for (int bj = 0; bj < 2; ++bj)
#pragma unroll
                    for (int m = 0; m < 4; ++m)
#pragma unroll
                        for (int n = 0; n < 2; ++n) *(f32x4*)(sb + (size_t)((((ai * 2 + bj) * 4 + m) * 2 + n) * 8192) + so) = acc[ai][bj][m][n];
            asm volatile("s_waitcnt vmcnt(0)" ::: "memory");
            __builtin_amdgcn_s_barrier(); asm volatile("" ::: "memory");
            if (tid == 0) { __builtin_amdgcn_fence(__ATOMIC_RELEASE, "agent"); asm volatile("s_waitcnt vmcnt(0)" ::: "memory"); __hip_atomic_store(flag, 1u, __ATOMIC_RELAXED, __HIP_MEMORY_SCOPE_AGENT); }
        } else {
            if (tid < 64) {
                unsigned spins = 0;
                while ((unsigned)__builtin_amdgcn_readfirstlane(__hip_atomic_load(flag, __ATOMIC_RELAXED, __HIP_MEMORY_SCOPE_AGENT)) == 0u) { __builtin_amdgcn_s_sleep(2); if (++spins > (1u << 24)) break; }
                __builtin_amdgcn_fence(__ATOMIC_ACQUIRE, "agent");
                asm volatile("s_waitcnt vmcnt(0)" ::: "memory");
            }
            asm volatile("" ::: "memory"); __builtin_amdgcn_s_barrier(); asm volatile("" ::: "memory");
#pragma unroll
            for (int ai = 0; ai < 2; ++ai)
#pragma unroll
                for (int bj = 0; bj < 2; ++bj)
#pragma unroll
                    for (int m = 0; m < 4; ++m) {
#pragma unroll
                        for (int n = 0; n < 2; ++n) acc[ai][bj][m][n] += *(const f32x4*)(sb + (size_t)((((ai * 2 + bj) * 4 + m) * 2 + n) * 8192) + so);
                        asm volatile("" ::: "memory");
                    }
            ffn_up_store(acc, rowsq2, ACT, u.pm, u.pn + pn_off, wr, wc, fr, fq);
        }
    }
};
struct EpiFfnDown {
    static constexpr bool PERM = false;
    const bf16* X1B; float* OUT;
    __device__ __forceinline__ void operator()(pg8::Acc& acc, const pg8::Unit& u, int wr, int wc, int fr, int fq, LAS unsigned char*) const {
        unsigned lo = (unsigned)((wr * 64 + fr) * 2048 + wc * 32 + fq * 4) * 4u; asm volatile("" : "+v"(lo));
        const size_t tile = ((size_t)u.pm * 256 * 2048 + (size_t)u.pn * 256) * 4;
        const char* st = (const char*)X1B + tile / 2; char* ot = (char*)OUT + tile;
#pragma unroll
        for (int ai = 0; ai < 2; ++ai)
#pragma unroll
            for (int m = 0; m < 4; ++m) {
                const size_t ro = (size_t)(ai * 128 + m * 16) * 8192;
#pragma unroll
                for (int bj = 0; bj < 2; ++bj)
#pragma unroll
                    for (int n = 0; n < 2; ++n) __builtin_nontemporal_store(ld_bf16x4((const bf16*)(st + ro / 2 + (lo >> 1) + bj * 256 + n * 32)) + acc[ai][bj][m][n], (f32x4*)(ot + ro + lo + bj * 512 + n * 64));
            }
    }
};

__device__ __forceinline__ void kiwi_issue(const bf16* H1r, const bf16* Wr, int kc, LAS unsigned char* buf, int wave, int lane) {
    const int sub = lane >> 4, pos = lane & 15;
#pragma unroll
    for (int j = 0; j < 4; ++j) {
        const int rowi = 4 * (wave + 8 * j) + sub;
        const bf16* base = (j == 0) ? H1r + (size_t)rowi * 2048 : Wr + (size_t)(rowi - 32) * 2048;
        __builtin_amdgcn_global_load_lds((const unsigned*)(base + kc * 128 + ((pos ^ (rowi & 15)) * 8)), (LAS unsigned*)(buf + (wave + 8 * j) * 1024), 16, 0, 0);
    }
}
__device__ __forceinline__ void kiwi_unit(int rb, const bf16* H1, const bf16* WIN, const float* gki, bf16* KI, float* WI, LAS unsigned char* lds, int wave, int lane) {
    const int r = lane & 31, hs = lane >> 5;
    const bf16* H1r = H1 + (size_t)(rb * 32) * 2048; const bf16* Wr = WIN + (size_t)10240 * 2048;
    f32x16 acc[3];
#pragma unroll
    for (int cb = 0; cb < 3; ++cb)
#pragma unroll
        for (int i = 0; i < 16; ++i) acc[cb][i] = 0.f;
    kiwi_issue(H1r, Wr, 0, lds, wave, lane); kiwi_issue(H1r, Wr, 1, lds + 32768, wave, lane); kiwi_issue(H1r, Wr, 2, lds + 65536, wave, lane);
    asm volatile("s_waitcnt vmcnt(8)" ::: "memory"); LDS_BARRIER();
    const unsigned fbase = (unsigned)(r * 256 + (((2 * wave + hs) ^ (r & 15)) << 4));
#pragma unroll 1
    for (int kc = 0; kc < 16; ++kc) {
        LAS unsigned char* cur = lds + (kc & 3) * 32768;
        if (kc + 3 < 16) kiwi_issue(H1r, Wr, kc + 3, lds + ((kc + 3) & 3) * 32768, wave, lane);
        const bf16x8 a = *(const LAS bf16x8*)(cur + fbase);
#pragma unroll
        for (int cb = 0; cb < 3; ++cb) { const bf16x8 bfr = *(const LAS bf16x8*)(cur + (32 + 32 * cb) * 256 + fbase); acc[cb] = __builtin_amdgcn_mfma_f32_32x32x16_bf16(a, bfr, acc[cb], 0, 0, 0); }
        if (kc + 3 < 16) asm volatile("s_waitcnt vmcnt(8)" ::: "memory"); else if (kc + 2 < 16) asm volatile("s_waitcnt vmcnt(4)" ::: "memory"); else asm volatile("s_waitcnt vmcnt(0)" ::: "memory");
        LDS_BARRIER();
    }
    LAS float* part = (LAS float*)lds;
#pragma unroll
    for (int cb = 0; cb < 3; ++cb)
#pragma unroll
        for (int i = 0; i < 16; ++i) part[(wave * 48 + cb * 16 + i) * 64 + lane] = acc[cb][i];
    LDS_BARRIER();
#pragma unroll
    for (int ii = 0; ii < 2; ++ii) {
        const int i = 2 * wave + ii; float v[3];
#pragma unroll
        for (int cb = 0; cb < 3; ++cb) { float s = 0.f;
#pragma unroll
            for (int w = 0; w < 8; ++w) s += part[(w * 48 + cb * 16 + i) * 64 + lane];
            v[cb] = s; }
        float ss = v[0] * v[0] + v[1] * v[1];
        ss += __shfl_xor(ss, 1); ss += __shfl_xor(ss, 2); ss += __shfl_xor(ss, 4); ss += __shfl_xor(ss, 8); ss += __shfl_xor(ss, 16);
        const float rs = 1.0f / sqrtf(ss * (1.0f / 64.0f) + EPS);
        const size_t row = (size_t)(rb * 32 + rowoff16(i) + 4 * hs);
        KI[row * 64 + r] = (bf16)f2bf(v[0] * rs * gki[r]); KI[row * 64 + 32 + r] = (bf16)f2bf(v[1] * rs * gki[32 + r]);
        if (r < 16) WI[row * 16 + r] = v[2];
    }
    LDS_BARRIER();
}

constexpr int W8_FLAG = 0x10000;
__device__ __forceinline__ int rowmap(int mode, int n) {
    if (mode == 1) {
        if (n < 2048) return FP8_QK ? (W8_FLAG | (6144 + n)) : n;
        if (n < 3072) return W8_FLAG | (4096 + (n - 2048));
        if (n < 4096) return (FP8_QK ? 0 : 2048) + (n - 3072);
        if (n < 4160) return 10240 + (n - 4096); if (n < 4176) return 10240 + 64 + (n - 4160);
        if (n < 5200) return (FP8_QK ? 1024 : 3072) + (n - 4176);
        if (n < 6224) return W8_FLAG | (5120 + (n - 5200));
        const int j = n - 6224, gb = j >> 11, c = j & 2047; return W8_FLAG | ((c >> 7) * 256 + gb * 128 + (c & 127)); }
    if (mode == 4) return W8_FLAG | n;
    if (mode == 2) return (n >> 7) * 256 + (n & 127);
    if (mode == 3) return (n >> 7) * 256 + 128 + (n & 127);
    return n;
}
constexpr int P0_PITCH = 68, P0_WAVE_BYTES = 64 * P0_PITCH * 4;
__device__ __forceinline__ void p0_transpose_item(const float* W, int N, bf16* WT, int ldk, int koff, int mode, const float* kscale, LAS float* scr, int item, int lane, unsigned char* W8 = nullptr, int pitch8 = 2048) {
    const int nblk = (N + 63) / 64, kb = item / nblk, nb = item % nblk, k0 = 64 * kb, n0 = 64 * nb;
    const int kr = lane >> 4, nc = lane & 15; const bool ok = (n0 + 4 * nc) < N;
    const float* wp = W + (size_t)(k0 + kr) * N + n0 + 4 * nc;
    f32x4 v[16];
#pragma unroll
    for (int i = 0; i < 16; ++i) v[i] = ok ? __builtin_nontemporal_load((const f32x4*)(wp + (size_t)(4 * i) * N)) : (f32x4){0.f, 0.f, 0.f, 0.f};
#pragma unroll
    for (int i = 0; i < 16; ++i) *(LAS f32x4*)(scr + (4 * i + kr) * P0_PITCH + 4 * nc) = v[i];
    LDS_WAIT(); asm volatile("" ::: "memory");
    const int c = lane & 7, ng = lane >> 3;
    f32x4 ks0 = (f32x4){1.f, 1.f, 1.f, 1.f}, ks1 = ks0;
    if (kscale) { ks0 = *(const f32x4*)(kscale + k0 + 8 * c); ks1 = *(const f32x4*)(kscale + k0 + 8 * c + 4); }
#pragma unroll
    for (int j = 0; j < 2; ++j) {
        const int nn = 4 * (ng + 8 * j);
        f32x4 r[8];
#pragma unroll
        for (int kk = 0; kk < 8; ++kk) r[kk] = *(const LAS f32x4*)(scr + (8 * c + kk) * P0_PITCH + nn) * (kk < 4 ? ks0[kk] : ks1[kk - 4]);
        const int rm = (n0 + nn < N) ? rowmap(mode, n0 + nn) : 0;
        if (((mode == 1 || mode == 4) && (rm & W8_FLAG)) || (mode == 5 && k0 < FFN_KF)) {
            {
                unsigned char* op8 = W8 + (size_t)(rm & (W8_FLAG - 1)) * pitch8 + k0 + 8 * c;
#pragma unroll
                for (int e = 0; e < 4; ++e) { u32x2 o; o.x = pk4_fp8(r[0][e] * GATE_WSCALE, r[1][e] * GATE_WSCALE, r[2][e] * GATE_WSCALE, r[3][e] * GATE_WSCALE); o.y = pk4_fp8(r[4][e] * GATE_WSCALE, r[5][e] * GATE_WSCALE, r[6][e] * GATE_WSCALE, r[7][e] * GATE_WSCALE); __builtin_nontemporal_store(o, (u32x2*)(op8 + (size_t)e * pitch8)); }
            }
        } else if (n0 + nn < N) {
            bf16* op = WT + (size_t)rm * ldk + koff + k0 + 8 * c;
#pragma unroll
            for (int e = 0; e < 4; ++e) { u32x4 o; o.x = pk2(r[0][e], r[1][e]); o.y = pk2(r[2][e], r[3][e]); o.z = pk2(r[4][e], r[5][e]); o.w = pk2(r[6][e], r[7][e]); __builtin_nontemporal_store(o, (u32x4*)(op + (size_t)e * ldk)); }
        }
    }
    LDS_WAIT(); asm volatile("" ::: "memory");
}
__device__ __forceinline__ void p0_prologue(const Ptrs& P, LAS unsigned char* lds, int vcu, int G) {
    const int tid = threadIdx.x, lane = tid & 63, wave = __builtin_amdgcn_readfirstlane(tid >> 6);
    unsigned char* ws = P.ws;
    LAS float* scr = (LAS float*)(lds + wave * P0_WAVE_BYTES);
    const int gw = vcu * 8 + wave, NGW = G * 8;
    bf16* WIN = (bf16*)(ws + WS_WIN); bf16* WAB = (bf16*)(ws + WS_WAB); bf16* WOUT = (bf16*)(ws + WS_WOUT); bf16* W1 = (bf16*)(ws + WS_W1); bf16* W2 = (bf16*)(ws + WS_W2);
    unsigned char* H1F8 = (unsigned char*)P.out + OUT_H1F8; unsigned char* W8 = (unsigned char*)P.out + OUT_W8;
    constexpr int I_IN = 32 * 162, I_A = 16 * 32, I_O = 32 * 32, I_G = 32 * 88, I_D = 88 * 32;
    constexpr int NITEMS = I_IN + 2 * I_A + I_O + 2 * I_G + I_D;
    for (int it = gw; it < NITEMS; it += NGW) {
        int r = it;
        if (r < I_IN) { p0_transpose_item(P.w_in, DIN, WIN, 2048, 0, 1, nullptr, scr, r, lane, W8); continue; } r -= I_IN;
        if (r < I_A) { p0_transpose_item(P.w_proj_a, 2048, WAB, 2048, 0, 4, nullptr, scr, r, lane, (unsigned char*)WAB, 4096); continue; } r -= I_A;
        if (r < I_A) { p0_transpose_item(P.w_proj_b, 2048, WAB, 2048, 1024, 0, nullptr, scr, r, lane); continue; } r -= I_A;
        if (r < I_O) { p0_transpose_item(P.w_out, 2048, WOUT, 2048, 0, 0, nullptr, scr, r, lane); continue; } r -= I_O;
        if (r < I_G) { p0_transpose_item(P.w_gate, DFF, W1, 2048, 0, 2, P.norm2_g, scr, r, lane); continue; } r -= I_G;
        if (r < I_G) { p0_transpose_item(P.w_up, DFF, W1, 2048, 0, 3, P.norm2_g, scr, r, lane); continue; } r -= I_G;
        p0_transpose_item(P.w_down, 2048, W2, DFF, 0, 5, nullptr, scr, r, lane, (unsigned char*)W2, DFF * 2);
    }
    for (int rr = DIN + gw; rr < NIN; rr += NGW) { u32x4* p = (u32x4*)(WIN + (size_t)rr * 2048); for (int j = lane; j < 256; j += 64) p[j] = (u32x4){0u, 0u, 0u, 0u}; }
    bf16* H1 = (bf16*)(ws + WS_H1);
    for (int m = gw; m < MTOK; m += NGW) {
        const f32x4* xr = (const f32x4*)(P.x + (size_t)m * DM) + lane; const f32x4* gr = (const f32x4*)P.norm1_g + lane;
        f32x4 v[8]; float s = 0.f;
#pragma unroll
        for (int j = 0; j < 8; ++j) { v[j] = __builtin_nontemporal_load(xr + 64 * j); s += (v[j][0] * v[j][0] + v[j][1] * v[j][1]) + (v[j][2] * v[j][2] + v[j][3] * v[j][3]); }
        const float rs = 1.0f / sqrtf(wave_sum(s) * (1.0f / DM) + EPS);
        u32x2* o = (u32x2*)(H1 + (size_t)m * DM) + lane; unsigned* o8 = (unsigned*)(H1F8 + (size_t)m * DM) + lane;
#pragma unroll
        for (int j = 0; j < 8; ++j) { const f32x4 gg = gr[64 * j]; const float h0 = v[j][0] * rs * gg[0], h1 = v[j][1] * rs * gg[1], h2 = v[j][2] * rs * gg[2], h3 = v[j][3] * rs * gg[3];
            u32x2 w; w.x = pk2(h0, h1); w.y = pk2(h2, h3); __builtin_nontemporal_store(w, o + 64 * j); __builtin_nontemporal_store(pk4_fp8(h0, h1, h2, h3), o8 + 64 * j); }
    }
    const int gt = vcu * 512 + tid, NGT = G * 512;
    bf16* WSP = (bf16*)(ws + WS_WSP); float* TBL = (float*)(ws + WS_TBL);
    for (int i = gt; i < NG * CHUNK * CHUNK; i += NGT) { const int s = i & 127, t = (i >> 7) & 127; WSP[i] = (bf16)f2bf(s <= t ? P.w_spatial[i] : 0.f); }
    for (int i = gt; i < NH * 132; i += NGT) { const int h = i / 132, d = i % 132; const int bk = d < 128 ? (int)T5_BUCKET[d] : 31; TBL[i] = P.rel_bias[bk * NH + h] * LOG2E; }
}

constexpr int IDX_ROW = 2048, IDX_WAVE_BYTES = 2 * IDX_ROW * 4;
__device__ __forceinline__ float half_min(float v) { v = fminf(v, __shfl_xor(v, 1)); v = fminf(v, __shfl_xor(v, 2)); v = fminf(v, __shfl_xor(v, 4)); v = fminf(v, __shfl_xor(v, 8)); return fminf(v, __shfl_xor(v, 16)); }
__device__ __forceinline__ float half_max(float v) { v = fmaxf(v, __shfl_xor(v, 1)); v = fmaxf(v, __shfl_xor(v, 2)); v = fmaxf(v, __shfl_xor(v, 4)); v = fmaxf(v, __shfl_xor(v, 8)); return fmaxf(v, __shfl_xor(v, 16)); }
__device__ __forceinline__ void indexer_unit(int b, int tb, const bf16* QI, const bf16* KI, const float* WI, unsigned* MASK, LAS unsigned char* lds, int wave, int lane, int mode = 0) {
    const int r = lane & 31, hs = lane >> 5;
    const int qa = tb * 16 + 2 * wave;
    const int cmax = (qa + 1) >> 5;
    const int aq = qa + ((r >> 2) & 1), ah = (r & 3) + 4 * (r >> 3);
    const bf16* ap = QI + ((size_t)(b * SEQ + aq)) * 1024 + ah * 64 + 8 * hs;
    bf16x8 af[4];
#pragma unroll
    for (int kk = 0; kk < 4; ++kk) af[kk] = *(const bf16x8*)(ap + 16 * kk);
    const int myq = qa + hs;
    const f32x4* wp = (const f32x4*)(WI + (size_t)(b * SEQ + myq) * 16);
    float wg[16];
#pragma unroll
    for (int j = 0; j < 4; ++j) { const f32x4 t = wp[j]; wg[4 * j] = t[0]; wg[4 * j + 1] = t[1]; wg[4 * j + 2] = t[2]; wg[4 * j + 3] = t[3]; }
    const bf16* kib = KI + (size_t)(b * SEQ) * 64;
    const unsigned kio = (unsigned)((8 * wave + (lane >> 3)) * 64 + (((lane & 7) ^ (((8 * wave + (lane >> 3)) >> 1) & 7)) * 8)) * 2u;
#define IDX_ISSUE(ch, buf) do { _Pragma("unroll") for (int _j = 0; _j < 4; ++_j) \
        __builtin_amdgcn_global_load_lds((const unsigned*)((const char*)kib + (size_t)(ch) * 32768 + (size_t)_j * 8192 + kio), (LAS unsigned*)((buf) + (wave + 8 * _j) * 1024), 16, 0, 0); } while (0)
    const unsigned fb = (unsigned)(r * 128 + ((((r >> 1) & 7) ^ hs) << 4));
    float u[64];
    float mn4[4] = {INFINITY, INFINITY, INFINITY, INFINITY}, mx4[4] = {-INFINITY, -INFINITY, -INFINITY, -INFINITY};
    if (mode != 2) {
        IDX_ISSUE(0, lds);
        if (8 <= cmax) { IDX_ISSUE(1, lds + 32768); asm volatile("s_waitcnt vmcnt(4)" ::: "memory"); } else asm volatile("s_waitcnt vmcnt(0)" ::: "memory");
        LDS_BARRIER();
    }
#pragma unroll
    for (int ch = 0; ch < 8; ++ch) {
        if (8 * ch <= cmax && mode != 2) {
            LAS unsigned char* cur = lds + (ch % 3) * 32768;
            const bool ahead = (ch + 2 < 8) && (8 * (ch + 2) <= cmax);
            if (ahead) IDX_ISSUE(ch + 2, lds + ((ch + 2) % 3) * 32768);
#pragma unroll
            for (int j = 0; j < 8; ++j) {
                const int c = 8 * ch + j;
                {
                    f32x16 acc;
#pragma unroll
                    for (int i = 0; i < 16; ++i) acc[i] = 0.f;
#pragma unroll
                    for (int kk = 0; kk < 4; ++kk) { const bf16x8 kf = *(const LAS bf16x8*)(cur + j * 4096 + (fb ^ (unsigned)(kk << 5))); acc = __builtin_amdgcn_mfma_f32_32x32x16_bf16(af[kk], kf, acc, 0, 0, 0); }
                    float s4[4] = {0.f, 0.f, 0.f, 0.f};
#pragma unroll
                    for (int i = 0; i < 16; ++i) { const float av = acc[i]; const int rb = __float_as_int(av); s4[i & 3] += wg[i] * __int_as_float(rb > 0 ? rb : 0); }
                    const float sv = (s4[0] + s4[1]) + (s4[2] + s4[3]); const bool ok = (32 * c + r <= myq);
                    u[c] = ok ? sv : -INFINITY; mx4[j & 3] = fmaxf(mx4[j & 3], ok ? sv : -INFINITY); mn4[j & 3] = fminf(mn4[j & 3], ok ? sv : INFINITY);
                }
            }
            if (ahead) asm volatile("s_waitcnt vmcnt(4)" ::: "memory"); else asm volatile("s_waitcnt vmcnt(0)" ::: "memory");
            LDS_BARRIER();
        } else {
#pragma unroll
            for (int j = 0; j < 8; ++j) u[8 * ch + j] = -INFINITY;
        }
    }
#undef IDX_ISSUE
    if (mode == 1) return;
    float T = -3.0e38f;
    if (qa >= 256) {
        float L = half_min(fminf(fminf(mn4[0], mn4[1]), fminf(mn4[2], mn4[3]))), H = half_max(fmaxf(fmaxf(mx4[0], mx4[1]), fmaxf(mx4[2], mx4[3])));
        bool done0 = false, done1 = false;
        for (int it = 0; it < 48; ++it) {
            const float mid = 0.5f * L + 0.5f * H;
            int cn4[4] = {0, 0, 0, 0};
#pragma unroll
            for (int g = 0; g < 8; ++g)
                if (8 * g <= cmax) {
#pragma unroll
                    for (int j = 0; j < 8; ++j) cn4[j & 3] += (u[8 * g + j] >= mid) ? 1 : 0;
                }
            int cnt = (cn4[0] + cn4[1]) + (cn4[2] + cn4[3]);
            cnt += __builtin_amdgcn_update_dpp(0, cnt, 0xB1, 0xF, 0xF, true);
            cnt += __builtin_amdgcn_update_dpp(0, cnt, 0x4E, 0xF, 0xF, true);
            cnt += __builtin_amdgcn_update_dpp(0, cnt, 0x141, 0xF, 0xF, true);
            cnt += __builtin_amdgcn_update_dpp(0, cnt, 0x140, 0xF, 0xF, true);
            const int c0 = __builtin_amdgcn_readlane(cnt, 0) + __builtin_amdgcn_readlane(cnt, 16);
            const int c1 = __builtin_amdgcn_readlane(cnt, 32) + __builtin_amdgcn_readlane(cnt, 48);
            const int mine = hs ? c1 : c0; const bool mydone = hs ? done1 : done0;
            if (!mydone) { if (mine == 256) T = mid; else if (mine > 256) L = mid; else H = mid; }
            done0 |= (c0 == 256); done1 |= (c1 == 256);
            if (done0 && done1) break;
        }
        if (!(hs ? done1 : done0)) T = L;
    }
    unsigned wl4[4] = {0u, 0u, 0u, 0u}, wh4[4] = {0u, 0u, 0u, 0u};
#pragma unroll
    for (int g = 0; g < 8; ++g)
        if (8 * g <= cmax) {
#pragma unroll
            for (int j = 0; j < 8; ++j) {
                const int c = 8 * g + j;
                const unsigned long long bal = __ballot(u[c] >= T);
                const unsigned blo = (unsigned)bal, bhi = (unsigned)(bal >> 32);
                asm volatile("s_nop 3\n\tv_writelane_b32 %0, %2, %4\n\tv_writelane_b32 %1, %3, %4" : "+v"(wl4[j & 3]), "+v"(wh4[j & 3]) : "s"(blo), "s"(bhi), "i"(c));
            }
            __builtin_amdgcn_sched_barrier(0);
        }
    const unsigned wlo = (wl4[0] | wl4[1]) | (wl4[2] | wl4[3]), whi = (wh4[0] | wh4[1]) | (wh4[2] | wh4[3]);
    MASK[(size_t)(b * SEQ + qa) * 64 + lane] = wlo; MASK[(size_t)(b * SEQ + qa + 1) * 64 + lane] = whi;
    LDS_WAIT();
}

__device__ __forceinline__ void sgu_unit(int b, int c, int g, const bf16* WSP, const bf16* VBT, const bf16* U, const float* rowsq_vb, float vbscale, const float* sgu_g, const float* bsp, bf16* OAB, LAS float* rsl, int wave, int lane) {
    const int tb = (wave >> 1) * 32, dblk = (wave & 1) * 64, r = lane & 31, hs = lane >> 5;
    LAS float* rw = rsl + wave * 128;
    const float q0 = rowsq_vb[b * SEQ + c * CHUNK + lane], q1 = rowsq_vb[b * SEQ + c * CHUNK + 64 + lane];
    f32x16 acc[2];
#pragma unroll
    for (int i = 0; i < 16; ++i) { acc[0][i] = 0.f; acc[1][i] = 0.f; }
    const int kkmax = 2 * (wave >> 1) + 1;
    u32x4 raw[8]; bf16x8 vfr[8][2];
#pragma unroll
    for (int kk = 0; kk < 8; ++kk)
        if (kk <= kkmax) {
            raw[kk] = *(const u32x4*)(WSP + (size_t)(g * CHUNK + tb + r) * CHUNK + 16 * kk + 8 * hs);
#pragma unroll
            for (int j2 = 0; j2 < 2; ++j2) vfr[kk][j2] = *(const bf16x8*)(VBT + ((size_t)(b * 1024 + g * 128 + dblk + 32 * j2 + r)) * 2048 + c * CHUNK + 16 * kk + 8 * hs);
        }
    const int t = tb + r; const size_t row = (size_t)(b * SEQ + c * CHUNK + t); const float bt = bsp[g * CHUNK + t];
    u32x2 uraw[2][4];
#pragma unroll
    for (int j2 = 0; j2 < 2; ++j2)
#pragma unroll
        for (int q4 = 0; q4 < 4; ++q4) uraw[j2][q4] = *(const u32x2*)(U + row * 1024 + g * 128 + dblk + 32 * j2 + 8 * q4 + 4 * hs);
    rw[lane] = 1.0f / sqrtf(q0 * vbscale + EPS); rw[64 + lane] = 1.0f / sqrtf(q1 * vbscale + EPS);
    LDS_WAIT();
#pragma unroll
    for (int kk = 0; kk < 8; ++kk)
        if (kk <= kkmax) {
            const LAS float* rp = rw + 16 * kk + 8 * hs;
            u32x4 sc;
            sc.x = pk2(bf2f(raw[kk].x & 0xffffu) * rp[0], bf2f(raw[kk].x >> 16) * rp[1]); sc.y = pk2(bf2f(raw[kk].y & 0xffffu) * rp[2], bf2f(raw[kk].y >> 16) * rp[3]);
            sc.z = pk2(bf2f(raw[kk].z & 0xffffu) * rp[4], bf2f(raw[kk].z >> 16) * rp[5]); sc.w = pk2(bf2f(raw[kk].w & 0xffffu) * rp[6], bf2f(raw[kk].w >> 16) * rp[7]);
            const bf16x8 wfr = __builtin_bit_cast(bf16x8, sc);
#pragma unroll
            for (int j2 = 0; j2 < 2; ++j2) acc[j2] = __builtin_amdgcn_mfma_f32_32x32x16_bf16(vfr[kk][j2], wfr, acc[j2], 0, 0, 0);
        }
#pragma unroll
    for (int j2 = 0; j2 < 2; ++j2)
#pragma unroll
        for (int q4 = 0; q4 < 4; ++q4) {
            const int d = g * 128 + dblk + 32 * j2 + 8 * q4 + 4 * hs;
            const f32x4 gd = *(const f32x4*)(sgu_g + d); const u32x2 uw = uraw[j2][q4]; f32x4 uv, o;
            uv[0] = bf2f(uw.x & 0xffffu); uv[1] = bf2f(uw.x >> 16); uv[2] = bf2f(uw.y & 0xffffu); uv[3] = bf2f(uw.y >> 16);
#pragma unroll
            for (int e = 0; e < 4; ++e) o[e] = uv[e] * (acc[j2][4 * q4 + e] * gd[e] + bt);
            store_bf16x4(OAB + row * 2048 + 1024 + d, o);
        }
    LDS_WAIT();
}

constexpr int AT_TILE = 16384, AT_BUF = 65536;
__device__ __forceinline__ void attn_issue(const bf16* Kg, const bf16* Vg, int s, LAS unsigned char* buf, int wave, unsigned voffK, unsigned voffV) {
#pragma unroll
    for (int tt = 0; tt < 2; ++tt)
#pragma unroll
        for (int j = 0; j < 2; ++j) {
            const int blk = wave + 8 * j;
            __builtin_amdgcn_global_load_lds((const unsigned*)((const char*)Kg + (size_t)(2 * s + tt) * 131072 + (size_t)j * 65536 + voffK), (LAS unsigned*)(buf + tt * AT_TILE + blk * 1024), 16, 0, 0);
            __builtin_amdgcn_global_load_lds((const unsigned*)((const char*)Vg + (size_t)(2 * s + tt) * 128 + (size_t)j * 262144 + voffV), (LAS unsigned*)(buf + 2 * AT_TILE + tt * AT_TILE + blk * 1024), 16, 0, 0);
        }
}
__device__ __forceinline__ void attn_unit(int b, int h, int iq, const bf16* Q, const bf16* K, const bf16* VT, const unsigned* MASK, const LAS float* tbl, bf16* OAB, LAS unsigned char* lds, int wave, int lane, int par, bool have_tile0, bool prefetch_next, bf16x8 (&qfx)[8], u32x2& mwx, int iq_next) {
    const int tid = threadIdx.x, qg = wave & 3, kg = wave >> 2, r = lane & 31, hs = lane >> 5;
    const int qw = 128 * iq + 32 * qg;
    const size_t qrow = (size_t)(b * SEQ + qw + r);
    const bf16* Kg = K + (size_t)(b * SEQ) * 1024 + h * HD;
    const bf16* Vg = VT + (size_t)(b * 1024 + h * HD) * 2048;
    const int nsteps = iq + 1;
    const int rq = 4 * wave + (lane >> 4);
    const unsigned voffK = (unsigned)(rq * 1024 + (((lane & 15) ^ (rq & 15)) * 8)) * 2u;
    const unsigned voffV = (unsigned)((8 * wave + (lane >> 3)) * 2048 + (((lane & 7) ^ (rq & 7)) * 8)) * 2u;
    if (!have_tile0) attn_issue(Kg, Vg, 0, lds + (par & 1) * AT_BUF, wave, voffK, voffV);
    bf16x8 qf[8]; u32x2 mw;
    if (have_tile0) {
#pragma unroll
        for (int kk = 0; kk < 8; ++kk) qf[kk] = qfx[kk];
        mw = mwx;
    } else {
#pragma unroll
        for (int kk = 0; kk < 8; ++kk) qf[kk] = *(const bf16x8*)(Q + qrow * 1024 + h * HD + 16 * kk + 8 * hs);
        mw = *(const u32x2*)(MASK + qrow * 64 + 2 * kg);
    }
    f32x16 o[4];
#pragma unroll
    for (int db = 0; db < 4; ++db)
#pragma unroll
        for (int i = 0; i < 16; ++i) o[db][i] = 0.f;
    float mref = 0.f, lrun = 0.f;
    const float c31 = tbl[128];
    const unsigned kbase = (unsigned)(r * 256 + (((r & 15) ^ hs) << 4));
    const unsigned vbase = (unsigned)(r * 128 + ((((r >> 1) & 7) ^ hs) << 4));
    AT_WAIT_BARRIER();
    for (int s = 0; s < nsteps; ++s) {
        LAS unsigned char* cur = lds + ((s + par) & 1) * AT_BUF; LAS unsigned char* nxt = lds + ((s + 1 + par) & 1) * AT_BUF;
        const bool more = (s + 1 < nsteps);
        if (more) attn_issue(Kg, Vg, s + 1, nxt, wave, voffK, voffV);
        else if (prefetch_next) attn_issue(Kg, Vg, 0, nxt, wave, voffK, voffV);
        const int t = 2 * s + kg;
        u32x2 mwn = mw;
        if (more) mwn = *(const u32x2*)(MASK + qrow * 64 + 2 * (t + 2));
        f32x16 p[2];
        const LAS unsigned char* Kt = cur + kg * AT_TILE;
        unsigned kofs = kbase; asm volatile("" : "+v"(kofs));
        const bool far = (qw - (64 * t + 63)) >= 113;
        if (far) {
            const int cb = __float_as_int(c31 - mref);
#pragma unroll
            for (int kb = 0; kb < 2; ++kb) {
                const int word = (int)((kb == 0 ? mw.x : mw.y) >> (4 * hs));
#pragma unroll
                for (int i = 0; i < 16; ++i) { const int tmask = __builtin_amdgcn_sbfe(word, rowoff16(i), 1); int rr; asm("v_bfi_b32 %0, %1, %2, %3" : "=v"(rr) : "v"(tmask), "v"(cb), "v"((int)0xFF800000)); p[kb][i] = __int_as_float(rr); }
            }
        } else {
            const int dist0 = (qw + r) - (64 * t + 4 * hs);
#pragma unroll
            for (int kb = 0; kb < 2; ++kb) {
                const int word = (int)((kb == 0 ? mw.x : mw.y) >> (4 * hs));
#pragma unroll
                for (int i = 0; i < 16; ++i) {
                    int di = dist0 - 32 * kb - rowoff16(i); di = di < 0 ? 0 : (di > 128 ? 128 : di);
                    const int cb = __float_as_int(tbl[di] - mref); const int tmask = __builtin_amdgcn_sbfe(word, rowoff16(i), 1); int rr;
                    asm("v_bfi_b32 %0, %1, %2, %3" : "=v"(rr) : "v"(tmask), "v"(cb), "v"((int)0xFF800000)); p[kb][i] = __int_as_float(rr);
                }
            }
        }
#pragma unroll
        for (int kb = 0; kb < 2; ++kb)
#pragma unroll
            for (int kk = 0; kk < 8; ++kk) {
                const bf16x8 kf = *(const LAS bf16x8*)(Kt + kb * 8192 + (kofs ^ (unsigned)(kk << 5)));
                p[kb] = __builtin_amdgcn_mfma_f32_32x32x16_bf16(kf, qf[kk], p[kb], 0, 0, 0);
            }
        float mx4[4] = {-INFINITY, -INFINITY, -INFINITY, -INFINITY};
#pragma unroll
        for (int kb = 0; kb < 2; ++kb)
#pragma unroll
            for (int i = 0; i < 16; ++i) { const float v = p[kb][i]; mx4[i & 3] = fmaxf(mx4[i & 3], v); }
        float mx = fmaxf(fmaxf(mx4[0], mx4[1]), fmaxf(mx4[2], mx4[3]));
        mx = fmaxf(mx, __shfl_xor(mx, 32));
        if (__any(mx > 8.0f)) {
            const float d = fmaxf(mx, 0.f), f = __builtin_amdgcn_exp2f(-d);
            mref += d; lrun *= f;
#pragma unroll
            for (int kb = 0; kb < 2; ++kb)
#pragma unroll
                for (int i = 0; i < 16; ++i) p[kb][i] -= d;
#pragma unroll
            for (int db = 0; db < 4; ++db)
#pragma unroll
                for (int i = 0; i < 16; ++i) o[db][i] *= f;
        }
        float ls4[4] = {0.f, 0.f, 0.f, 0.f};
#pragma unroll
        for (int kb = 0; kb < 2; ++kb)
#pragma unroll
            for (int i = 0; i < 16; ++i) { const float pv = p[kb][i]; const float e = __builtin_amdgcn_exp2f(pv); p[kb][i] = e; ls4[i & 3] += e; }
        lrun += (ls4[0] + ls4[1]) + (ls4[2] + ls4[3]);
        const LAS unsigned char* Vt = cur + 2 * AT_TILE + kg * AT_TILE;
        unsigned vofs = vbase; asm volatile("" : "+v"(vofs));
#pragma unroll
        for (int s4 = 0; s4 < 4; ++s4) {
            const int kb = s4 >> 1, e0 = 8 * (s4 & 1);
            u32x4 w; w.x = pk2(p[kb][e0], p[kb][e0 + 1]); w.y = pk2(p[kb][e0 + 2], p[kb][e0 + 3]); w.z = pk2(p[kb][e0 + 4], p[kb][e0 + 5]); w.w = pk2(p[kb][e0 + 6], p[kb][e0 + 7]);
            const bf16x8 pf = __builtin_bit_cast(bf16x8, w);
#pragma unroll
            for (int db = 0; db < 4; ++db) {
                const bf16x8 vf = *(const LAS bf16x8*)(Vt + db * 4096 + (vofs ^ (unsigned)((2 * s4) << 4)));
                o[db] = __builtin_amdgcn_mfma_f32_32x32x16_bf16(vf, pf, o[db], 0, 0, 0);
            }
        }
        mw = mwn;
        AT_WAIT_BARRIER();
    }
    if (prefetch_next) {
        const size_t qrow2 = (size_t)(b * SEQ + 128 * iq_next + 32 * qg + r);
#pragma unroll
        for (int kk = 0; kk < 8; ++kk) qfx[kk] = *(const bf16x8*)(Q + qrow2 * 1024 + h * HD + 16 * kk + 8 * hs);
        mwx = *(const u32x2*)(MASK + qrow2 * 64 + 2 * kg);
    }
    lrun += __shfl_xor(lrun, 32);
    LAS unsigned char* ebase = lds + ((nsteps - 1 + par) & 1) * AT_BUF;
    LAS unsigned* comb = (LAS unsigned*)(ebase + qg * 8704); LAS float* combf = (LAS float*)(ebase + qg * 8704 + 8192);
    if (kg == 1) {
#pragma unroll
        for (int db = 0; db < 4; ++db)
#pragma unroll
            for (int i2 = 0; i2 < 8; ++i2) comb[(db * 8 + i2) * 64 + lane] = pk2(o[db][2 * i2], o[db][2 * i2 + 1]);
        combf[lane] = mref; combf[64 + lane] = lrun;
    }
    LDS_BARRIER();
    if (kg == 0) {
        const float m1 = combf[lane], l1 = combf[64 + lane];
        const float mm = fmaxf(mref, m1);
        const float a0 = __builtin_amdgcn_exp2f(mref - mm), a1 = __builtin_amdgcn_exp2f(m1 - mm);
        const float inv = 1.0f / (lrun * a0 + l1 * a1);
        const float s0 = a0 * inv, s1 = a1 * inv;
        LAS unsigned char* stg = ebase + 34816 + qg * 4608;
#pragma unroll
        for (int db = 0; db < 4; ++db)
#pragma unroll
            for (int i4 = 0; i4 < 4; ++i4) {
                float v[4];
                const unsigned c01 = comb[(db * 8 + 2 * i4) * 64 + lane], c23 = comb[(db * 8 + 2 * i4 + 1) * 64 + lane];
                v[0] = o[db][4 * i4] * s0 + bf2f(c01 & 0xffffu) * s1; v[1] = o[db][4 * i4 + 1] * s0 + bf2f(c01 >> 16) * s1;
                v[2] = o[db][4 * i4 + 2] * s0 + bf2f(c23 & 0xffffu) * s1; v[3] = o[db][4 * i4 + 3] * s0 + bf2f(c23 >> 16) * s1;
                *(LAS unsigned*)(stg + r * 144 + (32 * db + 8 * i4 + 4 * hs)) = pk4_fp8(v[0] * OA_SCALE, v[1] * OA_SCALE, v[2] * OA_SCALE, v[3] * OA_SCALE);
            }
        LDS_WAIT();
#pragma unroll
        for (int j = 0; j < 4; ++j) {
            const int cid = lane + 64 * j, row = cid >> 3, ch = cid & 7;
            const u32x4 v = *(const LAS u32x4*)(stg + row * 144 + ch * 16);
            *(u32x4*)((unsigned char*)OAB + ((size_t)(b * SEQ + qw + row)) * 4096 + h * HD + ch * 16) = v;
        }
    }
    LDS_BARRIER();
}

#define XB_TMO      128
#define XB_XCNT(j)  (256  + 64 * (j))
#define XB_XSUB(j)  (1280 + 64 * (j))
#define XB_XGEN(j)  (2304 + 64 * (j))
#define XB_TOP      3328
#define XB_TOPGEN   3392
#define XCD_BAR_WORDS 3456
#define XB_SPIN_CAP (1u << 22)
__device__ __forceinline__ unsigned xb_ld(unsigned* p)              { return __hip_atomic_load(p, __ATOMIC_RELAXED, __HIP_MEMORY_SCOPE_AGENT); }
__device__ __forceinline__ unsigned xb_add(unsigned* p, unsigned v) { return __hip_atomic_fetch_add(p, v, __ATOMIC_RELAXED, __HIP_MEMORY_SCOPE_AGENT); }
__device__ __forceinline__ unsigned xb_xcc_id() { return (unsigned)__builtin_amdgcn_s_getreg((3 << 11) | 20) & 0xFu; }
#define XB_SPIN(cond, bar) do { unsigned _sp = 0; while (cond) { __builtin_amdgcn_s_sleep(1); \
    if ((++_sp & 255u) == 0u) { if (xb_ld(&(bar)[XB_TMO])) break; if (_sp > XB_SPIN_CAP) { atomicAdd(&(bar)[XB_TMO], 1u); break; } } } } while (0)
struct XcdBarrier { unsigned* bar; unsigned x; volatile LAS unsigned* st; };
__device__ __forceinline__ XcdBarrier xcd_barrier_post(unsigned* bar, volatile LAS unsigned* st) {
    XcdBarrier b; b.bar = bar; b.x = xb_xcc_id(); b.st = st;
    if (threadIdx.x == 0) (void)xb_add(&bar[XB_XCNT(b.x)], 1u);
    return b;
}
__device__ __forceinline__ void xcd_barrier_complete(unsigned* bar, unsigned x, unsigned& nloc, unsigned& nx) {
    const unsigned G = gridDim.x * gridDim.y * gridDim.z;
    unsigned sum, cnt, mine, sp = 0u;
    for (;;) {
        sum = 0u; cnt = 0u; mine = 0u;
#pragma unroll
        for (unsigned j = 0; j < 16; ++j) { const unsigned c = xb_ld(&bar[XB_XCNT(j)]); sum += c; cnt += (c > 0u) ? 1u : 0u; mine = (j == x) ? c : mine; }
        if (sum == G) break;
        __builtin_amdgcn_s_sleep(1);
        if ((++sp & 255u) == 0u) { if (xb_ld(&bar[XB_TMO])) break; if (sp > XB_SPIN_CAP) { atomicAdd(&bar[XB_TMO], 1u); break; } }
    }
    nloc = mine > 0u ? mine : 1u; nx = cnt > 0u ? cnt : 1u;
}
__device__ __forceinline__ void xcd_barrier(const XcdBarrier& b) {
    asm volatile("s_waitcnt vmcnt(0)" ::: "memory");
    __syncthreads();
    if (threadIdx.x == 0) {
        unsigned* bar = b.bar;
        __builtin_amdgcn_s_waitcnt(0);
        unsigned nloc = b.st[0], nx = b.st[1];
        if (nloc == 0u) { xcd_barrier_complete(bar, b.x, nloc, nx); b.st[0] = nloc; b.st[1] = nx; }
        const unsigned old = xb_add(&bar[XB_XSUB(b.x)], 1u);
        const unsigned gen = old / nloc;
        if (old + 1u == (gen + 1u) * nloc) {
            __builtin_amdgcn_fence(__ATOMIC_RELEASE, "agent");
            asm volatile("s_waitcnt vmcnt(0)" ::: "memory");
            const unsigned og = xb_add(&bar[XB_TOP], 1u);
            const unsigned tg = og / nx;
            if (og + 1u == (tg + 1u) * nx) xb_add(&bar[XB_TOPGEN], 1u);
            else XB_SPIN(xb_ld(&bar[XB_TOPGEN]) == tg, bar);
            __builtin_amdgcn_fence(__ATOMIC_ACQUIRE, "agent");
            xb_add(&bar[XB_XGEN(b.x)], 1u);
            asm volatile("s_waitcnt vmcnt(0)" ::: "memory");
        } else {
            XB_SPIN(xb_ld(&bar[XB_XGEN(b.x)]) == gen, bar);
            __builtin_amdgcn_fence(__ATOMIC_ACQUIRE, "agent");
            asm volatile("s_waitcnt vmcnt(0)" ::: "memory");
        }
    }
    __syncthreads();
}

struct Args { Ptrs p; int ph_lo, ph_hi, vbrep, mode; };
constexpr int NPHASE = 8;

__global__ void __launch_bounds__(512, 2) fwd(Args args) {
    extern __shared__ __attribute__((aligned(16))) unsigned char lds_raw[];
    LAS unsigned char* lds = (LAS unsigned char*)lds_raw;
    const Ptrs& P = args.p; unsigned char* ws = P.ws;
    const int tid = threadIdx.x, lane = tid & 63, wave = __builtin_amdgcn_readfirstlane(tid >> 6);
    const int G = gridDim.x, bx = blockIdx.x;
    const int vcu = (G % 8 == 0) ? (bx % 8) * (G / 8) + bx / 8 : bx;
    const int lo = args.ph_lo, hi = args.ph_hi;
#ifndef PHASE_MASK
#define PHASE_MASK 0xff
#endif
#define IN(k) (((PHASE_MASK >> (k)) & 1) && lo <= (k) && (k) < hi)
#if ONE_LAUNCH
    volatile LAS unsigned* bst = (volatile LAS unsigned*)(lds + LDS_BYTES - 64);
    if (tid < 16) bst[tid] = 0u;
    {
        unsigned* ctl = (unsigned*)(ws + WS_CTL);
        for (int i = bx * 512 + tid; i < (int)(CTL_BYTES / 4); i += G * 512) __hip_atomic_store(&ctl[i], 0u, __ATOMIC_RELAXED, __HIP_MEMORY_SCOPE_AGENT);
        asm volatile("s_waitcnt vmcnt(0)" ::: "memory");
    }
    __syncthreads();
    if (tid == 0) __builtin_amdgcn_fence(__ATOMIC_RELEASE, "agent");
    cg::this_grid().sync();
    XcdBarrier xbar = xcd_barrier_post((unsigned*)(ws + WS_CTL + CTL_BAR), bst);
#define SEAM(k) do { if (IN(k) && IN((k) + 1)) { xcd_barrier(xbar); if (NREP(13) == 2) xcd_barrier(xbar); } } while (0)
#else
#define SEAM(k) do { } while (0)
#endif
    bf16* WIN = (bf16*)(ws + WS_WIN); bf16* WAB = (bf16*)(ws + WS_WAB); bf16* WOUT = (bf16*)(ws + WS_WOUT); bf16* W1 = (bf16*)(ws + WS_W1); bf16* W2 = (bf16*)(ws + WS_W2);
    bf16* H1 = (bf16*)(ws + WS_H1); bf16* OAB = (bf16*)(ws + WS_OAB); bf16* ACT = (bf16*)(ws + WS_ACT);
    bf16* Qb = (bf16*)(ws + WS_Q); bf16* Kb = (bf16*)(ws + WS_K); bf16* VT = (bf16*)(ws + WS_VT); bf16* QI = (bf16*)(ws + WS_QI);
    bf16* Ub = (bf16*)(ws + WS_U); bf16* VBT = (bf16*)(ws + WS_VBT); bf16* X1B = (bf16*)(ws + WS_X1B); const unsigned char* GA = ws + WS_GA; const unsigned char* GB = ws + WS_GB;
    bf16* KI = (bf16*)(ws + WS_KI); float* WI = (float*)(ws + WS_WI); bf16* WSP = (bf16*)(ws + WS_WSP); float* TBL = (float*)(ws + WS_TBL);
    unsigned* MASK = (unsigned*)(ws + WS_MASK); bf16* MERGED = (bf16*)(ws + WS_MERGED);
    float* rowsq_vb = (float*)(ws + WS_CTL + CTL_ROWSQ_VB); float* rowsq2 = (float*)(ws + WS_CTL + CTL_ROWSQ2);

    if (IN(0)) for (int rep = 0; rep < NREP(0); ++rep) { p0_prologue(P, lds, vcu, G); }
    SEAM(0);
    if (IN(1)) for (int rep = 0; rep < NREP(1); ++rep) {
        { pg8::Gemm g{H1, WIN, MTOK, P1_NB16, DM, DM, DM}; pg8::StaticOrder S; S.init(MTOK, P1_NB16, G, bx);
          EpiIn<false> E{ws, P.q_norm_g, P.k_norm_g};
          pg8::gemm_phase<EpiIn<false>, pg8::NoMid, NREP(12)>(lds, g, S, E); }
        { pg8::Gemm g{(const pg8::bf16_t*)((const unsigned char*)P.out + OUT_H1F8), (const pg8::bf16_t*)((const unsigned char*)P.out + OUT_W8), MTOK, P1_NF8, DM / 2, DM / 2, DM / 2}; pg8::StaticOrder S; S.init(MTOK, P1_NF8, G, bx);
          EpiIn<true> E{ws, P.q_norm_g, P.k_norm_g};
          pg8::gemm_phase<EpiIn<true>, pg8::NoMid, 1, pg8::StaticOrder, true>(lds, g, S, E); }
        for (int rb = bx; rb < MTOK / 32; rb += G) kiwi_unit(rb, H1, WIN, P.idx_k_norm_g, KI, WI, lds, wave, lane);
    }
    SEAM(1);
    if (IN(2)) for (int rep = 0; rep < NREP(2); ++rep) {
        for (int r2 = 0; r2 < NREP(8); ++r2)
        for (int p = vcu; p < 256; p += G) { const int b = p >> 6, i = p & 63; indexer_unit(b, i, QI, KI, WI, MASK, lds, wave, lane, args.mode); indexer_unit(b, 127 - i, QI, KI, WI, MASK, lds, wave, lane, args.mode); }
        __syncthreads();
        if (args.mode == 0)
        for (int r2 = 0; r2 < NREP(9); ++r2)
        for (int un = vcu; un < 512; un += G) { const int b = un >> 7, c = (un >> 3) & 15, g = un & 7; sgu_unit(b, c, g, WSP, VBT, Ub, rowsq_vb, 1.0f / (float)(WBW * NREP(1) * NREP(12) * args.vbrep), P.sgu_norm_g, P.b_spatial, OAB, (LAS float*)(lds + SCR_OFF), wave, lane); }
    }
    SEAM(2);
    if (IN(3)) for (int rep = 0; rep < NREP(3); ++rep) {
        LAS float* tbl = (LAS float*)(lds + SCR_OFF);
        for (int p = vcu; p < 256; p += G) {
            const int b = p >> 6, h = (p >> 3) & 7, i = p & 7;
            __syncthreads();
            if (tid < 132) tbl[tid] = TBL[h * 132 + tid];
            __syncthreads();
            bf16x8 qfx[8]; u32x2 mwx;
            attn_unit(b, h, i, Qb, Kb, VT, MASK, tbl, OAB, lds, wave, lane, 0, false, true, qfx, mwx, 15 - i);
            attn_unit(b, h, 15 - i, Qb, Kb, VT, MASK, tbl, OAB, lds, wave, lane, (i + 1) & 1, true, false, qfx, mwx, 0);
        }
    }
    SEAM(3);
    if (IN(4)) for (int rep = 0; rep < NREP(4); ++rep) {
        pg8::Gemm g{OAB, WAB, MTOK, DM, 1536, DM, DM, 8}; pg8::StaticOrder S; S.init(MTOK, DM, G, bx);
        EpiMerge E{GB, MERGED}; MidMerge H{GA, GB, 1.0f / (GATE_WSCALE * OA_SCALE)}; pg8::gemm_phase<EpiMerge, MidMerge, 1, pg8::StaticOrder, 2>(lds, g, S, E, H);
    }
    SEAM(4);
    if (IN(5)) for (int rep = 0; rep < NREP(5); ++rep) {
        pg8::Gemm g{MERGED, WOUT, MTOK, DM, DM, DM, DM}; pg8::StaticOrder S; S.init(MTOK, DM, G, bx);
        EpiOut E{P.x, X1B, rowsq2}; pg8::gemm_phase(lds, g, S, E);
    }
    SEAM(5);
    if (IN(6)) for (int rep = 0; rep < NREP(6); ++rep) {
        { pg8::Gemm g{X1B, W1, MTOK, 10240, DM, DM, DM}; pg8::StaticOrder S; S.init(MTOK, 10240, G, bx); EpiFfnUp E{rowsq2, ACT, 0}; pg8::gemm_phase(lds, g, S, E); }
        if (G == 256) {
            const int xcd = bx & 7, idx = bx >> 3, t = xcd * 16 + (idx >> 1), half = idx & 1;
            pg8::Gemm g{X1B + half * 1024, W1 + (size_t)10240 * 2048 + half * 1024, MTOK, 1024, 1024, DM, DM}; pg8::OneUnit S{t >> 2, t & 3};
            EpiFfnUpPair E{rowsq2, ACT, 40, half, (float*)(ws + WS_SLAB) + (size_t)t * 65536, (unsigned*)(ws + WS_CTL + CTL_PAIR) + t * 16};
            pg8::gemm_phase<EpiFfnUpPair, pg8::NoMid, 1, pg8::OneUnit>(lds, g, S, E);
        } else {
            pg8::Gemm g{X1B, W1 + (size_t)10240 * 2048, MTOK, 1024, DM, DM, DM}; pg8::StaticOrder S; S.init(MTOK, 1024, G, bx); EpiFfnUp E{rowsq2, ACT, 40}; pg8::gemm_phase(lds, g, S, E);
        }
    }
    SEAM(6);
    if (IN(7)) for (int rep = 0; rep < NREP(7); ++rep) {
        pg8::Gemm g{ACT, W2, MTOK, DM, FFN_T8 * 64 + (DFF - FFN_KF), DFF, DFF, FFN_T8}; pg8::StaticOrder S; S.init(MTOK, DM, G, bx);
        EpiFfnDown E{X1B, P.out}; MidScale H{1.0f / GATE_WSCALE}; pg8::gemm_phase<EpiFfnDown, MidScale, 1, pg8::StaticOrder, 2>(lds, g, S, E, H);
    }
#undef IN
#undef SEAM
}

extern "C" void kernel_launch(void* const* d_in, const int* in_sizes, int n_in, void* d_out, int out_size, void* d_ws, size_t ws_size, hipStream_t stream) {
    static int grid = 0;
    if (grid == 0) {
        if (n_in != 17 || in_sizes[0] != MTOK * DM || out_size != MTOK * DM || ws_size < WS_END) { fprintf(stderr, "kernel_launch: unexpected shapes (n_in %d, in0 %d, out %d, ws %zu < %zu); nothing launched\n", n_in, n_in > 0 ? in_sizes[0] : -1, out_size, ws_size, (size_t)WS_END); grid = -1; return; }
        int dev = 0, cus = 0;
        if (hipGetDevice(&dev) != hipSuccess || hipDeviceGetAttribute(&cus, hipDeviceAttributeMultiprocessorCount, dev) != hipSuccess) { grid = -1; return; }
        if (hipFuncSetAttribute((const void*)fwd, hipFuncAttributeMaxDynamicSharedMemorySize, LDS_BYTES) != hipSuccess) { fprintf(stderr, "kernel_launch: hipFuncSetAttribute failed\n"); grid = -1; return; }
        int per_cu = 0;
        if (hipOccupancyMaxActiveBlocksPerMultiprocessor(&per_cu, (const void*)fwd, 512, LDS_BYTES) != hipSuccess || per_cu < 1) { fprintf(stderr, "kernel_launch: occupancy query says %d blocks per CU\n", per_cu); (void)hipGetLastError(); grid = -1; return; }
        grid = cus;
    }
    if (grid < 0) return;
#if !ONE_LAUNCH
    (void)hipMemsetAsync((char*)d_ws + WS_CTL, 0, CTL_BYTES, stream);
#endif
    Args a{};
    const float** pp = (const float**)&a.p;
    for (int i = 0; i < 17; ++i) pp[i] = (const float*)d_in[i];
    a.p.out = (float*)d_out; a.p.ws = (unsigned char*)d_ws;
#if ONE_LAUNCH
    a.ph_lo = 0; a.ph_hi = NPHASE; a.vbrep = 1; a.mode = 0;
    void* kargs[] = {&a};
    hipError_t e = hipLaunchCooperativeKernel((const void*)fwd, dim3(grid), dim3(512), kargs, LDS_BYTES, stream);
    if (e != hipSuccess) fprintf(stderr, "cooperative launch failed: %s (grid %d)\n", hipGetErrorString(e), grid);
#else
#ifndef ML_REP_PHASE
#define ML_REP_PHASE -1
#endif
    a.vbrep = (ML_REP_PHASE == 1) ? 2 : 1; a.mode = 0;
#ifndef ML_P2_MODE
#define ML_P2_MODE 0
#endif
    for (int ph = 0; ph < NPHASE; ++ph) { a.ph_lo = ph; a.ph_hi = ph + 1; if (ph == 2 && ML_P2_MODE) { a.mode = ML_P2_MODE; hipLaunchKernelGGL(fwd, dim3(grid), dim3(512), LDS_BYTES, stream, a); a.mode = 0; }
        for (int k = 0; k < ((ph == ML_REP_PHASE) ? 2 : 1); ++k) hipLaunchKernelGGL(fwd, dim3(grid), dim3(512), LDS_BYTES, stream, a); }
#endif
}
```

```cpp
#include <hip/hip_runtime.h>
#include <hip/hip_cooperative_groups.h>
#include <cstdio>
#include <cstdint>
namespace cg = cooperative_groups;

#ifndef ONE_LAUNCH
#define ONE_LAUNCH 1
#endif
#ifndef REP_MASK
#define REP_MASK 0
#endif
#define NREP(k) (((REP_MASK >> (k)) & 1) ? 2 : 1)

#define LAS __attribute__((address_space(3)))
typedef unsigned short bf16;
typedef short bf16x8 __attribute__((ext_vector_type(8)));
typedef float f32x4 __attribute__((ext_vector_type(4)));
typedef float f32x16 __attribute__((ext_vector_type(16)));
typedef unsigned u32x4 __attribute__((ext_vector_type(4)));
typedef unsigned u32x2 __attribute__((ext_vector_type(2)));
typedef int i32x4 __attribute__((ext_vector_type(4)));
typedef int i32x8 __attribute__((ext_vector_type(8)));

constexpr int NB = 4, SEQ = 2048, DM = 2048, MTOK = NB * SEQ;
constexpr int WA = 1024, NH = 8, HD = 128, NIH = 16, IDXD = 64, WBW = 1024, NG = 8, CHUNK = 128;
constexpr int DFF = 5632, DIN = 10320, NIN = 10496;
constexpr float EPS = 1e-6f;
constexpr float LOG2E = 1.4426950408889634f;

constexpr size_t MiB = 1u << 20;
constexpr size_t WS_CTL = 0, CTL_BYTES = 144 * 1024;
constexpr size_t WS_KI = 1 * MiB;
constexpr size_t WS_WI = 2 * MiB;
constexpr size_t WS_WSP = 2 * MiB + 512 * 1024, WS_TBL = 2 * MiB + 768 * 1024;
constexpr size_t WS_MASK = 3 * MiB;
constexpr size_t WS_WIN = 5 * MiB;
constexpr size_t WS_MERGED = 5 * MiB;
constexpr size_t WS_SLAB = 5 * MiB;
constexpr size_t WS_WAB = 46 * MiB;
constexpr size_t WS_WOUT = 54 * MiB;
constexpr size_t WS_W1 = 62 * MiB;
constexpr size_t WS_W2 = 106 * MiB;
constexpr size_t WS_H1 = 128 * MiB;
constexpr size_t WS_OAB = 128 * MiB;
constexpr size_t WS_ACT = 128 * MiB;
constexpr size_t WS_Q = 160 * MiB, WS_K = 176 * MiB, WS_VT = 192 * MiB, WS_QI = 208 * MiB;
constexpr size_t WS_U = 224 * MiB, WS_VBT = 240 * MiB;
constexpr size_t WS_X1B = 224 * MiB;
constexpr size_t WS_GA = 256 * MiB, WS_GB = 288 * MiB;
constexpr size_t WS_END = 320 * MiB;
constexpr size_t OUT_H1F8 = 0, OUT_W8 = 16 * MiB;
constexpr size_t CTL_ROWSQ_VB = 0, CTL_ROWSQ2 = 32768, CTL_BAR = 65536, CTL_SEAM2 = 98304, CTL_PAIR = 131072;

constexpr int RING_BYTES = 131072, SCR_OFF = RING_BYTES, LDS_BYTES = 147456;

__device__ const unsigned char T5_BUCKET[128] = {0, 1, 2, 3, 4, 5, 6, 7, 8, 9, 10, 11, 12, 13, 14, 15, 16, 16, 16, 17, 17, 18, 18, 18, 19, 19, 19, 20, 20, 20, 20, 21, 21, 21, 21, 22, 22, 22, 22, 22, 23, 23, 23, 23, 23, 23, 24, 24, 24, 24, 24, 24, 25, 25, 25, 25, 25, 25, 25, 26, 26, 26, 26, 26, 26, 26, 26, 27, 27, 27, 27, 27, 27, 27, 27, 27, 27, 28, 28, 28, 28, 28, 28, 28, 28, 28, 28, 29, 29, 29, 29, 29, 29, 29, 29, 29, 29, 29, 29, 30, 30, 30, 30, 30, 30, 30, 30, 30, 30, 30, 30, 30, 30, 31, 31, 31, 31, 31, 31, 31, 31, 31, 31, 31, 31, 31, 31, 31};

__device__ __forceinline__ unsigned f2bf(float f) { unsigned u = __builtin_bit_cast(unsigned, f); return (u + 0x7fffu + ((u >> 16) & 1u)) >> 16; }
typedef float f32x2_t __attribute__((ext_vector_type(2))); typedef __bf16 bf16x2_t __attribute__((ext_vector_type(2)));
__device__ __forceinline__ unsigned pk2(float lo, float hi) { f32x2_t v = {lo, hi}; bf16x2_t b = __builtin_convertvector(v, bf16x2_t); return __builtin_bit_cast(unsigned, b); }
__device__ __forceinline__ float bf2f(unsigned v) { return __builtin_bit_cast(float, v << 16); }
__device__ __forceinline__ float sigmoidf_(float x) { return __builtin_amdgcn_rcpf(1.0f + __builtin_amdgcn_exp2f(-x * LOG2E)); }
__device__ __forceinline__ float gelu_tanh(float x) { const float t = x * (1.0f + 0.044715f * x * x) * (2.0f * 0.7978845608028654f); return x * sigmoidf_(t); }
__device__ __forceinline__ float wave_sum(float v) {
#pragma unroll
    for (int o = 1; o < 64; o <<= 1) v += __shfl_xor(v, o);
    return v;
}
__device__ __forceinline__ int rowoff16(int i) { return (i & 3) + 8 * (i >> 2); }
#define LDS_WAIT() asm volatile("s_waitcnt lgkmcnt(0)" ::: "memory")
#define LDS_BARRIER() do { asm volatile("s_waitcnt lgkmcnt(0)" ::: "memory"); __builtin_amdgcn_s_barrier(); asm volatile("" ::: "memory"); } while (0)
#define AT_WAIT_BARRIER() do { asm volatile("s_waitcnt vmcnt(0) lgkmcnt(0)" ::: "memory"); __builtin_amdgcn_s_barrier(); asm volatile("" ::: "memory"); } while (0)

namespace pg8 {
#define PG8_LAS __attribute__((address_space(3)))
typedef unsigned short bf16_t;
constexpr int BM = 256, BK = 64, HALF = 128, HTB = HALF * BK * 2, STAGE_BYTES = 8 * HTB, NXCD = 8, WGM = 8;
__host__ __device__ __forceinline__ int lds_byte(int r, int c) { const int st = (r >> 4) * 2 + (c >> 5), rr = r & 15, cc = c & 31, ob = rr * 64 + cc * 2; return st * 1024 + (ob ^ (((ob >> 9) & 1) << 5)); }
__host__ __device__ __forceinline__ void stage_rc(int b, int& R, int& C) { const int st = b / 1024, sb = b % 1024, swz = sb ^ (((sb >> 9) & 1) << 5); R = (st >> 1) * 16 + swz / 64; C = (st & 1) * 32 + (swz % 64) / 2; }
__host__ __device__ __forceinline__ int perm32(int rho) { const int n = rho >> 4, i = rho & 15; return 8 * (i >> 2) + 4 * n + (i & 3); }
struct Unit { int pm, pn; };
struct Gemm { const bf16_t* A; const bf16_t* Bt; int M, N, K, lda, ldb, T8 = 0; };
struct StaticOrder {
    int nM, nN, nwg, G, c;
    __host__ __device__ void init(int M, int N, int G_, int c_) { nM = M / BM; nN = N / BM; nwg = nM * nN; G = G_; c = c_; }
    __host__ __device__ bool next(int i, Unit& u) const {
        const long L = (long)i * G + c; if (L >= nwg) return false;
        int wgid = (int)L; { const int q = nwg / NXCD, r = nwg % NXCD, xcd = wgid % NXCD, off = wgid / NXCD; wgid = (xcd < r ? xcd * (q + 1) : r * (q + 1) + (xcd - r) * q) + off; }
        const int nig = WGM * nN, gid = wgid / nig, fm = gid * WGM, gsz = (nM - fm) < WGM ? (nM - fm) : WGM;
        u.pm = fm + ((wgid % nig) % gsz); u.pn = (wgid % nig) / gsz; return true;
    }
};
typedef f32x4 Acc[2][2][4][2];

template <bool F8> struct Frag;
template <> struct Frag<false> { bf16x8 k[2]; };
template <> struct Frag<true>  { i32x8 v; };
__device__ __forceinline__ void frag_ld(Frag<false>& d, const PG8_LAS unsigned char* p) { d.k[0] = *(const PG8_LAS bf16x8*)p; d.k[1] = *(const PG8_LAS bf16x8*)(p + 1024); }
__device__ __forceinline__ void frag_ld(Frag<true>& d, const PG8_LAS unsigned char* p) { d.v.lo = *(const PG8_LAS i32x4*)p; d.v.hi = *(const PG8_LAS i32x4*)(p + 1024); }
template <bool ASM> __device__ __forceinline__ void frag_mma(f32x4& c, const Frag<false>& b, const Frag<false>& a) {
    if constexpr (ASM) { asm volatile("v_mfma_f32_16x16x32_bf16 %0, %1, %2, %0" : "+v"(c) : "v"(b.k[0]), "v"(a.k[0])); asm volatile("v_mfma_f32_16x16x32_bf16 %0, %1, %2, %0" : "+v"(c) : "v"(b.k[1]), "v"(a.k[1])); }
    else { c = __builtin_amdgcn_mfma_f32_16x16x32_bf16(b.k[0], a.k[0], c, 0, 0, 0); c = __builtin_amdgcn_mfma_f32_16x16x32_bf16(b.k[1], a.k[1], c, 0, 0, 0); }
}
template <bool ASM> __device__ __forceinline__ void frag_mma(f32x4& c, const Frag<true>& b, const Frag<true>& a) { asm volatile("v_mfma_f32_16x16x128_f8f6f4 %0, %1, %2, %0" : "+v"(c) : "v"(b.v), "v"(a.v)); }
struct NoMid { static constexpr bool ACTIVE = false; __device__ __forceinline__ void operator()(Acc&, const Unit&, int, int, int, int) const {} };
struct OneUnit { int pm, pn; __device__ __forceinline__ bool next(int i, Unit& u) const { if (i != 0) return false; u.pm = pm; u.pn = pn; return true; } };
template <class Epi, class Mid = NoMid, int EREP = 1, class Sched = StaticOrder, int MODE = 0>
__device__ __forceinline__ void gemm_phase(PG8_LAS unsigned char* lds, const Gemm g, const Sched& S, const Epi& E, const Mid& H = Mid()) {
    int tid_ = threadIdx.x; asm volatile("" : "+v"(tid_));
    const int tid = tid_, wid = __builtin_amdgcn_readfirstlane(tid >> 6), lane = tid & 63, wr = wid >> 2, wc = wid & 3, fr = lane & 15, fq = lane >> 4;
    constexpr bool FP8 = MODE != 0;
    const int K = g.K, nt = K / BK, T8 = MODE == 2 ? g.T8 : 0, th = MODE == 2 ? T8 : (nt >> 1);
    unsigned voffA[2], voffB[2];
#pragma unroll
    for (int i = 0; i < 2; ++i) { int R, C; stage_rc(tid * 16 + i * 8192, R, C); const int Rb = Epi::PERM ? ((R & ~31) + perm32(R & 31)) : R; voffA[i] = (unsigned)(R * g.lda + C) * 2u; voffB[i] = (unsigned)(Rb * g.ldb + C) * 2u; }
    const size_t kstep = (size_t)(BK * 2);
    const size_t hstepA = (size_t)HALF * g.lda * 2, hstepB = (size_t)HALF * g.ldb * 2;
    const size_t tstepA = 2 * hstepA, tstepB = 2 * hstepB;
    const unsigned ldsw = (unsigned)wid * 1024u;
    const int aoff = lds_byte(wr * 64 + fr, fq * 8), boff = lds_byte(wc * 32 + fr, fq * 8);
#define PG8_SA(b, h) (((b) * 2 + (h)) * HTB)
#define PG8_SB(b, h) ((4 + (b) * 2 + (h)) * HTB)
#define PG8_STAGE(bufoff, gbase, voff) do { _Pragma("unroll") for (int _i = 0; _i < 2; ++_i) \
        __builtin_amdgcn_global_load_lds((const unsigned*)((const char*)(gbase) + (voff)[_i]), (PG8_LAS unsigned*)(lds + (bufoff) + ldsw + _i * 8192), 16, 0, 0); } while (0)
#define PG8_LDF(dst, i, base) frag_ld(dst[i], lds + (base) + (i) * 2048)
#define PG8_LDA(dst, b, h) do { _Pragma("unroll") for (int m = 0; m < 4; ++m) PG8_LDF(dst, m, PG8_SA(b, h) + aoff); } while (0)
#define PG8_LDB(dst, b, h) do { _Pragma("unroll") for (int n = 0; n < 2; ++n) PG8_LDF(dst, n, PG8_SB(b, h) + boff); } while (0)
#define PG8_MMA(ai, bj, At, Bt) do { __builtin_amdgcn_s_setprio(1); _Pragma("unroll") for (int m = 0; m < 4; ++m) _Pragma("unroll") for (int n = 0; n < 2; ++n) frag_mma<MODE == 2>(acc[ai][bj][m][n], Bt[n], At[m]); \
        __builtin_amdgcn_s_setprio(0); } while (0)
#define PG8_WAIT_V(n) asm volatile("s_waitcnt vmcnt(" #n ")" ::: "memory")
#define PG8_WAIT_L(n) asm volatile("s_waitcnt lgkmcnt(" #n ")" ::: "memory")
#define PG8_BAR __builtin_amdgcn_s_barrier()
#define PG8_SCHED __builtin_amdgcn_sched_barrier(0)
    Unit cur, nxt; int ui = 0;
    if (!S.next(0, cur)) return;
    Acc acc;
#pragma unroll
    for (int a = 0; a < 2; ++a)
#pragma unroll
        for (int b = 0; b < 2; ++b)
#pragma unroll
            for (int m = 0; m < 4; ++m)
#pragma unroll
                for (int n = 0; n < 2; ++n) acc[a][b][m][n] = (f32x4){0.f, 0.f, 0.f, 0.f};
    Frag<false> Ab[4], Bb0[2], Bb1[2]; Frag<true> Af[4], Bf0[2], Bf1[2];
    const char* cA = (const char*)g.A + (size_t)cur.pm * tstepA; const char* cB = (const char*)g.Bt + (size_t)cur.pn * tstepB;
    PG8_STAGE(PG8_SB(0, 0), cB, voffB); PG8_STAGE(PG8_SB(0, 1), cB + hstepB, voffB); PG8_STAGE(PG8_SA(0, 0), cA, voffA); PG8_STAGE(PG8_SA(0, 1), cA + hstepA, voffA);
    if (wr == 1) PG8_BAR;
    PG8_WAIT_V(2); PG8_BAR;
    PG8_STAGE(PG8_SB(1, 0), cB + kstep, voffB); PG8_STAGE(PG8_SA(1, 0), cA + kstep, voffA); PG8_STAGE(PG8_SB(1, 1), cB + hstepB + kstep, voffB);
    PG8_WAIT_V(6); PG8_BAR;
    for (;;) {
        const bool has_next = S.next(ui + 1, nxt);
        const char* nA = has_next ? (const char*)g.A + (size_t)nxt.pm * tstepA : cA; const char* nB = has_next ? (const char*)g.Bt + (size_t)nxt.pn * tstepB : cB;
#define PG8_KOFF(t) ((size_t)(t) * kstep + ((MODE == 2 && (t) >= T8) ? (size_t)T8 * kstep : (size_t)0))
#define PG8_TRIP(At, B0, B1) do { \
            const bool last = (t == nt - 2); \
            const char* a1 = cA + PG8_KOFF(t + 1); \
            const char* a2 = last ? nA : cA + PG8_KOFF(t + 2); const char* b2 = last ? nB : cB + PG8_KOFF(t + 2); \
            const char* a3 = a2 + kstep; const char* b3 = b2 + kstep; \
            if constexpr (Mid::ACTIVE) { if (t == th) { if constexpr (MODE == 2) asm volatile("s_nop 15\n\ts_nop 15" ::: "memory"); H(acc, cur, wr, wc, fr, fq); } } \
            PG8_LDB(B0, 0, 0); PG8_LDB(B1, 0, 1); PG8_SCHED; PG8_LDA(At, 0, 0); PG8_STAGE(PG8_SA(1, 1), a1 + hstepA, voffA); \
            PG8_WAIT_V(8); PG8_WAIT_L(0); PG8_BAR; PG8_MMA(0, 0, At, B0); PG8_MMA(0, 1, At, B1); PG8_BAR; PG8_SCHED; \
            PG8_LDA(At, 0, 1); PG8_STAGE(PG8_SB(0, 0), b2, voffB); PG8_STAGE(PG8_SB(0, 1), b2 + hstepB, voffB); PG8_STAGE(PG8_SA(0, 0), a2, voffA); \
            PG8_WAIT_V(8); PG8_WAIT_L(0); PG8_BAR; PG8_MMA(1, 0, At, B0); PG8_MMA(1, 1, At, B1); PG8_BAR; PG8_SCHED; \
            PG8_LDB(B0, 1, 0); PG8_LDB(B1, 1, 1); PG8_SCHED; PG8_LDA(At, 1, 0); PG8_STAGE(PG8_SA(0, 1), a2 + hstepA, voffA); \
            PG8_WAIT_V(8); PG8_WAIT_L(0); PG8_BAR; PG8_MMA(0, 0, At, B0); PG8_MMA(0, 1, At, B1); PG8_BAR; PG8_SCHED; \
            PG8_LDA(At, 1, 1); PG8_STAGE(PG8_SB(1, 0), b3, voffB); PG8_STAGE(PG8_SB(1, 1), b3 + hstepB, voffB); PG8_STAGE(PG8_SA(1, 0), a3, voffA); \
            PG8_WAIT_V(8); PG8_WAIT_L(0); PG8_BAR; PG8_MMA(1, 0, At, B0); PG8_MMA(1, 1, At, B1); PG8_BAR; PG8_SCHED; \
        } while (0)
        if constexpr (MODE == 2) {
            for (int t = 0; t < T8; t += 2) PG8_TRIP(Af, Bf0, Bf1);
            for (int t = T8; t < nt; t += 2) PG8_TRIP(Ab, Bb0, Bb1);
        } else if constexpr (MODE == 1) {
            for (int t = 0; t < nt; t += 2) PG8_TRIP(Af, Bf0, Bf1);
        } else {
            for (int t = 0; t < nt; t += 2) PG8_TRIP(Ab, Bb0, Bb1);
        }
        if constexpr (FP8) asm volatile("s_nop 15\n\ts_nop 15" ::: "memory");
        if (wr == 0) PG8_BAR;
        E(acc, cur, wr, wc, fr, fq, lds + STAGE_BYTES);
        if constexpr (EREP == 2) { asm volatile("" ::: "memory"); E(acc, cur, wr, wc, fr, fq, lds + STAGE_BYTES); }
        if (!has_next) break;
#pragma unroll
        for (int a = 0; a < 2; ++a)
#pragma unroll
            for (int b = 0; b < 2; ++b)
#pragma unroll
                for (int m = 0; m < 4; ++m)
#pragma unroll
                    for (int n = 0; n < 2; ++n) acc[a][b][m][n] = (f32x4){0.f, 0.f, 0.f, 0.f};
        cur = nxt; cA = nA; cB = nB; ++ui;
        if (wr == 1) PG8_BAR;
    }
    PG8_WAIT_V(0);
    PG8_BAR;
#undef PG8_SA
#undef PG8_SB
#undef PG8_STAGE
#undef PG8_LDA
#undef PG8_LDB
#undef PG8_MMA
#undef PG8_LDF
#undef PG8_TRIP
#undef PG8_KOFF
#undef PG8_WAIT_V
#undef PG8_WAIT_L
#undef PG8_BAR
#undef PG8_SCHED
}
}

struct Ptrs {
    const float *x, *norm1_g, *w_in, *q_norm_g, *k_norm_g, *idx_k_norm_g, *sgu_norm_g, *w_spatial, *b_spatial, *w_proj_a, *w_proj_b, *w_out, *norm2_g, *w_gate, *w_up, *w_down, *rel_bias;
    float* out; unsigned char* ws;
};

__device__ __forceinline__ unsigned pk4_fp8(float a, float b, float c, float d) { int w = __builtin_amdgcn_cvt_pk_fp8_f32(a, b, 0, false); w = __builtin_amdgcn_cvt_pk_fp8_f32(c, d, w, true); return (unsigned)w; }
__device__ __forceinline__ f32x4 ld_bf16x4(const bf16* p) { const u32x2 w = *(const u32x2*)p; f32x4 r; r[0] = bf2f(w.x & 0xffffu); r[1] = bf2f(w.x >> 16); r[2] = bf2f(w.y & 0xffffu); r[3] = bf2f(w.y >> 16); return r; }
__device__ __forceinline__ void store_bf16x4(bf16* p, f32x4 v) { u32x2 w; w.x = pk2(v[0], v[1]); w.y = pk2(v[2], v[3]); *(u32x2*)p = w; }

__device__ __forceinline__ void store_bf16x8(void* p, f32x4 a, f32x4 b) { u32x4 w; w.x = pk2(a[0], a[1]); w.y = pk2(a[2], a[3]); w.z = pk2(b[0], b[1]); w.w = pk2(b[2], b[3]); *(u32x4*)p = w; }
template <int ACT> __device__ __forceinline__ f32x4 act4(f32x4 v) {
    if (ACT == 1) { v[0] = gelu_tanh(v[0]); v[1] = gelu_tanh(v[1]); v[2] = gelu_tanh(v[2]); v[3] = gelu_tanh(v[3]); }
    if (ACT == 2) { v[0] = sigmoidf_(v[0]); v[1] = sigmoidf_(v[1]); v[2] = sigmoidf_(v[2]); v[3] = sigmoidf_(v[3]); }
    return v;
}
template <int ACT> __device__ __forceinline__ void epi_rowmajor(pg8::Acc& acc, char* dt, int rowb, unsigned lo) {
#pragma unroll
    for (int ai = 0; ai < 2; ++ai)
#pragma unroll
        for (int m = 0; m < 4; ++m) { char* dr = dt + (size_t)(ai * 128 + m * 16) * rowb;
#pragma unroll
            for (int bj = 0; bj < 2; ++bj) store_bf16x8(dr + lo + bj * 256, act4<ACT>(acc[ai][bj][m][0]), act4<ACT>(acc[ai][bj][m][1])); }
}
#ifndef FP8_QK
#define FP8_QK 1
#endif
constexpr int P1_NB16 = FP8_QK ? 2048 : 4096, P1_NF8 = FP8_QK ? 8192 : 6144;
constexpr int FFN_T8 = 12, FFN_KF = 128 * FFN_T8;
constexpr float OA_SCALE = 4.0f;
constexpr float GATE_WSCALE = 32.0f;
template <bool F8>
struct EpiIn {
    static constexpr bool PERM = true;
    unsigned char* ws; const float *gq, *gk;
    __device__ __forceinline__ void operator()(pg8::Acc& acc, const pg8::Unit& u, int wr, int wc, int fr, int fq, LAS unsigned char* scr) const {
        constexpr float SC = F8 ? 1.0f / GATE_WSCALE : 1.0f;
        const int rt0 = wr * 64 + fr; const int row0 = u.pm * 256 + rt0;
        if constexpr (F8) if (u.pn < 16) {
            unsigned char* ga_ = ws + WS_GA + (size_t)u.pm * 256 * 2048 + u.pn * 128; unsigned char* gb_ = ws + WS_GB + (size_t)u.pm * 256 * 2048 + u.pn * 128;
            unsigned lo = (unsigned)(rt0 * 2048 + wc * 32 + 8 * fq); asm volatile("" : "+v"(lo));
            constexpr float NS = -LOG2E * SC;
#pragma unroll
            for (int ai = 0; ai < 2; ++ai)
#pragma unroll
                for (int m = 0; m < 4; ++m) {
                    u32x2 wa, wb; wa.x = wa.y = wb.x = wb.y = 0u;
#pragma unroll
                    for (int n = 0; n < 2; ++n)
#pragma unroll
                        for (int e = 0; e < 4; ++e) {
                            const float ea = __builtin_amdgcn_exp2f(acc[ai][0][m][n][e] * NS), eb = __builtin_amdgcn_exp2f(acc[ai][1][m][n][e] * NS);
                            const float sa = 255.0f * __builtin_amdgcn_rcpf(1.0f + ea), sb = fmaxf(255.0f * __builtin_amdgcn_rcpf(1.0f + eb), 1.0f);
                            if (n == 0) { wa.x = __builtin_amdgcn_cvt_pk_u8_f32(sa, e, wa.x); wb.x = __builtin_amdgcn_cvt_pk_u8_f32(sb, e, wb.x); }
                            else        { wa.y = __builtin_amdgcn_cvt_pk_u8_f32(sa, e, wa.y); wb.y = __builtin_amdgcn_cvt_pk_u8_f32(sb, e, wb.y); }
                        }
                    *(u32x2*)(ga_ + (size_t)(ai * 128 + m * 16) * 2048 + lo) = wa; *(u32x2*)(gb_ + (size_t)(ai * 128 + m * 16) * 2048 + lo) = wb;
                }
            return;
        }
        const int pn = F8 ? (u.pn < 20 ? u.pn - 8 : (u.pn < 24 ? u.pn : u.pn - 24)) : (FP8_QK ? u.pn + 12 : (u.pn < 8 ? u.pn : u.pn + 4));
        LAS float* P = (LAS float*)scr;
        if (pn < 8) {
            const bool isq = pn < 4; const float* g = isq ? gq : gk;
            const float osc = (isq ? (0.08838834764831845f * LOG2E) : 1.0f) * SC;
#pragma unroll
            for (int ai = 0; ai < 2; ++ai)
#pragma unroll
                for (int m = 0; m < 4; ++m)
#pragma unroll
                    for (int bj = 0; bj < 2; ++bj) {
                        float s = 0.f;
#pragma unroll
                        for (int n = 0; n < 2; ++n) { const f32x4 v = acc[ai][bj][m][n]; s += (v[0] * v[0] + v[1] * v[1]) + (v[2] * v[2] + v[3] * v[3]); }
                        s += __shfl_xor(s, 16); s += __shfl_xor(s, 32);
                        if (fq == 0) P[(ai * 128 + rt0 + m * 16) * 8 + bj * 4 + wc] = s;
                    }
            LDS_BARRIER();
            f32x4 gv[2];
#pragma unroll
            for (int n = 0; n < 2; ++n) gv[n] = *(const f32x4*)(g + wc * 32 + 8 * fq + 4 * n) * osc;
            char* dt = (char*)ws + (isq ? WS_Q : WS_K) + ((size_t)u.pm * 256 * 1024 + (pn & 3) * 256) * 2;
            unsigned lo = (unsigned)(rt0 * 1024 + wc * 32 + 8 * fq) * 2u; asm volatile("" : "+v"(lo));
#pragma unroll
            for (int ai = 0; ai < 2; ++ai)
#pragma unroll
                for (int m = 0; m < 4; ++m) { char* dr = dt + (size_t)(ai * 128 + m * 16) * 2048;
#pragma unroll
                    for (int bj = 0; bj < 2; ++bj) {
                        const f32x4 pp = *(const LAS f32x4*)(P + (ai * 128 + rt0 + m * 16) * 8 + bj * 4);
                        const float rs = __builtin_amdgcn_rsqf(((pp[0] + pp[1]) + (pp[2] + pp[3])) * (SC * SC / 128.0f) + EPS);
                        store_bf16x8(dr + lo + bj * 256, acc[ai][bj][m][0] * rs * gv[0], acc[ai][bj][m][1] * rs * gv[1]);
                    } }
        } else if (pn < 12 || (pn >= 20 && pn < 24)) {
            const bool isv = pn < 12; bf16* dst = (bf16*)(ws + (isv ? WS_VT : WS_VBT)); const int chbase = ((isv ? pn - 8 : pn - 20)) * 256; float* rowsq_vb = (float*)(ws + WS_CTL + CTL_ROWSQ_VB);
            const int frp = isv ? (8 * ((fr >> 2) & 1) + 4 * (fr >> 3) + (fr & 3)) : fr;
            const int b = u.pm >> 3, s0 = (u.pm & 7) * 256 + wr * 64 + frp;
#pragma unroll
            for (int ai = 0; ai < 2; ++ai)
#pragma unroll
                for (int m = 0; m < 4; ++m) {
                    float ss = 0.f;
#pragma unroll
                    for (int bj = 0; bj < 2; ++bj)
#pragma unroll
                        for (int n = 0; n < 2; ++n) {
                            f32x4 v = acc[ai][bj][m][n];
                            if constexpr (F8) v = v * SC;
                            if (!isv) { v = act4<1>(v); ss += (v[0] * v[0] + v[1] * v[1]) + (v[2] * v[2] + v[3] * v[3]); }
                            const int ch = chbase + bj * 128 + wc * 32 + 8 * fq + 4 * n;
                            bf16* p = dst + ((size_t)(b * 1024 + ch)) * 2048 + s0 + ai * 128 + m * 16;
                            const unsigned w01 = pk2(v[0], v[1]), w23 = pk2(v[2], v[3]);
                            p[0] = (bf16)(w01 & 0xffffu); p[2048] = (bf16)(w01 >> 16); p[4096] = (bf16)(w23 & 0xffffu); p[6144] = (bf16)(w23 >> 16);
                        }
                    if (!isv) { ss += __shfl_xor(ss, 16); ss += __shfl_xor(ss, 32); if (fq == 0) unsafeAtomicAdd(rowsq_vb + row0 + ai * 128 + m * 16, ss); }
                }
        } else if constexpr (!F8) {
            const size_t doff = pn < 16 ? WS_QI : WS_U; const int colbase = (pn & 3) * 256;
            char* dt = (char*)ws + doff + ((size_t)u.pm * 256 * 1024 + colbase) * 2;
            unsigned lo = (unsigned)(rt0 * 1024 + wc * 32 + 8 * fq) * 2u; asm volatile("" : "+v"(lo));
            if (pn < 16) epi_rowmajor<0>(acc, dt, 2048, lo); else epi_rowmajor<1>(acc, dt, 2048, lo);
        }
    }
};

__device__ __forceinline__ void ld_bf16x8(const void* p, f32x4& a, f32x4& b) { const u32x4 w = *(const u32x4*)p; a[0] = bf2f(w.x & 0xffffu); a[1] = bf2f(w.x >> 16); a[2] = bf2f(w.y & 0xffffu); a[3] = bf2f(w.y >> 16); b[0] = bf2f(w.z & 0xffffu); b[1] = bf2f(w.z >> 16); b[2] = bf2f(w.w & 0xffffu); b[3] = bf2f(w.w >> 16); }
struct MidScale {
    static constexpr bool ACTIVE = true; float sc;
    __device__ __forceinline__ void operator()(pg8::Acc& acc, const pg8::Unit&, int, int, int, int) const {
#pragma unroll
        for (int ai = 0; ai < 2; ++ai)
#pragma unroll
            for (int bj = 0; bj < 2; ++bj)
#pragma unroll
                for (int m = 0; m < 4; ++m)
#pragma unroll
                    for (int n = 0; n < 2; ++n) acc[ai][bj][m][n] *= sc;
    }
};
__device__ __forceinline__ void ld_u8x8(const void* p, f32x4& a, f32x4& b) { const u32x2 w = *(const u32x2*)p;
    a[0] = (float)(w.x & 0xffu); a[1] = (float)((w.x >> 8) & 0xffu); a[2] = (float)((w.x >> 16) & 0xffu); a[3] = (float)(w.x >> 24);
    b[0] = (float)(w.y & 0xffu); b[1] = (float)((w.y >> 8) & 0xffu); b[2] = (float)((w.y >> 16) & 0xffu); b[3] = (float)(w.y >> 24); }
struct MidMerge {
    static constexpr bool ACTIVE = true;
    const unsigned char *GA, *GB; float sc;
    __device__ __forceinline__ void operator()(pg8::Acc& acc, const pg8::Unit& u, int wr, int wc, int fr, int fq) const {
        unsigned lane_off = (unsigned)((wr * 64 + fr) * 2048 + wc * 32 + fq * 8); asm volatile("" : "+v"(lane_off));
        const size_t tile = (size_t)u.pm * 256 * 2048 + (size_t)u.pn * 256;
        const unsigned char* ga_t = GA + tile; const unsigned char* gb_t = GB + tile;
#pragma unroll
        for (int ai = 0; ai < 2; ++ai)
#pragma unroll
            for (int m = 0; m < 4; ++m) {
                const unsigned char* ga_r = ga_t + (size_t)(ai * 128 + m * 16) * 2048; const unsigned char* gb_r = gb_t + (size_t)(ai * 128 + m * 16) * 2048;
#pragma unroll
                for (int bj = 0; bj < 2; ++bj) {
                    f32x4 a0, a1, b0, b1; ld_u8x8(ga_r + lane_off + bj * 128, a0, a1); ld_u8x8(gb_r + lane_off + bj * 128, b0, b1);
#pragma unroll
                    for (int e = 0; e < 4; ++e) { acc[ai][bj][m][0][e] *= a0[e] * __builtin_amdgcn_rcpf(b0[e]) * sc; acc[ai][bj][m][1][e] *= a1[e] * __builtin_amdgcn_rcpf(b1[e]) * sc; }
                }
                asm volatile("" ::: "memory");
            }
    }
};
struct EpiMerge {
    static constexpr bool PERM = true;
    const unsigned char* GB; bf16* MERGED;
    __device__ __forceinline__ void operator()(pg8::Acc& acc, const pg8::Unit& u, int wr, int wc, int fr, int fq, LAS unsigned char*) const {
        unsigned lane_off = (unsigned)((wr * 64 + fr) * 2048 + wc * 32 + fq * 8) * 2u; asm volatile("" : "+v"(lane_off));
        const size_t tile = ((size_t)u.pm * 256 * 2048 + (size_t)u.pn * 256) * 2;
        const unsigned char* gb_t = GB + (tile >> 1); char* mt = (char*)MERGED + tile;
#pragma unroll
        for (int ai = 0; ai < 2; ++ai)
#pragma unroll
            for (int m = 0; m < 4; ++m) {
                const unsigned char* gb_r = gb_t + (size_t)(ai * 128 + m * 16) * 2048; char* mr = mt + (size_t)(ai * 128 + m * 16) * 4096;
#pragma unroll
                for (int bj = 0; bj < 2; ++bj) { f32x4 gb0, gb1; ld_u8x8(gb_r + (lane_off >> 1) + bj * 128, gb0, gb1); store_bf16x8(mr + lane_off + bj * 256, acc[ai][bj][m][0] * (gb0 * (1.0f / 255.0f)), acc[ai][bj][m][1] * (gb1 * (1.0f / 255.0f))); }
            }
    }
};
struct EpiOut {
    static constexpr bool PERM = false;
    const float* X; bf16* X1B; float* rowsq2;
    __device__ __forceinline__ void operator()(pg8::Acc& acc, const pg8::Unit& u, int wr, int wc, int fr, int fq, LAS unsigned char*) const {
        const int row0 = u.pm * 256 + wr * 64 + fr;
        unsigned lo = (unsigned)((wr * 64 + fr) * 2048 + wc * 32 + fq * 4) * 4u; asm volatile("" : "+v"(lo));
        const size_t tile = ((size_t)u.pm * 256 * 2048 + (size_t)u.pn * 256) * 4;
        const char* xt = (const char*)X + tile; char* bt = (char*)X1B + tile / 2;
#pragma unroll
        for (int ai = 0; ai < 2; ++ai)
#pragma unroll
            for (int m = 0; m < 4; ++m) {
                const size_t ro = (size_t)(ai * 128 + m * 16) * 8192;
                float ss = 0.f;
#pragma unroll
                for (int bj = 0; bj < 2; ++bj)
#pragma unroll
                    for (int n = 0; n < 2; ++n) {
                        const f32x4 v = __builtin_nontemporal_load((const f32x4*)(xt + ro + lo + bj * 512 + n * 64)) + acc[ai][bj][m][n];
                        ss += (v[0] * v[0] + v[1] * v[1]) + (v[2] * v[2] + v[3] * v[3]);
                        store_bf16x4((bf16*)(bt + ro / 2 + (lo >> 1) + bj * 256 + n * 32), v);
                    }
                ss += __shfl_xor(ss, 16); ss += __shfl_xor(ss, 32);
                if (fq == 0) unsafeAtomicAdd(rowsq2 + row0 + ai * 128 + m * 16, ss);
            }
    }
};
__device__ __forceinline__ void ffn_up_store(pg8::Acc& acc, const float* rowsq2, bf16* ACT, int pm, int pnc, int wr, int wc, int fr, int fq) {
    const int row0 = pm * 256 + wr * 64 + fr;
    unsigned lane_off = (unsigned)((wr * 64 + fr) * DFF + wc * 32 + fq * 8) * 2u; asm volatile("" : "+v"(lane_off));
    const bool f8 = pnc < FFN_T8;
    char* at = (char*)ACT + (size_t)pm * 256 * DFF * 2 + (size_t)pnc * 128 * (f8 ? 1 : 2);
    if (f8) { lane_off = (unsigned)((wr * 64 + fr) * DFF * 2 + wc * 32 + fq * 8); asm volatile("" : "+v"(lane_off)); }
#pragma unroll
    for (int ai = 0; ai < 2; ++ai)
#pragma unroll
        for (int m = 0; m < 4; ++m) {
            const int row = row0 + ai * 128 + m * 16;
            const float rs = __builtin_amdgcn_rsqf(rowsq2[row] * (1.0f / (2048.0f * NREP(5))) + EPS);
            f32x4 o[2];
#pragma unroll
            for (int n = 0; n < 2; ++n) {
                const f32x4 gt = acc[ai][0][m][n] * rs, up = acc[ai][1][m][n] * rs;
#pragma unroll
                for (int e = 0; e < 4; ++e) o[n][e] = gt[e] * sigmoidf_(gt[e]) * up[e];
            }
            if (f8) { u32x2 w; w.x = pk4_fp8(o[0][0], o[0][1], o[0][2], o[0][3]); w.y = pk4_fp8(o[1][0], o[1][1], o[1][2], o[1][3]); *(u32x2*)(at + (size_t)(ai * 128 + m * 16) * (DFF * 2) + lane_off) = w; }
            else store_bf16x8(at + (size_t)(ai * 128 + m * 16) * (DFF * 2) + lane_off, o[0], o[1]);
        }
}
struct EpiFfnUp {
    static constexpr bool PERM = true;
    const float* rowsq2; bf16* ACT; int pn_off;
    __device__ __forceinline__ void operator()(pg8::Acc& acc, const pg8::Unit& u, int wr, int wc, int fr, int fq, LAS unsigned char*) const { ffn_up_store(acc, rowsq2, ACT, u.pm, u.pn + pn_off, wr, wc, fr, fq); }
};
struct EpiFfnUpPair {
    static constexpr bool PERM = true;
    const float* rowsq2; bf16* ACT; int pn_off; int half; float* slab; unsigned* flag;
    __device__ __forceinline__ void operator()(pg8::Acc& acc, const pg8::Unit& u, int wr, int wc, int fr, int fq, LAS unsigned char*) const {
        const int tid = threadIdx.x;
        unsigned so = (unsigned)tid * 16u; asm volatile("" : "+v"(so));
        char* sb = (char*)slab;
        if (half) {
#pragma unroll
            for (int ai = 0; ai < 2; ++ai)
#pragma unroll
                for (int bj = 0; bj < 2; ++bj)
#pragma unroll
                    for (int m = 0; m < 4; ++m)
#pragma unroll
                        for (int n = 0; n < 2; ++n) *(f32x4*)(sb + (size_t)((((ai * 2 + bj) * 4 + m) * 2 + n) * 8192) + so) = acc[ai][bj][m][n];
            asm volatile("s_waitcnt vmcnt(0)" ::: "memory");
            __builtin_amdgcn_s_barrier(); asm volatile("" ::: "memory");
            if (tid == 0) { __builtin_amdgcn_fence(__ATOMIC_RELEASE, "agent"); asm volatile("s_waitcnt vmcnt(0)" ::: "memory"); __hip_atomic_store(flag, 1u, __ATOMIC_RELAXED, __HIP_MEMORY_SCOPE_AGENT); }
        } else {
            if (tid < 64) {
                unsigned spins = 0;
                while ((unsigned)__builtin_amdgcn_readfirstlane(__hip_atomic_load(flag, __ATOMIC_RELAXED, __HIP_MEMORY_SCOPE_AGENT)) == 0u) { __builtin_amdgcn_s_sleep(2); if (++spins > (1u << 24)) break; }
                __builtin_amdgcn_fence(__ATOMIC_ACQUIRE, "agent");
                asm volatile("s_waitcnt vmcnt(0)" ::: "memory");
            }
            asm volatile("" ::: "memory"); __builtin_amdgcn_s_barrier(); asm volatile("" ::: "memory");
#pragma unroll
            for (int ai = 0; ai < 2; ++ai)
#pragma unroll
                for (int bj = 0; bj < 2; ++bj)
#pragma unroll
                    for (int m = 0; m < 4; ++m) {
#pragma unroll
                        for (int n = 0; n < 2; ++n) acc[ai][bj][m][n] += *(const f32x4*)(sb + (size_t)((((ai * 2 + bj) * 4 + m) * 2 + n) * 8192) + so);
                        asm volatile("" ::: "memory");
                    }
            ffn_up_store(acc, rowsq2, ACT, u.pm, u.pn + pn_off, wr, wc, fr, fq);
        }
    }
};
struct EpiFfnDown {
    static constexpr bool PERM = false;
    const bf16* X1B; float* OUT;
    __device__ __forceinline__ void operator()(pg8::Acc& acc, const pg8::Unit& u, int wr, int wc, int fr, int fq, LAS unsigned char*) const {
        unsigned lo = (unsigned)((wr * 64 + fr) * 2048 + wc * 32 + fq * 4) * 4u; asm volatile("" : "+v"(lo));
        const size_t tile = ((size_t)u.pm * 256 * 2048 + (size_t)u.pn * 256) * 4;
        const char* st = (const char*)X1B + tile / 2; char* ot = (char*)OUT + tile;
#pragma unroll
        for (int ai = 0; ai < 2; ++ai)
#pragma unroll
            for (int m = 0; m < 4; ++m) {
                const size_t ro = (size_t)(ai * 128 + m * 16) * 8192;
#pragma unroll
                for (int bj = 0; bj < 2; ++bj)
#pragma unroll
                    for (int n = 0; n < 2; ++n) __builtin_nontemporal_store(ld_bf16x4((const bf16*)(st + ro / 2 + (lo >> 1) + bj * 256 + n * 32)) + acc[ai][bj][m][n], (f32x4*)(ot + ro + lo + bj * 512 + n * 64));
            }
    }
};

__device__ __forceinline__ void kiwi_issue(const bf16* H1r, const bf16* Wr, int kc, LAS unsigned char* buf, int wave, int lane) {
    const int sub = lane >> 4, pos = lane & 15;
#pragma unroll
    for (int j = 0; j < 4; ++j) {
        const int rowi = 4 * (wave + 8 * j) + sub;
        const bf16* base = (j == 0) ? H1r + (size_t)rowi * 2048 : Wr + (size_t)(rowi - 32) * 2048;
        __builtin_amdgcn_global_load_lds((const unsigned*)(base + kc * 128 + ((pos ^ (rowi & 15)) * 8)), (LAS unsigned*)(buf + (wave + 8 * j) * 1024), 16, 0, 0);
    }
}
__device__ __forceinline__ void kiwi_unit(int rb, const bf16* H1, const bf16* WIN, const float* gki, bf16* KI, float* WI, LAS unsigned char* lds, int wave, int lane) {
    const int r = lane & 31, hs = lane >> 5;
    const bf16* H1r = H1 + (size_t)(rb * 32) * 2048; const bf16* Wr = WIN + (size_t)10240 * 2048;
    f32x16 acc[3];
#pragma unroll
    for (int cb = 0; cb < 3; ++cb)
#pragma unroll
        for (int i = 0; i < 16; ++i) acc[cb][i] = 0.f;
    kiwi_issue(H1r, Wr, 0, lds, wave, lane); kiwi_issue(H1r, Wr, 1, lds + 32768, wave, lane); kiwi_issue(H1r, Wr, 2, lds + 65536, wave, lane);
    asm volatile("s_waitcnt vmcnt(8)" ::: "memory"); LDS_BARRIER();
    const unsigned fbase = (unsigned)(r * 256 + (((2 * wave + hs) ^ (r & 15)) << 4));
#pragma unroll 1
    for (int kc = 0; kc < 16; ++kc) {
        LAS unsigned char* cur = lds + (kc & 3) * 32768;
        if (kc + 3 < 16) kiwi_issue(H1r, Wr, kc + 3, lds + ((kc + 3) & 3) * 32768, wave, lane);
        const bf16x8 a = *(const LAS bf16x8*)(cur + fbase);
#pragma unroll
        for (int cb = 0; cb < 3; ++cb) { const bf16x8 bfr = *(const LAS bf16x8*)(cur + (32 + 32 * cb) * 256 + fbase); acc[cb] = __builtin_amdgcn_mfma_f32_32x32x16_bf16(a, bfr, acc[cb], 0, 0, 0); }
        if (kc + 3 < 16) asm volatile("s_waitcnt vmcnt(8)" ::: "memory"); else if (kc + 2 < 16) asm volatile("s_waitcnt vmcnt(4)" ::: "memory"); else asm volatile("s_waitcnt vmcnt(0)" ::: "memory");
        LDS_BARRIER();
    }
    LAS float* part = (LAS float*)lds;
#pragma unroll
    for (int cb = 0; cb < 3; ++cb)
#pragma unroll
        for (int i = 0; i < 16; ++i) part[(wave * 48 + cb * 16 + i) * 64 + lane] = acc[cb][i];
    LDS_BARRIER();
#pragma unroll
    for (int ii = 0; ii < 2; ++ii) {
        const int i = 2 * wave + ii; float v[3];
#pragma unroll
        for (int cb = 0; cb < 3; ++cb) { float s = 0.f;
#pragma unroll
            for (int w = 0; w < 8; ++w) s += part[(w * 48 + cb * 16 + i) * 64 + lane];
            v[cb] = s; }
        float ss = v[0] * v[0] + v[1] * v[1];
        ss += __shfl_xor(ss, 1); ss += __shfl_xor(ss, 2); ss += __shfl_xor(ss, 4); ss += __shfl_xor(ss, 8); ss += __shfl_xor(ss, 16);
        const float rs = 1.0f / sqrtf(ss * (1.0f / 64.0f) + EPS);
        const size_t row = (size_t)(rb * 32 + rowoff16(i) + 4 * hs);
        KI[row * 64 + r] = (bf16)f2bf(v[0] * rs * gki[r]); KI[row * 64 + 32 + r] = (bf16)f2bf(v[1] * rs * gki[32 + r]);
        if (r < 16) WI[row * 16 + r] = v[2];
    }
    LDS_BARRIER();
}

constexpr int W8_FLAG = 0x10000;
__device__ __forceinline__ int rowmap(int mode, int n) {
    if (mode == 1) {
        if (n < 2048) return FP8_QK ? (W8_FLAG | (6144 + n)) : n;
        if (n < 3072) return W8_FLAG | (4096 + (n - 2048));
        if (n < 4096) return (FP8_QK ? 0 : 2048) + (n - 3072);
        if (n < 4160) return 10240 + (n - 4096); if (n < 4176) return 10240 + 64 + (n - 4160);
        if (n < 5200) return (FP8_QK ? 1024 : 3072) + (n - 4176);
        if (n < 6224) return W8_FLAG | (5120 + (n - 5200));
        const int j = n - 6224, gb = j >> 11, c = j & 2047; return W8_FLAG | ((c >> 7) * 256 + gb * 128 + (c & 127)); }
    if (mode == 4) return W8_FLAG | n;
    if (mode == 2) return (n >> 7) * 256 + (n & 127);
    if (mode == 3) return (n >> 7) * 256 + 128 + (n & 127);
    return n;
}
constexpr int P0_PITCH = 68, P0_WAVE_BYTES = 64 * P0_PITCH * 4;
__device__ __forceinline__ void p0_transpose_item(const float* W, int N, bf16* WT, int ldk, int koff, int mode, const float* kscale, LAS float* scr, int item, int lane, unsigned char* W8 = nullptr, int pitch8 = 2048) {
    const int nblk = (N + 63) / 64, kb = item / nblk, nb = item % nblk, k0 = 64 * kb, n0 = 64 * nb;
    const int kr = lane >> 4, nc = lane & 15; const bool ok = (n0 + 4 * nc) < N;
    const float* wp = W + (size_t)(k0 + kr) * N + n0 + 4 * nc;
    f32x4 v[16];
#pragma unroll
    for (int i = 0; i < 16; ++i) v[i] = ok ? __builtin_nontemporal_load((const f32x4*)(wp + (size_t)(4 * i) * N)) : (f32x4){0.f, 0.f, 0.f, 0.f};
#pragma unroll
    for (int i = 0; i < 16; ++i) *(LAS f32x4*)(scr + (4 * i + kr) * P0_PITCH + 4 * nc) = v[i];
    LDS_WAIT(); asm volatile("" ::: "memory");
    const int c = lane & 7, ng = lane >> 3;
    f32x4 ks0 = (f32x4){1.f, 1.f, 1.f, 1.f}, ks1 = ks0;
    if (kscale) { ks0 = *(const f32x4*)(kscale + k0 + 8 * c); ks1 = *(const f32x4*)(kscale + k0 + 8 * c + 4); }
#pragma unroll
    for (int j = 0; j < 2; ++j) {
        const int nn = 4 * (ng + 8 * j);
        f32x4 r[8];
#pragma unroll
        for (int kk = 0; kk < 8; ++kk) r[kk] = *(const LAS f32x4*)(scr + (8 * c + kk) * P0_PITCH + nn) * (kk < 4 ? ks0[kk] : ks1[kk - 4]);
        const int rm = (n0 + nn < N) ? rowmap(mode, n0 + nn) : 0;
        if (((mode == 1 || mode == 4) && (rm & W8_FLAG)) || (mode == 5 && k0 < FFN_KF)) {
            {
                unsigned char* op8 = W8 + (size_t)(rm & (W8_FLAG - 1)) * pitch8 + k0 + 8 * c;
#pragma unroll
                for (int e = 0; e < 4; ++e) { u32x2 o; o.x = pk4_fp8(r[0][e] * GATE_WSCALE, r[1][e] * GATE_WSCALE, r[2][e] * GATE_WSCALE, r[3][e] * GATE_WSCALE); o.y = pk4_fp8(r[4][e] * GATE_WSCALE, r[5][e] * GATE_WSCALE, r[6][e] * GATE_WSCALE, r[7][e] * GATE_WSCALE); __builtin_nontemporal_store(o, (u32x2*)(op8 + (size_t)e * pitch8)); }
            }
        } else if (n0 + nn < N) {
            bf16* op = WT + (size_t)rm * ldk + koff + k0 + 8 * c;
#pragma unroll
            for (int e = 0; e < 4; ++e) { u32x4 o; o.x = pk2(r[0][e], r[1][e]); o.y = pk2(r[2][e], r[3][e]); o.z = pk2(r[4][e], r[5][e]); o.w = pk2(r[6][e], r[7][e]); __builtin_nontemporal_store(o, (u32x4*)(op + (size_t)e * ldk)); }
        }
    }
    LDS_WAIT(); asm volatile("" ::: "memory");
}
__device__ __forceinline__ void p0_prologue(const Ptrs& P, LAS unsigned char* lds, int vcu, int G) {
    const int tid = threadIdx.x, lane = tid & 63, wave = __builtin_amdgcn_readfirstlane(tid >> 6);
    unsigned char* ws = P.ws;
    LAS float* scr = (LAS float*)(lds + wave * P0_WAVE_BYTES);
    const int gw = vcu * 8 + wave, NGW = G * 8;
    bf16* WIN = (bf16*)(ws + WS_WIN); bf16* WAB = (bf16*)(ws + WS_WAB); bf16* WOUT = (bf16*)(ws + WS_WOUT); bf16* W1 = (bf16*)(ws + WS_W1); bf16* W2 = (bf16*)(ws + WS_W2);
    unsigned char* H1F8 = (unsigned char*)P.out + OUT_H1F8; unsigned char* W8 = (unsigned char*)P.out + OUT_W8;
    constexpr int I_IN = 32 * 162, I_A = 16 * 32, I_O = 32 * 32, I_G = 32 * 88, I_D = 88 * 32;
    constexpr int NITEMS = I_IN + 2 * I_A + I_O + 2 * I_G + I_D;
    for (int it = gw; it < NITEMS; it += NGW) {
        int r = it;
        if (r < I_IN) { p0_transpose_item(P.w_in, DIN, WIN, 2048, 0, 1, nullptr, scr, r, lane, W8); continue; } r -= I_IN;
        if (r < I_A) { p0_transpose_item(P.w_proj_a, 2048, WAB, 2048, 0, 4, nullptr, scr, r, lane, (unsigned char*)WAB, 4096); continue; } r -= I_A;
        if (r < I_A) { p0_transpose_item(P.w_proj_b, 2048, WAB, 2048, 1024, 0, nullptr, scr, r, lane); continue; } r -= I_A;
        if (r < I_O) { p0_transpose_item(P.w_out, 2048, WOUT, 2048, 0, 0, nullptr, scr, r, lane); continue; } r -= I_O;
        if (r < I_G) { p0_transpose_item(P.w_gate, DFF, W1, 2048, 0, 2, P.norm2_g, scr, r, lane); continue; } r -= I_G;
        if (r < I_G) { p0_transpose_item(P.w_up, DFF, W1, 2048, 0, 3, P.norm2_g, scr, r, lane); continue; } r -= I_G;
        p0_transpose_item(P.w_down, 2048, W2, DFF, 0, 5, nullptr, scr, r, lane, (unsigned char*)W2, DFF * 2);
    }
    for (int rr = DIN + gw; rr < NIN; rr += NGW) { u32x4* p = (u32x4*)(WIN + (size_t)rr * 2048); for (int j = lane; j < 256; j += 64) p[j] = (u32x4){0u, 0u, 0u, 0u}; }
    bf16* H1 = (bf16*)(ws + WS_H1);
    for (int m = gw; m < MTOK; m += NGW) {
        const f32x4* xr = (const f32x4*)(P.x + (size_t)m * DM) + lane; const f32x4* gr = (const f32x4*)P.norm1_g + lane;
        f32x4 v[8]; float s = 0.f;
#pragma unroll
        for (int j = 0; j < 8; ++j) { v[j] = __builtin_nontemporal_load(xr + 64 * j); s += (v[j][0] * v[j][0] + v[j][1] * v[j][1]) + (v[j][2] * v[j][2] + v[j][3] * v[j][3]); }
        const float rs = 1.0f / sqrtf(wave_sum(s) * (1.0f / DM) + EPS);
        u32x2* o = (u32x2*)(H1 + (size_t)m * DM) + lane; unsigned* o8 = (unsigned*)(H1F8 + (size_t)m * DM) + lane;
#pragma unroll
        for (int j = 0; j < 8; ++j) { const f32x4 gg = gr[64 * j]; const float h0 = v[j][0] * rs * gg[0], h1 = v[j][1] * rs * gg[1], h2 = v[j][2] * rs * gg[2], h3 = v[j][3] * rs * gg[3];
            u32x2 w; w.x = pk2(h0, h1); w.y = pk2(h2, h3); __builtin_nontemporal_store(w, o + 64 * j); __builtin_nontemporal_store(pk4_fp8(h0, h1, h2, h3), o8 + 64 * j); }
    }
    const int gt = vcu * 512 + tid, NGT = G * 512;
    bf16* WSP = (bf16*)(ws + WS_WSP); float* TBL = (float*)(ws + WS_TBL);
    for (int i = gt; i < NG * CHUNK * CHUNK; i += NGT) { const int s = i & 127, t = (i >> 7) & 127; WSP[i] = (bf16)f2bf(s <= t ? P.w_spatial[i] : 0.f); }
    for (int i = gt; i < NH * 132; i += NGT) { const int h = i / 132, d = i % 132; const int bk = d < 128 ? (int)T5_BUCKET[d] : 31; TBL[i] = P.rel_bias[bk * NH + h] * LOG2E; }
}

constexpr int IDX_ROW = 2048, IDX_WAVE_BYTES = 2 * IDX_ROW * 4;
__device__ __forceinline__ float half_min(float v) { v = fminf(v, __shfl_xor(v, 1)); v = fminf(v, __shfl_xor(v, 2)); v = fminf(v, __shfl_xor(v, 4)); v = fminf(v, __shfl_xor(v, 8)); return fminf(v, __shfl_xor(v, 16)); }
__device__ __forceinline__ float half_max(float v) { v = fmaxf(v, __shfl_xor(v, 1)); v = fmaxf(v, __shfl_xor(v, 2)); v = fmaxf(v, __shfl_xor(v, 4)); v = fmaxf(v, __shfl_xor(v, 8)); return fmaxf(v, __shfl_xor(v, 16)); }
__device__ __forceinline__ void indexer_unit(int b, int tb, const bf16* QI, const bf16* KI, const float* WI, unsigned* MASK, LAS unsigned char* lds, int wave, int lane, int mode = 0) {
    const int r = lane & 31, hs = lane >> 5;
    const int qa = tb * 16 + 2 * wave;
    const int cmax = (qa + 1) >> 5;
    const int aq = qa + ((r >> 2) & 1), ah = (r & 3) + 4 * (r >> 3);
    const bf16* ap = QI + ((size_t)(b * SEQ + aq)) * 1024 + ah * 64 + 8 * hs;
    bf16x8 af[4];
#pragma unroll
    for (int kk = 0; kk < 4; ++kk) af[kk] = *(const bf16x8*)(ap + 16 * kk);
    const int myq = qa + hs;
    const f32x4* wp = (const f32x4*)(WI + (size_t)(b * SEQ + myq) * 16);
    float wg[16];
#pragma unroll
    for (int j = 0; j < 4; ++j) { const f32x4 t = wp[j]; wg[4 * j] = t[0]; wg[4 * j + 1] = t[1]; wg[4 * j + 2] = t[2]; wg[4 * j + 3] = t[3]; }
    const bf16* kib = KI + (size_t)(b * SEQ) * 64;
    const unsigned kio = (unsigned)((8 * wave + (lane >> 3)) * 64 + (((lane & 7) ^ (((8 * wave + (lane >> 3)) >> 1) & 7)) * 8)) * 2u;
#define IDX_ISSUE(ch, buf) do { _Pragma("unroll") for (int _j = 0; _j < 4; ++_j) \
        __builtin_amdgcn_global_load_lds((const unsigned*)((const char*)kib + (size_t)(ch) * 32768 + (size_t)_j * 8192 + kio), (LAS unsigned*)((buf) + (wave + 8 * _j) * 1024), 16, 0, 0); } while (0)
    const unsigned fb = (unsigned)(r * 128 + ((((r >> 1) & 7) ^ hs) << 4));
    float u[64];
    float mn4[4] = {INFINITY, INFINITY, INFINITY, INFINITY}, mx4[4] = {-INFINITY, -INFINITY, -INFINITY, -INFINITY};
    if (mode != 2) {
        IDX_ISSUE(0, lds);
        if (8 <= cmax) { IDX_ISSUE(1, lds + 32768); asm volatile("s_waitcnt vmcnt(4)" ::: "memory"); } else asm volatile("s_waitcnt vmcnt(0)" ::: "memory");
        LDS_BARRIER();
    }
#pragma unroll
    for (int ch = 0; ch < 8; ++ch) {
        if (8 * ch <= cmax && mode != 2) {
            LAS unsigned char* cur = lds + (ch % 3) * 32768;
            const bool ahead = (ch + 2 < 8) && (8 * (ch + 2) <= cmax);
            if (ahead) IDX_ISSUE(ch + 2, lds + ((ch + 2) % 3) * 32768);
#pragma unroll
            for (int j = 0; j < 8; ++j) {
                const int c = 8 * ch + j;
                {
                    f32x16 acc;
#pragma unroll
                    for (int i = 0; i < 16; ++i) acc[i] = 0.f;
#pragma unroll
                    for (int kk = 0; kk < 4; ++kk) { const bf16x8 kf = *(const LAS bf16x8*)(cur + j * 4096 + (fb ^ (unsigned)(kk << 5))); acc = __builtin_amdgcn_mfma_f32_32x32x16_bf16(af[kk], kf, acc, 0, 0, 0); }
                    float s4[4] = {0.f, 0.f, 0.f, 0.f};
#pragma unroll
                    for (int i = 0; i < 16; ++i) { const float av = acc[i]; const int rb = __float_as_int(av); s4[i & 3] += wg[i] * __int_as_float(rb > 0 ? rb : 0); }
                    const float sv = (s4[0] + s4[1]) + (s4[2] + s4[3]); const bool ok = (32 * c + r <= myq);
                    u[c] = ok ? sv : -INFINITY; mx4[j & 3] = fmaxf(mx4[j & 3], ok ? sv : -INFINITY); mn4[j & 3] = fminf(mn4[j & 3], ok ? sv : INFINITY);
                }
            }
            if (ahead) asm volatile("s_waitcnt vmcnt(4)" ::: "memory"); else asm volatile("s_waitcnt vmcnt(0)" ::: "memory");
            LDS_BARRIER();
        } else {
#pragma unroll
            for (int j = 0; j < 8; ++j) u[8 * ch + j] = -INFINITY;
        }
    }
#undef IDX_ISSUE
    if (mode == 1) return;
    float T = -3.0e38f;
    if (qa >= 256) {
        float L = half_min(fminf(fminf(mn4[0], mn4[1]), fminf(mn4[2], mn4[3]))), H = half_max(fmaxf(fmaxf(mx4[0], mx4[1]), fmaxf(mx4[2], mx4[3])));
        bool done0 = false, done1 = false;
        for (int it = 0; it < 48; ++it) {
            const float mid = 0.5f * L + 0.5f * H;
            int cn4[4] = {0, 0, 0, 0};
#pragma unroll
            for (int g = 0; g < 8; ++g)
                if (8 * g <= cmax) {
#pragma unroll
                    for (int j = 0; j < 8; ++j) cn4[j & 3] += (u[8 * g + j] >= mid) ? 1 : 0;
                }
            int cnt = (cn4[0] + cn4[1]) + (cn4[2] + cn4[3]);
            cnt += __builtin_amdgcn_update_dpp(0, cnt, 0xB1, 0xF, 0xF, true);
            cnt += __builtin_amdgcn_update_dpp(0, cnt, 0x4E, 0xF, 0xF, true);
            cnt += __builtin_amdgcn_update_dpp(0, cnt, 0x141, 0xF, 0xF, true);
            cnt += __builtin_amdgcn_update_dpp(0, cnt, 0x140, 0xF, 0xF, true);
            const int c0 = __builtin_amdgcn_readlane(cnt, 0) + __builtin_amdgcn_readlane(cnt, 16);
            const int c1 = __builtin_amdgcn_readlane(cnt, 32) + __builtin_amdgcn_readlane(cnt, 48);
            const int mine = hs ? c1 : c0; const bool mydone = hs ? done1 : done0;
            if (!mydone) { if (mine == 256) T = mid; else if (mine > 256) L = mid; else H = mid; }
            done0 |= (c0 == 256); done1 |= (c1 == 256);
            if (done0 && done1) break;
        }
        if (!(hs ? done1 : done0)) T = L;
    }
    unsigned wl4[4] = {0u, 0u, 0u, 0u}, wh4[4] = {0u, 0u, 0u, 0u};
#pragma unroll
    for (int g = 0; g < 8; ++g)
        if (8 * g <= cmax) {
#pragma unroll
            for (int j = 0; j < 8; ++j) {
                const int c = 8 * g + j;
                const unsigned long long bal = __ballot(u[c] >= T);
                const unsigned blo = (unsigned)bal, bhi = (unsigned)(bal >> 32);
                asm volatile("s_nop 3\n\tv_writelane_b32 %0, %2, %4\n\tv_writelane_b32 %1, %3, %4" : "+v"(wl4[j & 3]), "+v"(wh4[j & 3]) : "s"(blo), "s"(bhi), "i"(c));
            }
            __builtin_amdgcn_sched_barrier(0);
        }
    const unsigned wlo = (wl4[0] | wl4[1]) | (wl4[2] | wl4[3]), whi = (wh4[0] | wh4[1]) | (wh4[2] | wh4[3]);
    MASK[(size_t)(b * SEQ + qa) * 64 + lane] = wlo; MASK[(size_t)(b * SEQ + qa + 1) * 64 + lane] = whi;
    LDS_WAIT();
}

__device__ __forceinline__ void sgu_unit(int b, int c, int g, const bf16* WSP, const bf16* VBT, const bf16* U, const float* rowsq_vb, float vbscale, const float* sgu_g, const float* bsp, bf16* OAB, LAS float* rsl, int wave, int lane) {
    const int tb = (wave >> 1) * 32, dblk = (wave & 1) * 64, r = lane & 31, hs = lane >> 5;
    LAS float* rw = rsl + wave * 128;
    const float q0 = rowsq_vb[b * SEQ + c * CHUNK + lane], q1 = rowsq_vb[b * SEQ + c * CHUNK + 64 + lane];
    f32x16 acc[2];
#pragma unroll
    for (int i = 0; i < 16; ++i) { acc[0][i] = 0.f; acc[1][i] = 0.f; }
    const int kkmax = 2 * (wave >> 1) + 1;
    u32x4 raw[8]; bf16x8 vfr[8][2];
#pragma unroll
    for (int kk = 0; kk < 8; ++kk)
        if (kk <= kkmax) {
            raw[kk] = *(const u32x4*)(WSP + (size_t)(g * CHUNK + tb + r) * CHUNK + 16 * kk + 8 * hs);
#pragma unroll
            for (int j2 = 0; j2 < 2; ++j2) vfr[kk][j2] = *(const bf16x8*)(VBT + ((size_t)(b * 1024 + g * 128 + dblk + 32 * j2 + r)) * 2048 + c * CHUNK + 16 * kk + 8 * hs);
        }
    const int t = tb + r; const size_t row = (size_t)(b * SEQ + c * CHUNK + t); const float bt = bsp[g * CHUNK + t];
    u32x2 uraw[2][4];
#pragma unroll
    for (int j2 = 0; j2 < 2; ++j2)
#pragma unroll
        for (int q4 = 0; q4 < 4; ++q4) uraw[j2][q4] = *(const u32x2*)(U + row * 1024 + g * 128 + dblk + 32 * j2 + 8 * q4 + 4 * hs);
    rw[lane] = 1.0f / sqrtf(q0 * vbscale + EPS); rw[64 + lane] = 1.0f / sqrtf(q1 * vbscale + EPS);
    LDS_WAIT();
#pragma unroll
    for (int kk = 0; kk < 8; ++kk)
        if (kk <= kkmax) {
            const LAS float* rp = rw + 16 * kk + 8 * hs;
            u32x4 sc;
            sc.x = pk2(bf2f(raw[kk].x & 0xffffu) * rp[0], bf2f(raw[kk].x >> 16) * rp[1]); sc.y = pk2(bf2f(raw[kk].y & 0xffffu) * rp[2], bf2f(raw[kk].y >> 16) * rp[3]);
            sc.z = pk2(bf2f(raw[kk].z & 0xffffu) * rp[4], bf2f(raw[kk].z >> 16) * rp[5]); sc.w = pk2(bf2f(raw[kk].w & 0xffffu) * rp[6], bf2f(raw[kk].w >> 16) * rp[7]);
            const bf16x8 wfr = __builtin_bit_cast(bf16x8, sc);
#pragma unroll
            for (int j2 = 0; j2 < 2; ++j2) acc[j2] = __builtin_amdgcn_mfma_f32_32x32x16_bf16(vfr[kk][j2], wfr, acc[j2], 0, 0, 0);
        }
#pragma unroll
    for (int j2 = 0; j2 < 2; ++j2)
#pragma unroll
        for (int q4 = 0; q4 < 4; ++q4) {
            const int d = g * 128 + dblk + 32 * j2 + 8 * q4 + 4 * hs;
            const f32x4 gd = *(const f32x4*)(sgu_g + d); const u32x2 uw = uraw[j2][q4]; f32x4 uv, o;
            uv[0] = bf2f(uw.x & 0xffffu); uv[1] = bf2f(uw.x >> 16); uv[2] = bf2f(uw.y & 0xffffu); uv[3] = bf2f(uw.y >> 16);
#pragma unroll
            for (int e = 0; e < 4; ++e) o[e] = uv[e] * (acc[j2][4 * q4 + e] * gd[e] + bt);
            store_bf16x4(OAB + row * 2048 + 1024 + d, o);
        }
    LDS_WAIT();
}

constexpr int AT_TILE = 16384, AT_BUF = 65536;
__device__ __forceinline__ void attn_issue(const bf16* Kg, const bf16* Vg, int s, LAS unsigned char* buf, int wave, unsigned voffK, unsigned voffV) {
#pragma unroll
    for (int tt = 0; tt < 2; ++tt)
#pragma unroll
        for (int j = 0; j < 2; ++j) {
            const int blk = wave + 8 * j;
            __builtin_amdgcn_global_load_lds((const unsigned*)((const char*)Kg + (size_t)(2 * s + tt) * 131072 + (size_t)j * 65536 + voffK), (LAS unsigned*)(buf + tt * AT_TILE + blk * 1024), 16, 0, 0);
            __builtin_amdgcn_global_load_lds((const unsigned*)((const char*)Vg + (size_t)(2 * s + tt) * 128 + (size_t)j * 262144 + voffV), (LAS unsigned*)(buf + 2 * AT_TILE + tt * AT_TILE + blk * 1024), 16, 0, 0);
        }
}
__device__ __forceinline__ void attn_unit(int b, int h, int iq, const bf16* Q, const bf16* K, const bf16* VT, const unsigned* MASK, const LAS float* tbl, bf16* OAB, LAS unsigned char* lds, int wave, int lane, int par, bool have_tile0, bool prefetch_next, bf16x8 (&qfx)[8], u32x2& mwx, int iq_next) {
    const int tid = threadIdx.x, qg = wave & 3, kg = wave >> 2, r = lane & 31, hs = lane >> 5;
    const int qw = 128 * iq + 32 * qg;
    const size_t qrow = (size_t)(b * SEQ + qw + r);
    const bf16* Kg = K + (size_t)(b * SEQ) * 1024 + h * HD;
    const bf16* Vg = VT + (size_t)(b * 1024 + h * HD) * 2048;
    const int nsteps = iq + 1;
    const int rq = 4 * wave + (lane >> 4);
    const unsigned voffK = (unsigned)(rq * 1024 + (((lane & 15) ^ (rq & 15)) * 8)) * 2u;
    const unsigned voffV = (unsigned)((8 * wave + (lane >> 3)) * 2048 + (((lane & 7) ^ (rq & 7)) * 8)) * 2u;
    if (!have_tile0) attn_issue(Kg, Vg, 0, lds + (par & 1) * AT_BUF, wave, voffK, voffV);
    bf16x8 qf[8]; u32x2 mw;
    if (have_tile0) {
#pragma unroll
        for (int kk = 0; kk < 8; ++kk) qf[kk] = qfx[kk];
        mw = mwx;
    } else {
#pragma unroll
        for (int kk = 0; kk < 8; ++kk) qf[kk] = *(const bf16x8*)(Q + qrow * 1024 + h * HD + 16 * kk + 8 * hs);
        mw = *(const u32x2*)(MASK + qrow * 64 + 2 * kg);
    }
    f32x16 o[4];
#pragma unroll
    for (int db = 0; db < 4; ++db)
#pragma unroll
        for (int i = 0; i < 16; ++i) o[db][i] = 0.f;
    float mref = 0.f, lrun = 0.f;
    const float c31 = tbl[128];
    const unsigned kbase = (unsigned)(r * 256 + (((r & 15) ^ hs) << 4));
    const unsigned vbase = (unsigned)(r * 128 + ((((r >> 1) & 7) ^ hs) << 4));
    AT_WAIT_BARRIER();
    for (int s = 0; s < nsteps; ++s) {
        LAS unsigned char* cur = lds + ((s + par) & 1) * AT_BUF; LAS unsigned char* nxt = lds + ((s + 1 + par) & 1) * AT_BUF;
        const bool more = (s + 1 < nsteps);
        if (more) attn_issue(Kg, Vg, s + 1, nxt, wave, voffK, voffV);
        else if (prefetch_next) attn_issue(Kg, Vg, 0, nxt, wave, voffK, voffV);
        const int t = 2 * s + kg;
        u32x2 mwn = mw;
        if (more) mwn = *(const u32x2*)(MASK + qrow * 64 + 2 * (t + 2));
        f32x16 p[2];
        const LAS unsigned char* Kt = cur + kg * AT_TILE;
        unsigned kofs = kbase; asm volatile("" : "+v"(kofs));
        const bool far = (qw - (64 * t + 63)) >= 113;
        if (far) {
            const int cb = __float_as_int(c31 - mref);
#pragma unroll
            for (int kb = 0; kb < 2; ++kb) {
                const int word = (int)((kb == 0 ? mw.x : mw.y) >> (4 * hs));
#pragma unroll
                for (int i = 0; i < 16; ++i) { const int tmask = __builtin_amdgcn_sbfe(word, rowoff16(i), 1); int rr; asm("v_bfi_b32 %0, %1, %2, %3" : "=v"(rr) : "v"(tmask), "v"(cb), "v"((int)0xFF800000)); p[kb][i] = __int_as_float(rr); }
            }
        } else {
            const int dist0 = (qw + r) - (64 * t + 4 * hs);
#pragma unroll
            for (int kb = 0; kb < 2; ++kb) {
                const int word = (int)((kb == 0 ? mw.x : mw.y) >> (4 * hs));
#pragma unroll
                for (int i = 0; i < 16; ++i) {
                    int di = dist0 - 32 * kb - rowoff16(i); di = di < 0 ? 0 : (di > 128 ? 128 : di);
                    const int cb = __float_as_int(tbl[di] - mref); const int tmask = __builtin_amdgcn_sbfe(word, rowoff16(i), 1); int rr;
                    asm("v_bfi_b32 %0, %1, %2, %3" : "=v"(rr) : "v"(tmask), "v"(cb), "v"((int)0xFF800000)); p[kb][i] = __int_as_float(rr);
                }
            }
        }
#pragma unroll
        for (int kb = 0; kb < 2; ++kb)
#pragma unroll
            for (int kk = 0; kk < 8; ++kk) {
                const bf16x8 kf = *(const LAS bf16x8*)(Kt + kb * 8192 + (kofs ^ (unsigned)(kk << 5)));
                p[kb] = __builtin_amdgcn_mfma_f32_32x32x16_bf16(kf, qf[kk], p[kb], 0, 0, 0);
            }
        float mx4[4] = {-INFINITY, -INFINITY, -INFINITY, -INFINITY};
#pragma unroll
        for (int kb = 0; kb < 2; ++kb)
#pragma unroll
            for (int i = 0; i < 16; ++i) { const float v = p[kb][i]; mx4[i & 3] = fmaxf(mx4[i & 3], v); }
        float mx = fmaxf(fmaxf(mx4[0], mx4[1]), fmaxf(mx4[2], mx4[3]));
        mx = fmaxf(mx, __shfl_xor(mx, 32));
        if (__any(mx > 8.0f)) {
            const float d = fmaxf(mx, 0.f), f = __builtin_amdgcn_exp2f(-d);
            mref += d; lrun *= f;
#pragma unroll
            for (int kb = 0; kb < 2; ++kb)
#pragma unroll
                for (int i = 0; i < 16; ++i) p[kb][i] -= d;
#pragma unroll
            for (int db = 0; db < 4; ++db)
#pragma unroll
                for (int i = 0; i < 16; ++i) o[db][i] *= f;
        }
        float ls4[4] = {0.f, 0.f, 0.f, 0.f};
#pragma unroll
        for (int kb = 0; kb < 2; ++kb)
#pragma unroll
            for (int i = 0; i < 16; ++i) { const float pv = p[kb][i]; const float e = __builtin_amdgcn_exp2f(pv); p[kb][i] = e; ls4[i & 3] += e; }
        lrun += (ls4[0] + ls4[1]) + (ls4[2] + ls4[3]);
        const LAS unsigned char* Vt = cur + 2 * AT_TILE + kg * AT_TILE;
        unsigned vofs = vbase; asm volatile("" : "+v"(vofs));
#pragma unroll
        for (int s4 = 0; s4 < 4; ++s4) {
            const int kb = s4 >> 1, e0 = 8 * (s4 & 1);
            u32x4 w; w.x = pk2(p[kb][e0], p[kb][e0 + 1]); w.y = pk2(p[kb][e0 + 2], p[kb][e0 + 3]); w.z = pk2(p[kb][e0 + 4], p[kb][e0 + 5]); w.w = pk2(p[kb][e0 + 6], p[kb][e0 + 7]);
            const bf16x8 pf = __builtin_bit_cast(bf16x8, w);
#pragma unroll
            for (int db = 0; db < 4; ++db) {
                const bf16x8 vf = *(const LAS bf16x8*)(Vt + db * 4096 + (vofs ^ (unsigned)((2 * s4) << 4)));
                o[db] = __builtin_amdgcn_mfma_f32_32x32x16_bf16(vf, pf, o[db], 0, 0, 0);
            }
        }
        mw = mwn;
        AT_WAIT_BARRIER();
    }
    if (prefetch_next) {
        const size_t qrow2 = (size_t)(b * SEQ + 128 * iq_next + 32 * qg + r);
#pragma unroll
        for (int kk = 0; kk < 8; ++kk) qfx[kk] = *(const bf16x8*)(Q + qrow2 * 1024 + h * HD + 16 * kk + 8 * hs);
        mwx = *(const u32x2*)(MASK + qrow2 * 64 + 2 * kg);
    }
    lrun += __shfl_xor(lrun, 32);
    LAS unsigned char* ebase = lds + ((nsteps - 1 + par) & 1) * AT_BUF;
    LAS unsigned* comb = (LAS unsigned*)(ebase + qg * 8704); LAS float* combf = (LAS float*)(ebase + qg * 8704 + 8192);
    if (kg == 1) {
#pragma unroll
        for (int db = 0; db < 4; ++db)
#pragma unroll
            for (int i2 = 0; i2 < 8; ++i2) comb[(db * 8 + i2) * 64 + lane] = pk2(o[db][2 * i2], o[db][2 * i2 + 1]);
        combf[lane] = mref; combf[64 + lane] = lrun;
    }
    LDS_BARRIER();
    if (kg == 0) {
        const float m1 = combf[lane], l1 = combf[64 + lane];
        const float mm = fmaxf(mref, m1);
        const float a0 = __builtin_amdgcn_exp2f(mref - mm), a1 = __builtin_amdgcn_exp2f(m1 - mm);
        const float inv = 1.0f / (lrun * a0 + l1 * a1);
        const float s0 = a0 * inv, s1 = a1 * inv;
        LAS unsigned char* stg = ebase + 34816 + qg * 4608;
#pragma unroll
        for (int db = 0; db < 4; ++db)
#pragma unroll
            for (int i4 = 0; i4 < 4; ++i4) {
                float v[4];
                const unsigned c01 = comb[(db * 8 + 2 * i4) * 64 + lane], c23 = comb[(db * 8 + 2 * i4 + 1) * 64 + lane];
                v[0] = o[db][4 * i4] * s0 + bf2f(c01 & 0xffffu) * s1; v[1] = o[db][4 * i4 + 1] * s0 + bf2f(c01 >> 16) * s1;
                v[2] = o[db][4 * i4 + 2] * s0 + bf2f(c23 & 0xffffu) * s1; v[3] = o[db][4 * i4 + 3] * s0 + bf2f(c23 >> 16) * s1;
                *(LAS unsigned*)(stg + r * 144 + (32 * db + 8 * i4 + 4 * hs)) = pk4_fp8(v[0] * OA_SCALE, v[1] * OA_SCALE, v[2] * OA_SCALE, v[3] * OA_SCALE);
            }
        LDS_WAIT();
#pragma unroll
        for (int j = 0; j < 4; ++j) {
            const int cid = lane + 64 * j, row = cid >> 3, ch = cid & 7;
            const u32x4 v = *(const LAS u32x4*)(stg + row * 144 + ch * 16);
            *(u32x4*)((unsigned char*)OAB + ((size_t)(b * SEQ + qw + row)) * 4096 + h * HD + ch * 16) = v;
        }
    }
    LDS_BARRIER();
}

#define XB_TMO      128
#define XB_XCNT(j)  (256  + 64 * (j))
#define XB_XSUB(j)  (1280 + 64 * (j))
#define XB_XGEN(j)  (2304 + 64 * (j))
#define XB_TOP      3328
#define XB_TOPGEN   3392
#define XCD_BAR_WORDS 3456
#define XB_SPIN_CAP (1u << 22)
__device__ __forceinline__ unsigned xb_ld(unsigned* p)              { return __hip_atomic_load(p, __ATOMIC_RELAXED, __HIP_MEMORY_SCOPE_AGENT); }
__device__ __forceinline__ unsigned xb_add(unsigned* p, unsigned v) { return __hip_atomic_fetch_add(p, v, __ATOMIC_RELAXED, __HIP_MEMORY_SCOPE_AGENT); }
__device__ __forceinline__ unsigned xb_xcc_id() { return (unsigned)__builtin_amdgcn_s_getreg((3 << 11) | 20) & 0xFu; }
#define XB_SPIN(cond, bar) do { unsigned _sp = 0; while (cond) { __builtin_amdgcn_s_sleep(1); \
    if ((++_sp & 255u) == 0u) { if (xb_ld(&(bar)[XB_TMO])) break; if (_sp > XB_SPIN_CAP) { atomicAdd(&(bar)[XB_TMO], 1u); break; } } } } while (0)
struct XcdBarrier { unsigned* bar; unsigned x; volatile LAS unsigned* st; };
__device__ __forceinline__ XcdBarrier xcd_barrier_post(unsigned* bar, volatile LAS unsigned* st) {
    XcdBarrier b; b.bar = bar; b.x = xb_xcc_id(); b.st = st;
    if (threadIdx.x == 0) (void)xb_add(&bar[XB_XCNT(b.x)], 1u);
    return b;
}
__device__ __forceinline__ void xcd_barrier_complete(unsigned* bar, unsigned x, unsigned& nloc, unsigned& nx) {
    const unsigned G = gridDim.x * gridDim.y * gridDim.z;
    unsigned sum, cnt, mine, sp = 0u;
    for (;;) {
        sum = 0u; cnt = 0u; mine = 0u;
#pragma unroll
        for (unsigned j = 0; j < 16; ++j) { const unsigned c = xb_ld(&bar[XB_XCNT(j)]); sum += c; cnt += (c > 0u) ? 1u : 0u; mine = (j == x) ? c : mine; }
        if (sum == G) break;
        __builtin_amdgcn_s_sleep(1);
        if ((++sp & 255u) == 0u) { if (xb_ld(&bar[XB_TMO])) break; if (sp > XB_SPIN_CAP) { atomicAdd(&bar[XB_TMO], 1u); break; } }
    }
    nloc = mine > 0u ? mine : 1u; nx = cnt > 0u ? cnt : 1u;
}
__device__ __forceinline__ void xcd_barrier(const XcdBarrier& b) {
    asm volatile("s_waitcnt vmcnt(0)" ::: "memory");
    __syncthreads();
    if (threadIdx.x == 0) {
        unsigned* bar = b.bar;
        __builtin_amdgcn_s_waitcnt(0);
        unsigned nloc = b.st[0], nx = b.st[1];
        if (nloc == 0u) { xcd_barrier_complete(bar, b.x, nloc, nx); b.st[0] = nloc; b.st[1] = nx; }
        const unsigned old = xb_add(&bar[XB_XSUB(b.x)], 1u);
        const unsigned gen = old / nloc;
        if (old + 1u == (gen + 1u) * nloc) {
            __builtin_amdgcn_fence(__ATOMIC_RELEASE, "agent");
            asm volatile("s_waitcnt vmcnt(0)" ::: "memory");
            const unsigned og = xb_add(&bar[XB_TOP], 1u);
            const unsigned tg = og / nx;
            if (og + 1u == (tg + 1u) * nx) xb_add(&bar[XB_TOPGEN], 1u);
            else XB_SPIN(xb_ld(&bar[XB_TOPGEN]) == tg, bar);
            __builtin_amdgcn_fence(__ATOMIC_ACQUIRE, "agent");
            xb_add(&bar[XB_XGEN(b.x)], 1u);
            asm volatile("s_waitcnt vmcnt(0)" ::: "memory");
        } else {
            XB_SPIN(xb_ld(&bar[XB_XGEN(b.x)]) == gen, bar);
            __builtin_amdgcn_fence(__ATOMIC_ACQUIRE, "agent");
            asm volatile("s_waitcnt vmcnt(0)" ::: "memory");
        }
    }
    __syncthreads();
}

struct Args { Ptrs p; int ph_lo, ph_hi, vbrep, mode; };
constexpr int NPHASE = 8;

__global__ void __launch_bounds__(512, 2) fwd(Args args) {
    extern __shared__ __attribute__((aligned(16))) unsigned char lds_raw[];
    LAS unsigned char* lds = (LAS unsigned char*)lds_raw;
    const Ptrs& P = args.p; unsigned char* ws = P.ws;
    const int tid = threadIdx.x, lane = tid & 63, wave = __builtin_amdgcn_readfirstlane(tid >> 6);
    const int G = gridDim.x, bx = blockIdx.x;
    const int vcu = (G % 8 == 0) ? (bx % 8) * (G / 8) + bx / 8 : bx;
    const int lo = args.ph_lo, hi = args.ph_hi;
#ifndef PHASE_MASK
#define PHASE_MASK 0xff
#endif
#define IN(k) (((PHASE_MASK >> (k)) & 1) && lo <= (k) && (k) < hi)
#if ONE_LAUNCH
    volatile LAS unsigned* bst = (volatile LAS unsigned*)(lds + LDS_BYTES - 64);
    if (tid < 16) bst[tid] = 0u;
    {
        unsigned* ctl = (unsigned*)(ws + WS_CTL);
        for (int i = bx * 512 + tid; i < (int)(CTL_BYTES / 4); i += G * 512) __hip_atomic_store(&ctl[i], 0u, __ATOMIC_RELAXED, __HIP_MEMORY_SCOPE_AGENT);
        asm volatile("s_waitcnt vmcnt(0)" ::: "memory");
    }
    __syncthreads();
    if (tid == 0) __builtin_amdgcn_fence(__ATOMIC_RELEASE, "agent");
    cg::this_grid().sync();
    XcdBarrier xbar = xcd_barrier_post((unsigned*)(ws + WS_CTL + CTL_BAR), bst);
#define SEAM(k) do { if (IN(k) && IN((k) + 1)) { xcd_barrier(xbar); if (NREP(13) == 2) xcd_barrier(xbar); } } while (0)
#else
#define SEAM(k) do { } while (0)
#endif
    bf16* WIN = (bf16*)(ws + WS_WIN); bf16* WAB = (bf16*)(ws + WS_WAB); bf16* WOUT = (bf16*)(ws + WS_WOUT); bf16* W1 = (bf16*)(ws + WS_W1); bf16* W2 = (bf16*)(ws + WS_W2);
    bf16* H1 = (bf16*)(ws + WS_H1); bf16* OAB = (bf16*)(ws + WS_OAB); bf16* ACT = (bf16*)(ws + WS_ACT);
    bf16* Qb = (bf16*)(ws + WS_Q); bf16* Kb = (bf16*)(ws + WS_K); bf16* VT = (bf16*)(ws + WS_VT); bf16* QI = (bf16*)(ws + WS_QI);
    bf16* Ub = (bf16*)(ws + WS_U); bf16* VBT = (bf16*)(ws + WS_VBT); bf16* X1B = (bf16*)(ws + WS_X1B); const unsigned char* GA = ws + WS_GA; const unsigned char* GB = ws + WS_GB;
    bf16* KI = (bf16*)(ws + WS_KI); float* WI = (float*)(ws + WS_WI); bf16* WSP = (bf16*)(ws + WS_WSP); float* TBL = (float*)(ws + WS_TBL);
    unsigned* MASK = (unsigned*)(ws + WS_MASK); bf16* MERGED = (bf16*)(ws + WS_MERGED);
    float* rowsq_vb = (float*)(ws + WS_CTL + CTL_ROWSQ_VB); float* rowsq2 = (float*)(ws + WS_CTL + CTL_ROWSQ2);

    if (IN(0)) for (int rep = 0; rep < NREP(0); ++rep) { p0_prologue(P, lds, vcu, G); }
    SEAM(0);
    if (IN(1)) for (int rep = 0; rep < NREP(1); ++rep) {
        { pg8::Gemm g{H1, WIN, MTOK, P1_NB16, DM, DM, DM}; pg8::StaticOrder S; S.init(MTOK, P1_NB16, G, bx);
          EpiIn<false> E{ws, P.q_norm_g, P.k_norm_g};
          pg8::gemm_phase<EpiIn<false>, pg8::NoMid, NREP(12)>(lds, g, S, E); }
        { pg8::Gemm g{(const pg8::bf16_t*)((const unsigned char*)P.out + OUT_H1F8), (const pg8::bf16_t*)((const unsigned char*)P.out + OUT_W8), MTOK, P1_NF8, DM / 2, DM / 2, DM / 2}; pg8::StaticOrder S; S.init(MTOK, P1_NF8, G, bx);
          EpiIn<true> E{ws, P.q_norm_g, P.k_norm_g};
          pg8::gemm_phase<EpiIn<true>, pg8::NoMid, 1, pg8::StaticOrder, true>(lds, g, S, E); }
        for (int rb = bx; rb < MTOK / 32; rb += G) kiwi_unit(rb, H1, WIN, P.idx_k_norm_g, KI, WI, lds, wave, lane);
    }
    SEAM(1);
    if (IN(2)) for (int rep = 0; rep < NREP(2); ++rep) {
        for (int r2 = 0; r2 < NREP(8); ++r2)
        for (int p = vcu; p < 256; p += G) { const int b = p >> 6, i = p & 63; indexer_unit(b, i, QI, KI, WI, MASK, lds, wave, lane, args.mode); indexer_unit(b, 127 - i, QI, KI, WI, MASK, lds, wave, lane, args.mode); }
#if ONE_LAUNCH
        asm volatile("s_waitcnt vmcnt(0)" ::: "memory");
        __syncthreads();
        if (IN(3) && tid == 0) { __builtin_amdgcn_fence(__ATOMIC_RELEASE, "agent"); asm volatile("s_waitcnt vmcnt(0)" ::: "memory"); (void)xb_add((unsigned*)(ws + WS_CTL + CTL_SEAM2), 1u); }
#else
        __syncthreads();
#endif
        if (args.mode == 0)
        for (int r2 = 0; r2 < NREP(9); ++r2)
        for (int un = vcu; un < 512; un += G) { const int b = un >> 7, c = (un >> 3) & 15, g = un & 7; sgu_unit(b, c, g, WSP, VBT, Ub, rowsq_vb, 1.0f / (float)(WBW * NREP(1) * NREP(12) * args.vbrep), P.sgu_norm_g, P.b_spatial, OAB, (LAS float*)(lds + SCR_OFF), wave, lane); }
    }
#if ONE_LAUNCH
    if (IN(2) && IN(3)) {
        __syncthreads();
        if (tid == 0) { unsigned* c2 = (unsigned*)(ws + WS_CTL + CTL_SEAM2); XB_SPIN(xb_ld(c2) < (unsigned)G, xbar.bar); __builtin_amdgcn_fence(__ATOMIC_ACQUIRE, "agent"); asm volatile("s_waitcnt vmcnt(0)" ::: "memory"); }
        __syncthreads();
    }
#endif
    if (IN(3)) for (int rep = 0; rep < NREP(3); ++rep) {
        LAS float* tbl = (LAS float*)(lds + SCR_OFF);
        for (int p = vcu; p < 256; p += G) {
            const int b = p >> 6, h = (p >> 3) & 7, i = p & 7;
            __syncthreads();
            if (tid < 132) tbl[tid] = TBL[h * 132 + tid];
            __syncthreads();
            bf16x8 qfx[8]; u32x2 mwx;
            attn_unit(b, h, i, Qb, Kb, VT, MASK, tbl, OAB, lds, wave, lane, 0, false, true, qfx, mwx, 15 - i);
            attn_unit(b, h, 15 - i, Qb, Kb, VT, MASK, tbl, OAB, lds, wave, lane, (i + 1) & 1, true, false, qfx, mwx, 0);
        }
    }
    SEAM(3);
    if (IN(4)) for (int rep = 0; rep < NREP(4); ++rep) {
        pg8::Gemm g{OAB, WAB, MTOK, DM, 1536, DM, DM, 8}; pg8::StaticOrder S; S.init(MTOK, DM, G, bx);
        EpiMerge E{GB, MERGED}; MidMerge H{GA, GB, 1.0f / (GATE_WSCALE * OA_SCALE)}; pg8::gemm_phase<EpiMerge, MidMerge, 1, pg8::StaticOrder, 2>(lds, g, S, E, H);
    }
    SEAM(4);
    if (IN(5)) for (int rep = 0; rep < NREP(5); ++rep) {
        pg8::Gemm g{MERGED, WOUT, MTOK, DM, DM, DM, DM}; pg8::StaticOrder S; S.init(MTOK, DM, G, bx);
        EpiOut E{P.x, X1B, rowsq2}; pg8::gemm_phase(lds, g, S, E);
    }
    SEAM(5);
    if (IN(6)) for (int rep = 0; rep < NREP(6); ++rep) {
        { pg8::Gemm g{X1B, W1, MTOK, 10240, DM, DM, DM}; pg8::StaticOrder S; S.init(MTOK, 10240, G, bx); EpiFfnUp E{rowsq2, ACT, 0}; pg8::gemm_phase(lds, g, S, E); }
        if (G == 256) {
            const int xcd = bx & 7, idx = bx >> 3, t = xcd * 16 + (idx >> 1), half = idx & 1;
            pg8::Gemm g{X1B + half * 1024, W1 + (size_t)10240 * 2048 + half * 1024, MTOK, 1024, 1024, DM, DM}; pg8::OneUnit S{t >> 2, t & 3};
            EpiFfnUpPair E{rowsq2, ACT, 40, half, (float*)(ws + WS_SLAB) + (size_t)t * 65536, (unsigned*)(ws + WS_CTL + CTL_PAIR) + t * 16};
            pg8::gemm_phase<EpiFfnUpPair, pg8::NoMid, 1, pg8::OneUnit>(lds, g, S, E);
        } else {
            pg8::Gemm g{X1B, W1 + (size_t)10240 * 2048, MTOK, 1024, DM, DM, DM}; pg8::StaticOrder S; S.init(MTOK, 1024, G, bx); EpiFfnUp E{rowsq2, ACT, 40}; pg8::gemm_phase(lds, g, S, E);
        }
    }
    SEAM(6);
    if (IN(7)) for (int rep = 0; rep < NREP(7); ++rep) {
        pg8::Gemm g{ACT, W2, MTOK, DM, FFN_T8 * 64 + (DFF - FFN_KF), DFF, DFF, FFN_T8}; pg8::StaticOrder S; S.init(MTOK, DM, G, bx);
        EpiFfnDown E{X1B, P.out}; MidScale H{1.0f / GATE_WSCALE}; pg8::gemm_phase<EpiFfnDown, MidScale, 1, pg8::StaticOrder, 2>(lds, g, S, E, H);
    }
#undef IN
#undef SEAM
}

extern "C" void kernel_launch(void* const* d_in, const int* in_sizes, int n_in, void* d_out, int out_size, void* d_ws, size_t ws_size, hipStream_t stream) {
    static int grid = 0;
    if (grid == 0) {
        if (n_in != 17 || in_sizes[0] != MTOK * DM || out_size != MTOK * DM || ws_size < WS_END) { fprintf(stderr, "kernel_launch: unexpected shapes (n_in %d, in0 %d, out %d, ws %zu < %zu); nothing launched\n", n_in, n_in > 0 ? in_sizes[0] : -1, out_size, ws_size, (size_t)WS_END); grid = -1; return; }
        int dev = 0, cus = 0;
        if (hipGetDevice(&dev) != hipSuccess || hipDeviceGetAttribute(&cus, hipDeviceAttributeMultiprocessorCount, dev) != hipSuccess) { grid = -1; return; }
        if (hipFuncSetAttribute((const void*)fwd, hipFuncAttributeMaxDynamicSharedMemorySize, LDS_BYTES) != hipSuccess) { fprintf(stderr, "kernel_launch: hipFuncSetAttribute failed\n"); grid = -1; return; }
        int per_cu = 0;
        if (hipOccupancyMaxActiveBlocksPerMultiprocessor(&per_cu, (const void*)fwd, 512, LDS_BYTES) != hipSuccess || per_cu < 1) { fprintf(stderr, "kernel_launch: occupancy query says %d blocks per CU\n", per_cu); (void)hipGetLastError(); grid = -1; return; }
        grid = cus;
    }
    if (grid < 0) return;
#if !ONE_LAUNCH
    (void)hipMemsetAsync((char*)d_ws + WS_CTL, 0, CTL_BYTES, stream);
#endif
    Args a{};
    const float** pp = (const float**)&a.p;
    for (int i = 0; i < 17; ++i) pp[i] = (const float*)d_in[i];
    a.p.out = (float*)d_out; a.p.ws = (unsigned char*)d_ws;
#if ONE_LAUNCH
    a.ph_lo = 0; a.ph_hi = NPHASE; a.vbrep = 1; a.mode = 0;
    void* kargs[] = {&a};
    hipError_t e = hipLaunchCooperativeKernel((const void*)fwd, dim3(grid), dim3(512), kargs, LDS_BYTES, stream);
    if (e != hipSuccess) fprintf(stderr, "cooperative launch failed: %s (grid %d)\n", hipGetErrorString(e), grid);
#else
#ifndef ML_REP_PHASE
#define ML_REP_PHASE -1
#endif
    a.vbrep = (ML_REP_PHASE == 1) ? 2 : 1; a.mode = 0;
#ifndef ML_P2_MODE
#define ML_P2_MODE 0
#endif
    for (int ph = 0; ph < NPHASE; ++ph) { a.ph_lo = ph; a.ph_hi = ph + 1; if (ph == 2 && ML_P2_MODE) { a.mode = ML_P2_MODE; hipLaunchKernelGGL(fwd, dim3(grid), dim3(512), LDS_BYTES, stream, a); a.mode = 0; }
        for (int k = 0; k < ((ph == ML_REP_PHASE) ? 2 : 1); ++k) hipLaunchKernelGGL(fwd, dim3(grid), dim3(512), LDS_BYTES, stream, a); }
#endif
}
```

```cpp
#include <hip/hip_runtime.h>
#include <hip/hip_cooperative_groups.h>
#include <cstdio>
#include <cstdint>
namespace cg = cooperative_groups;

#ifndef ONE_LAUNCH
#define ONE_LAUNCH 1
#endif
#ifndef REP_MASK
#define REP_MASK 0
#endif
#define NREP(k) (((REP_MASK >> (k)) & 1) ? 2 : 1)

#define LAS __attribute__((address_space(3)))
typedef unsigned short bf16;
typedef short bf16x8 __attribute__((ext_vector_type(8)));
typedef float f32x4 __attribute__((ext_vector_type(4)));
typedef float f32x16 __attribute__((ext_vector_type(16)));
typedef unsigned u32x4 __attribute__((ext_vector_type(4)));
typedef unsigned u32x2 __attribute__((ext_vector_type(2)));
typedef int i32x4 __attribute__((ext_vector_type(4)));
typedef int i32x8 __attribute__((ext_vector_type(8)));

constexpr int NB = 4, SEQ = 2048, DM = 2048, MTOK = NB * SEQ;
constexpr int WA = 1024, NH = 8, HD = 128, NIH = 16, IDXD = 64, WBW = 1024, NG = 8, CHUNK = 128;
constexpr int DFF = 5632, DIN = 10320, NIN = 10496;
constexpr float EPS = 1e-6f;
constexpr float LOG2E = 1.4426950408889634f;

constexpr size_t MiB = 1u << 20;
constexpr size_t WS_CTL = 0, CTL_BYTES = 144 * 1024;
constexpr size_t WS_KI = 1 * MiB;
constexpr size_t WS_WI = 2 * MiB;
constexpr size_t WS_WSP = 2 * MiB + 512 * 1024, WS_TBL = 2 * MiB + 768 * 1024;
constexpr size_t WS_MASK = 3 * MiB;
constexpr size_t WS_WIN = 5 * MiB;
constexpr size_t WS_MERGED = 5 * MiB;
constexpr size_t WS_SLAB = 5 * MiB;
constexpr size_t WS_WAB = 46 * MiB;
constexpr size_t WS_WOUT = 54 * MiB;
constexpr size_t WS_W1 = 62 * MiB;
constexpr size_t WS_W2 = 106 * MiB;
constexpr size_t WS_H1 = 128 * MiB;
constexpr size_t WS_OAB = 128 * MiB;
constexpr size_t WS_ACT = 128 * MiB;
constexpr size_t WS_Q = 160 * MiB, WS_K = 176 * MiB, WS_VT = 192 * MiB, WS_QI = 208 * MiB;
constexpr size_t WS_U = 224 * MiB, WS_VBT = 240 * MiB;
constexpr size_t WS_X1B = 224 * MiB;
constexpr size_t WS_GA = 256 * MiB, WS_GB = 288 * MiB;
constexpr size_t WS_END = 320 * MiB;
constexpr size_t OUT_H1F8 = 0, OUT_W8 = 16 * MiB;
constexpr size_t CTL_ROWSQ_VB = 0, CTL_ROWSQ2 = 32768, CTL_BAR = 65536, CTL_SEAM2 = 98304, CTL_SEAM0 = 98368, CTL_PAIR = 131072;

constexpr int RING_BYTES = 131072, SCR_OFF = RING_BYTES, LDS_BYTES = 147456;

__device__ const unsigned char T5_BUCKET[128] = {0, 1, 2, 3, 4, 5, 6, 7, 8, 9, 10, 11, 12, 13, 14, 15, 16, 16, 16, 17, 17, 18, 18, 18, 19, 19, 19, 20, 20, 20, 20, 21, 21, 21, 21, 22, 22, 22, 22, 22, 23, 23, 23, 23, 23, 23, 24, 24, 24, 24, 24, 24, 25, 25, 25, 25, 25, 25, 25, 26, 26, 26, 26, 26, 26, 26, 26, 27, 27, 27, 27, 27, 27, 27, 27, 27, 27, 28, 28, 28, 28, 28, 28, 28, 28, 28, 28, 29, 29, 29, 29, 29, 29, 29, 29, 29, 29, 29, 29, 30, 30, 30, 30, 30, 30, 30, 30, 30, 30, 30, 30, 30, 30, 31, 31, 31, 31, 31, 31, 31, 31, 31, 31, 31, 31, 31, 31, 31};

__device__ __forceinline__ unsigned f2bf(float f) { unsigned u = __builtin_bit_cast(unsigned, f); return (u + 0x7fffu + ((u >> 16) & 1u)) >> 16; }
typedef float f32x2_t __attribute__((ext_vector_type(2))); typedef __bf16 bf16x2_t __attribute__((ext_vector_type(2)));
__device__ __forceinline__ unsigned pk2(float lo, float hi) { f32x2_t v = {lo, hi}; bf16x2_t b = __builtin_convertvector(v, bf16x2_t); return __builtin_bit_cast(unsigned, b); }
__device__ __forceinline__ float bf2f(unsigned v) { return __builtin_bit_cast(float, v << 16); }
__device__ __forceinline__ float sigmoidf_(float x) { return __builtin_amdgcn_rcpf(1.0f + __builtin_amdgcn_exp2f(-x * LOG2E)); }
__device__ __forceinline__ float gelu_tanh(float x) { const float t = x * (1.0f + 0.044715f * x * x) * (2.0f * 0.7978845608028654f); return x * sigmoidf_(t); }
__device__ __forceinline__ float wave_sum(float v) {
#pragma unroll
    for (int o = 1; o < 64; o <<= 1) v += __shfl_xor(v, o);
    return v;
}
__device__ __forceinline__ int rowoff16(int i) { return (i & 3) + 8 * (i >> 2); }
#define LDS_WAIT() asm volatile("s_waitcnt lgkmcnt(0)" ::: "memory")
#define LDS_BARRIER() do { asm volatile("s_waitcnt lgkmcnt(0)" ::: "memory"); __builtin_amdgcn_s_barrier(); asm volatile("" ::: "memory"); } while (0)
#define AT_WAIT_BARRIER() do { asm volatile("s_waitcnt vmcnt(0) lgkmcnt(0)" ::: "memory"); __builtin_amdgcn_s_barrier(); asm volatile("" ::: "memory"); } while (0)

namespace pg8 {
#define PG8_LAS __attribute__((address_space(3)))
typedef unsigned short bf16_t;
constexpr int BM = 256, BK = 64, HALF = 128, HTB = HALF * BK * 2, STAGE_BYTES = 8 * HTB, NXCD = 8, WGM = 8;
__host__ __device__ __forceinline__ int lds_byte(int r, int c) { const int st = (r >> 4) * 2 + (c >> 5), rr = r & 15, cc = c & 31, ob = rr * 64 + cc * 2; return st * 1024 + (ob ^ (((ob >> 9) & 1) << 5)); }
__host__ __device__ __forceinline__ void stage_rc(int b, int& R, int& C) { const int st = b / 1024, sb = b % 1024, swz = sb ^ (((sb >> 9) & 1) << 5); R = (st >> 1) * 16 + swz / 64; C = (st & 1) * 32 + (swz % 64) / 2; }
__host__ __device__ __forceinline__ int perm32(int rho) { const int n = rho >> 4, i = rho & 15; return 8 * (i >> 2) + 4 * n + (i & 3); }
struct Unit { int pm, pn; };
struct Gemm { const bf16_t* A; const bf16_t* Bt; int M, N, K, lda, ldb, T8 = 0; };
struct StaticOrder {
    int nM, nN, nwg, G, c;
    __host__ __device__ void init(int M, int N, int G_, int c_) { nM = M / BM; nN = N / BM; nwg = nM * nN; G = G_; c = c_; }
    __host__ __device__ bool next(int i, Unit& u) const {
        const long L = (long)i * G + c; if (L >= nwg) return false;
        int wgid = (int)L; { const int q = nwg / NXCD, r = nwg % NXCD, xcd = wgid % NXCD, off = wgid / NXCD; wgid = (xcd < r ? xcd * (q + 1) : r * (q + 1) + (xcd - r) * q) + off; }
        const int nig = WGM * nN, gid = wgid / nig, fm = gid * WGM, gsz = (nM - fm) < WGM ? (nM - fm) : WGM;
        u.pm = fm + ((wgid % nig) % gsz); u.pn = (wgid % nig) / gsz; return true;
    }
};
typedef f32x4 Acc[2][2][4][2];

template <bool F8> struct Frag;
template <> struct Frag<false> { bf16x8 k[2]; };
template <> struct Frag<true>  { i32x8 v; };
__device__ __forceinline__ void frag_ld(Frag<false>& d, const PG8_LAS unsigned char* p) { d.k[0] = *(const PG8_LAS bf16x8*)p; d.k[1] = *(const PG8_LAS bf16x8*)(p + 1024); }
__device__ __forceinline__ void frag_ld(Frag<true>& d, const PG8_LAS unsigned char* p) { d.v.lo = *(const PG8_LAS i32x4*)p; d.v.hi = *(const PG8_LAS i32x4*)(p + 1024); }
template <bool ASM> __device__ __forceinline__ void frag_mma(f32x4& c, const Frag<false>& b, const Frag<false>& a) {
    if constexpr (ASM) { asm volatile("v_mfma_f32_16x16x32_bf16 %0, %1, %2, %0" : "+v"(c) : "v"(b.k[0]), "v"(a.k[0])); asm volatile("v_mfma_f32_16x16x32_bf16 %0, %1, %2, %0" : "+v"(c) : "v"(b.k[1]), "v"(a.k[1])); }
    else { c = __builtin_amdgcn_mfma_f32_16x16x32_bf16(b.k[0], a.k[0], c, 0, 0, 0); c = __builtin_amdgcn_mfma_f32_16x16x32_bf16(b.k[1], a.k[1], c, 0, 0, 0); }
}
template <bool ASM> __device__ __forceinline__ void frag_mma(f32x4& c, const Frag<true>& b, const Frag<true>& a) { asm volatile("v_mfma_f32_16x16x128_f8f6f4 %0, %1, %2, %0" : "+v"(c) : "v"(b.v), "v"(a.v)); }
struct NoMid { static constexpr bool ACTIVE = false; __device__ __forceinline__ void operator()(Acc&, const Unit&, int, int, int, int) const {} };
struct OneUnit { int pm, pn; __device__ __forceinline__ bool next(int i, Unit& u) const { if (i != 0) return false; u.pm = pm; u.pn = pn; return true; } };
template <class Epi, class Mid = NoMid, int EREP = 1, class Sched = StaticOrder, int MODE = 0>
__device__ __forceinline__ void gemm_phase(PG8_LAS unsigned char* lds, const Gemm g, const Sched& S, const Epi& E, const Mid& H = Mid()) {
    int tid_ = threadIdx.x; asm volatile("" : "+v"(tid_));
    const int tid = tid_, wid = __builtin_amdgcn_readfirstlane(tid >> 6), lane = tid & 63, wr = wid >> 2, wc = wid & 3, fr = lane & 15, fq = lane >> 4;
    constexpr bool FP8 = MODE != 0;
    const int K = g.K, nt = K / BK, T8 = MODE == 2 ? g.T8 : 0, th = MODE == 2 ? T8 : (nt >> 1);
    unsigned voffA[2], voffB[2];
#pragma unroll
    for (int i = 0; i < 2; ++i) { int R, C; stage_rc(tid * 16 + i * 8192, R, C); const int Rb = Epi::PERM ? ((R & ~31) + perm32(R & 31)) : R; voffA[i] = (unsigned)(R * g.lda + C) * 2u; voffB[i] = (unsigned)(Rb * g.ldb + C) * 2u; }
    const size_t kstep = (size_t)(BK * 2);
    const size_t hstepA = (size_t)HALF * g.lda * 2, hstepB = (size_t)HALF * g.ldb * 2;
    const size_t tstepA = 2 * hstepA, tstepB = 2 * hstepB;
    const unsigned ldsw = (unsigned)wid * 1024u;
    const int aoff = lds_byte(wr * 64 + fr, fq * 8), boff = lds_byte(wc * 32 + fr, fq * 8);
#define PG8_SA(b, h) (((b) * 2 + (h)) * HTB)
#define PG8_SB(b, h) ((4 + (b) * 2 + (h)) * HTB)
#define PG8_STAGE(bufoff, gbase, voff) do { _Pragma("unroll") for (int _i = 0; _i < 2; ++_i) \
        __builtin_amdgcn_global_load_lds((const unsigned*)((const char*)(gbase) + (voff)[_i]), (PG8_LAS unsigned*)(lds + (bufoff) + ldsw + _i * 8192), 16, 0, 0); } while (0)
#define PG8_LDF(dst, i, base) frag_ld(dst[i], lds + (base) + (i) * 2048)
#define PG8_LDA(dst, b, h) do { _Pragma("unroll") for (int m = 0; m < 4; ++m) PG8_LDF(dst, m, PG8_SA(b, h) + aoff); } while (0)
#define PG8_LDB(dst, b, h) do { _Pragma("unroll") for (int n = 0; n < 2; ++n) PG8_LDF(dst, n, PG8_SB(b, h) + boff); } while (0)
#define PG8_MMA(ai, bj, At, Bt) do { __builtin_amdgcn_s_setprio(1); _Pragma("unroll") for (int m = 0; m < 4; ++m) _Pragma("unroll") for (int n = 0; n < 2; ++n) frag_mma<MODE == 2>(acc[ai][bj][m][n], Bt[n], At[m]); \
        __builtin_amdgcn_s_setprio(0); } while (0)
#define PG8_WAIT_V(n) asm volatile("s_waitcnt vmcnt(" #n ")" ::: "memory")
#define PG8_WAIT_L(n) asm volatile("s_waitcnt lgkmcnt(" #n ")" ::: "memory")
#define PG8_BAR __builtin_amdgcn_s_barrier()
#define PG8_SCHED __builtin_amdgcn_sched_barrier(0)
    Unit cur, nxt; int ui = 0;
    if (!S.next(0, cur)) return;
    Acc acc;
#pragma unroll
    for (int a = 0; a < 2; ++a)
#pragma unroll
        for (int b = 0; b < 2; ++b)
#pragma unroll
            for (int m = 0; m < 4; ++m)
#pragma unroll
                for (int n = 0; n < 2; ++n) acc[a][b][m][n] = (f32x4){0.f, 0.f, 0.f, 0.f};
    Frag<false> Ab[4], Bb0[2], Bb1[2]; Frag<true> Af[4], Bf0[2], Bf1[2];
    const char* cA = (const char*)g.A + (size_t)cur.pm * tstepA; const char* cB = (const char*)g.Bt + (size_t)cur.pn * tstepB;
    PG8_STAGE(PG8_SB(0, 0), cB, voffB); PG8_STAGE(PG8_SB(0, 1), cB + hstepB, voffB); PG8_STAGE(PG8_SA(0, 0), cA, voffA); PG8_STAGE(PG8_SA(0, 1), cA + hstepA, voffA);
    if (wr == 1) PG8_BAR;
    PG8_WAIT_V(2); PG8_BAR;
    PG8_STAGE(PG8_SB(1, 0), cB + kstep, voffB); PG8_STAGE(PG8_SA(1, 0), cA + kstep, voffA); PG8_STAGE(PG8_SB(1, 1), cB + hstepB + kstep, voffB);
    PG8_WAIT_V(6); PG8_BAR;
    for (;;) {
        const bool has_next = S.next(ui + 1, nxt);
        const char* nA = has_next ? (const char*)g.A + (size_t)nxt.pm * tstepA : cA; const char* nB = has_next ? (const char*)g.Bt + (size_t)nxt.pn * tstepB : cB;
#define PG8_KOFF(t) ((size_t)(t) * kstep + ((MODE == 2 && (t) >= T8) ? (size_t)T8 * kstep : (size_t)0))
#define PG8_TRIP(At, B0, B1) do { \
            const bool last = (t == nt - 2); \
            const char* a1 = cA + PG8_KOFF(t + 1); \
            const char* a2 = last ? nA : cA + PG8_KOFF(t + 2); const char* b2 = last ? nB : cB + PG8_KOFF(t + 2); \
            const char* a3 = a2 + kstep; const char* b3 = b2 + kstep; \
            if constexpr (Mid::ACTIVE) { if (t == th) { if constexpr (MODE == 2) asm volatile("s_nop 15\n\ts_nop 15" ::: "memory"); H(acc, cur, wr, wc, fr, fq); } } \
            PG8_LDB(B0, 0, 0); PG8_LDB(B1, 0, 1); PG8_SCHED; PG8_LDA(At, 0, 0); PG8_STAGE(PG8_SA(1, 1), a1 + hstepA, voffA); \
            PG8_WAIT_V(8); PG8_WAIT_L(0); PG8_BAR; PG8_MMA(0, 0, At, B0); PG8_MMA(0, 1, At, B1); PG8_BAR; PG8_SCHED; \
            PG8_LDA(At, 0, 1); PG8_STAGE(PG8_SB(0, 0), b2, voffB); PG8_STAGE(PG8_SB(0, 1), b2 + hstepB, voffB); PG8_STAGE(PG8_SA(0, 0), a2, voffA); \
            PG8_WAIT_V(8); PG8_WAIT_L(0); PG8_BAR; PG8_MMA(1, 0, At, B0); PG8_MMA(1, 1, At, B1); PG8_BAR; PG8_SCHED; \
            PG8_LDB(B0, 1, 0); PG8_LDB(B1, 1, 1); PG8_SCHED; PG8_LDA(At, 1, 0); PG8_STAGE(PG8_SA(0, 1), a2 + hstepA, voffA); \
            PG8_WAIT_V(8); PG8_WAIT_L(0); PG8_BAR; PG8_MMA(0, 0, At, B0); PG8_MMA(0, 1, At, B1); PG8_BAR; PG8_SCHED; \
            PG8_LDA(At, 1, 1); PG8_STAGE(PG8_SB(1, 0), b3, voffB); PG8_STAGE(PG8_SB(1, 1), b3 + hstepB, voffB); PG8_STAGE(PG8_SA(1, 0), a3, voffA); \
            PG8_WAIT_V(8); PG8_WAIT_L(0); PG8_BAR; PG8_MMA(1, 0, At, B0); PG8_MMA(1, 1, At, B1); PG8_BAR; PG8_SCHED; \
        } while (0)
        if constexpr (MODE == 2) {
            for (int t = 0; t < T8; t += 2) PG8_TRIP(Af, Bf0, Bf1);
            for (int t = T8; t < nt; t += 2) PG8_TRIP(Ab, Bb0, Bb1);
        } else if constexpr (MODE == 1) {
            for (int t = 0; t < nt; t += 2) PG8_TRIP(Af, Bf0, Bf1);
        } else {
            for (int t = 0; t < nt; t += 2) PG8_TRIP(Ab, Bb0, Bb1);
        }
        if constexpr (FP8) asm volatile("s_nop 15\n\ts_nop 15" ::: "memory");
        if (wr == 0) PG8_BAR;
        E(acc, cur, wr, wc, fr, fq, lds + STAGE_BYTES);
        if constexpr (EREP == 2) { asm volatile("" ::: "memory"); E(acc, cur, wr, wc, fr, fq, lds + STAGE_BYTES); }
        if (!has_next) break;
#pragma unroll
        for (int a = 0; a < 2; ++a)
#pragma unroll
            for (int b = 0; b < 2; ++b)
#pragma unroll
                for (int m = 0; m < 4; ++m)
#pragma unroll
                    for (int n = 0; n < 2; ++n) acc[a][b][m][n] = (f32x4){0.f, 0.f, 0.f, 0.f};
        cur = nxt; cA = nA; cB = nB; ++ui;
        if (wr == 1) PG8_BAR;
    }
    PG8_WAIT_V(0);
    PG8_BAR;
#undef PG8_SA
#undef PG8_SB
#undef PG8_STAGE
#undef PG8_LDA
#undef PG8_LDB
#undef PG8_MMA
#undef PG8_LDF
#undef PG8_TRIP
#undef PG8_KOFF
#undef PG8_WAIT_V
#undef PG8_WAIT_L
#undef PG8_BAR
#undef PG8_SCHED
}
}

struct Ptrs {
    const float *x, *norm1_g, *w_in, *q_norm_g, *k_norm_g, *idx_k_norm_g, *sgu_norm_g, *w_spatial, *b_spatial, *w_proj_a, *w_proj_b, *w_out, *norm2_g, *w_gate, *w_up, *w_down, *rel_bias;
    float* out; unsigned char* ws;
};

__device__ __forceinline__ unsigned pk4_fp8(float a, float b, float c, float d) { int w = __builtin_amdgcn_cvt_pk_fp8_f32(a, b, 0, false); w = __builtin_amdgcn_cvt_pk_fp8_f32(c, d, w, true); return (unsigned)w; }
__device__ __forceinline__ f32x4 ld_bf16x4(const bf16* p) { const u32x2 w = *(const u32x2*)p; f32x4 r; r[0] = bf2f(w.x & 0xffffu); r[1] = bf2f(w.x >> 16); r[2] = bf2f(w.y & 0xffffu); r[3] = bf2f(w.y >> 16); return r; }
__device__ __forceinline__ void store_bf16x4(bf16* p, f32x4 v) { u32x2 w; w.x = pk2(v[0], v[1]); w.y = pk2(v[2], v[3]); *(u32x2*)p = w; }

__device__ __forceinline__ void store_bf16x8(void* p, f32x4 a, f32x4 b) { u32x4 w; w.x = pk2(a[0], a[1]); w.y = pk2(a[2], a[3]); w.z = pk2(b[0], b[1]); w.w = pk2(b[2], b[3]); *(u32x4*)p = w; }
template <int ACT> __device__ __forceinline__ f32x4 act4(f32x4 v) {
    if (ACT == 1) { v[0] = gelu_tanh(v[0]); v[1] = gelu_tanh(v[1]); v[2] = gelu_tanh(v[2]); v[3] = gelu_tanh(v[3]); }
    if (ACT == 2) { v[0] = sigmoidf_(v[0]); v[1] = sigmoidf_(v[1]); v[2] = sigmoidf_(v[2]); v[3] = sigmoidf_(v[3]); }
    return v;
}
template <int ACT> __device__ __forceinline__ void epi_rowmajor(pg8::Acc& acc, char* dt, int rowb, unsigned lo) {
#pragma unroll
    for (int ai = 0; ai < 2; ++ai)
#pragma unroll
        for (int m = 0; m < 4; ++m) { char* dr = dt + (size_t)(ai * 128 + m * 16) * rowb;
#pragma unroll
            for (int bj = 0; bj < 2; ++bj) store_bf16x8(dr + lo + bj * 256, act4<ACT>(acc[ai][bj][m][0]), act4<ACT>(acc[ai][bj][m][1])); }
}
#ifndef FP8_QK
#define FP8_QK 1
#endif
constexpr int P1_NB16 = FP8_QK ? 2048 : 4096, P1_NF8 = FP8_QK ? 8192 : 6144;
constexpr int FFN_T8 = 12, FFN_KF = 128 * FFN_T8;
constexpr float OA_SCALE = 4.0f;
constexpr float GATE_WSCALE = 32.0f;
template <bool F8>
struct EpiIn {
    static constexpr bool PERM = true;
    unsigned char* ws; const float *gq, *gk;
    __device__ __forceinline__ void operator()(pg8::Acc& acc, const pg8::Unit& u, int wr, int wc, int fr, int fq, LAS unsigned char* scr) const {
        constexpr float SC = F8 ? 1.0f / GATE_WSCALE : 1.0f;
        const int rt0 = wr * 64 + fr; const int row0 = u.pm * 256 + rt0;
        if constexpr (F8) if (u.pn < 16) {
            unsigned char* ga_ = ws + WS_GA + (size_t)u.pm * 256 * 2048 + u.pn * 128; unsigned char* gb_ = ws + WS_GB + (size_t)u.pm * 256 * 2048 + u.pn * 128;
            unsigned lo = (unsigned)(rt0 * 2048 + wc * 32 + 8 * fq); asm volatile("" : "+v"(lo));
            constexpr float NS = -LOG2E * SC;
#pragma unroll
            for (int ai = 0; ai < 2; ++ai)
#pragma unroll
                for (int m = 0; m < 4; ++m) {
                    u32x2 wa, wb; wa.x = wa.y = wb.x = wb.y = 0u;
#pragma unroll
                    for (int n = 0; n < 2; ++n)
#pragma unroll
                        for (int e = 0; e < 4; ++e) {
                            const float ea = __builtin_amdgcn_exp2f(acc[ai][0][m][n][e] * NS), eb = __builtin_amdgcn_exp2f(acc[ai][1][m][n][e] * NS);
                            const float sa = 255.0f * __builtin_amdgcn_rcpf(1.0f + ea), sb = fmaxf(255.0f * __builtin_amdgcn_rcpf(1.0f + eb), 1.0f);
                            if (n == 0) { wa.x = __builtin_amdgcn_cvt_pk_u8_f32(sa, e, wa.x); wb.x = __builtin_amdgcn_cvt_pk_u8_f32(sb, e, wb.x); }
                            else        { wa.y = __builtin_amdgcn_cvt_pk_u8_f32(sa, e, wa.y); wb.y = __builtin_amdgcn_cvt_pk_u8_f32(sb, e, wb.y); }
                        }
                    *(u32x2*)(ga_ + (size_t)(ai * 128 + m * 16) * 2048 + lo) = wa; *(u32x2*)(gb_ + (size_t)(ai * 128 + m * 16) * 2048 + lo) = wb;
                }
            return;
        }
        const int pn = F8 ? (u.pn < 20 ? u.pn - 8 : (u.pn < 24 ? u.pn : u.pn - 24)) : (FP8_QK ? u.pn + 12 : (u.pn < 8 ? u.pn : u.pn + 4));
        LAS float* P = (LAS float*)scr;
        if (pn < 8) {
            const bool isq = pn < 4; const float* g = isq ? gq : gk;
            const float osc = (isq ? (0.08838834764831845f * LOG2E) : 1.0f) * SC;
#pragma unroll
            for (int ai = 0; ai < 2; ++ai)
#pragma unroll
                for (int m = 0; m < 4; ++m)
#pragma unroll
                    for (int bj = 0; bj < 2; ++bj) {
                        float s = 0.f;
#pragma unroll
                        for (int n = 0; n < 2; ++n) { const f32x4 v = acc[ai][bj][m][n]; s += (v[0] * v[0] + v[1] * v[1]) + (v[2] * v[2] + v[3] * v[3]); }
                        s += __shfl_xor(s, 16); s += __shfl_xor(s, 32);
                        if (fq == 0) P[(ai * 128 + rt0 + m * 16) * 8 + bj * 4 + wc] = s;
                    }
            LDS_BARRIER();
            f32x4 gv[2];
#pragma unroll
            for (int n = 0; n < 2; ++n) gv[n] = *(const f32x4*)(g + wc * 32 + 8 * fq + 4 * n) * osc;
            char* dt = (char*)ws + (isq ? WS_Q : WS_K) + ((size_t)u.pm * 256 * 1024 + (pn & 3) * 256) * 2;
            unsigned lo = (unsigned)(rt0 * 1024 + wc * 32 + 8 * fq) * 2u; asm volatile("" : "+v"(lo));
#pragma unroll
            for (int ai = 0; ai < 2; ++ai)
#pragma unroll
                for (int m = 0; m < 4; ++m) { char* dr = dt + (size_t)(ai * 128 + m * 16) * 2048;
#pragma unroll
                    for (int bj = 0; bj < 2; ++bj) {
                        const f32x4 pp = *(const LAS f32x4*)(P + (ai * 128 + rt0 + m * 16) * 8 + bj * 4);
                        const float rs = __builtin_amdgcn_rsqf(((pp[0] + pp[1]) + (pp[2] + pp[3])) * (SC * SC / 128.0f) + EPS);
                        store_bf16x8(dr + lo + bj * 256, acc[ai][bj][m][0] * rs * gv[0], acc[ai][bj][m][1] * rs * gv[1]);
                    } }
        } else if (pn < 12 || (pn >= 20 && pn < 24)) {
            const bool isv = pn < 12; bf16* dst = (bf16*)(ws + (isv ? WS_VT : WS_VBT)); const int chbase = ((isv ? pn - 8 : pn - 20)) * 256; float* rowsq_vb = (float*)(ws + WS_CTL + CTL_ROWSQ_VB);
            const int frp = isv ? (8 * ((fr >> 2) & 1) + 4 * (fr >> 3) + (fr & 3)) : fr;
            const int b = u.pm >> 3, s0 = (u.pm & 7) * 256 + wr * 64 + frp;
#pragma unroll
            for (int ai = 0; ai < 2; ++ai)
#pragma unroll
                for (int m = 0; m < 4; ++m) {
                    float ss = 0.f;
#pragma unroll
                    for (int bj = 0; bj < 2; ++bj)
#pragma unroll
                        for (int n = 0; n < 2; ++n) {
                            f32x4 v = acc[ai][bj][m][n];
                            if constexpr (F8) v = v * SC;
                            if (!isv) { v = act4<1>(v); ss += (v[0] * v[0] + v[1] * v[1]) + (v[2] * v[2] + v[3] * v[3]); }
                            const int ch = chbase + bj * 128 + wc * 32 + 8 * fq + 4 * n;
                            bf16* p = dst + ((size_t)(b * 1024 + ch)) * 2048 + s0 + ai * 128 + m * 16;
                            const unsigned w01 = pk2(v[0], v[1]), w23 = pk2(v[2], v[3]);
                            p[0] = (bf16)(w01 & 0xffffu); p[2048] = (bf16)(w01 >> 16); p[4096] = (bf16)(w23 & 0xffffu); p[6144] = (bf16)(w23 >> 16);
                        }
                    if (!isv) { ss += __shfl_xor(ss, 16); ss += __shfl_xor(ss, 32); if (fq == 0) unsafeAtomicAdd(rowsq_vb + row0 + ai * 128 + m * 16, ss); }
                }
        } else if constexpr (!F8) {
            const size_t doff = pn < 16 ? WS_QI : WS_U; const int colbase = (pn & 3) * 256;
            char* dt = (char*)ws + doff + ((size_t)u.pm * 256 * 1024 + colbase) * 2;
            unsigned lo = (unsigned)(rt0 * 1024 + wc * 32 + 8 * fq) * 2u; asm volatile("" : "+v"(lo));
            if (pn < 16) epi_rowmajor<0>(acc, dt, 2048, lo); else epi_rowmajor<1>(acc, dt, 2048, lo);
        }
    }
};

__device__ __forceinline__ void ld_bf16x8(const void* p, f32x4& a, f32x4& b) { const u32x4 w = *(const u32x4*)p; a[0] = bf2f(w.x & 0xffffu); a[1] = bf2f(w.x >> 16); a[2] = bf2f(w.y & 0xffffu); a[3] = bf2f(w.y >> 16); b[0] = bf2f(w.z & 0xffffu); b[1] = bf2f(w.z >> 16); b[2] = bf2f(w.w & 0xffffu); b[3] = bf2f(w.w >> 16); }
struct MidScale {
    static constexpr bool ACTIVE = true; float sc;
    __device__ __forceinline__ void operator()(pg8::Acc& acc, const pg8::Unit&, int, int, int, int) const {
#pragma unroll
        for (int ai = 0; ai < 2; ++ai)
#pragma unroll
            for (int bj = 0; bj < 2; ++bj)
#pragma unroll
                for (int m = 0; m < 4; ++m)
#pragma unroll
                    for (int n = 0; n < 2; ++n) acc[ai][bj][m][n] *= sc;
    }
};
__device__ __forceinline__ void ld_u8x8(const void* p, f32x4& a, f32x4& b) { const u32x2 w = *(const u32x2*)p;
    a[0] = (float)(w.x & 0xffu); a[1] = (float)((w.x >> 8) & 0xffu); a[2] = (float)((w.x >> 16) & 0xffu); a[3] = (float)(w.x >> 24);
    b[0] = (float)(w.y & 0xffu); b[1] = (float)((w.y >> 8) & 0xffu); b[2] = (float)((w.y >> 16) & 0xffu); b[3] = (float)(w.y >> 24); }
struct MidMerge {
    static constexpr bool ACTIVE = true;
    const unsigned char *GA, *GB; float sc;
    __device__ __forceinline__ void operator()(pg8::Acc& acc, const pg8::Unit& u, int wr, int wc, int fr, int fq) const {
        unsigned lane_off = (unsigned)((wr * 64 + fr) * 2048 + wc * 32 + fq * 8); asm volatile("" : "+v"(lane_off));
        const size_t tile = (size_t)u.pm * 256 * 2048 + (size_t)u.pn * 256;
        const unsigned char* ga_t = GA + tile; const unsigned char* gb_t = GB + tile;
#pragma unroll
        for (int ai = 0; ai < 2; ++ai)
#pragma unroll
            for (int m = 0; m < 4; ++m) {
                const unsigned char* ga_r = ga_t + (size_t)(ai * 128 + m * 16) * 2048; const unsigned char* gb_r = gb_t + (size_t)(ai * 128 + m * 16) * 2048;
#pragma unroll
                for (int bj = 0; bj < 2; ++bj) {
                    f32x4 a0, a1, b0, b1; ld_u8x8(ga_r + lane_off + bj * 128, a0, a1); ld_u8x8(gb_r + lane_off + bj * 128, b0, b1);
#pragma unroll
                    for (int e = 0; e < 4; ++e) { acc[ai][bj][m][0][e] *= a0[e] * __builtin_amdgcn_rcpf(b0[e]) * sc; acc[ai][bj][m][1][e] *= a1[e] * __builtin_amdgcn_rcpf(b1[e]) * sc; }
                }
                asm volatile("" ::: "memory");
            }
    }
};
struct EpiMerge {
    static constexpr bool PERM = true;
    const unsigned char* GB; bf16* MERGED;
    __device__ __forceinline__ void operator()(pg8::Acc& acc, const pg8::Unit& u, int wr, int wc, int fr, int fq, LAS unsigned char*) const {
        unsigned lane_off = (unsigned)((wr * 64 + fr) * 2048 + wc * 32 + fq * 8) * 2u; asm volatile("" : "+v"(lane_off));
        const size_t tile = ((size_t)u.pm * 256 * 2048 + (size_t)u.pn * 256) * 2;
        const unsigned char* gb_t = GB + (tile >> 1); char* mt = (char*)MERGED + tile;
#pragma unroll
        for (int ai = 0; ai < 2; ++ai)
#pragma unroll
            for (int m = 0; m < 4; ++m) {
                const unsigned char* gb_r = gb_t + (size_t)(ai * 128 + m * 16) * 2048; char* mr = mt + (size_t)(ai * 128 + m * 16) * 4096;
#pragma unroll
                for (int bj = 0; bj < 2; ++bj) { f32x4 gb0, gb1; ld_u8x8(gb_r + (lane_off >> 1) + bj * 128, gb0, gb1); store_bf16x8(mr + lane_off + bj * 256, acc[ai][bj][m][0] * (gb0 * (1.0f / 255.0f)), acc[ai][bj][m][1] * (gb1 * (1.0f / 255.0f))); }
            }
    }
};
struct EpiOut {
    static constexpr bool PERM = false;
    const float* X; bf16* X1B; float* rowsq2;
    __device__ __forceinline__ void operator()(pg8::Acc& acc, const pg8::Unit& u, int wr, int wc, int fr, int fq, LAS unsigned char*) const {
        const int row0 = u.pm * 256 + wr * 64 + fr;
        unsigned lo = (unsigned)((wr * 64 + fr) * 2048 + wc * 32 + fq * 4) * 4u; asm volatile("" : "+v"(lo));
        const size_t tile = ((size_t)u.pm * 256 * 2048 + (size_t)u.pn * 256) * 4;
        const char* xt = (const char*)X + tile; char* bt = (char*)X1B + tile / 2;
#pragma unroll
        for (int ai = 0; ai < 2; ++ai)
#pragma unroll
            for (int m = 0; m < 4; ++m) {
                const size_t ro = (size_t)(ai * 128 + m * 16) * 8192;
                float ss = 0.f;
#pragma unroll
                for (int bj = 0; bj < 2; ++bj)
#pragma unroll
                    for (int n = 0; n < 2; ++n) {
                        const f32x4 v = __builtin_nontemporal_load((const f32x4*)(xt + ro + lo + bj * 512 + n * 64)) + acc[ai][bj][m][n];
                        ss += (v[0] * v[0] + v[1] * v[1]) + (v[2] * v[2] + v[3] * v[3]);
                        store_bf16x4((bf16*)(bt + ro / 2 + (lo >> 1) + bj * 256 + n * 32), v);
                    }
                ss += __shfl_xor(ss, 16); ss += __shfl_xor(ss, 32);
                if (fq == 0) unsafeAtomicAdd(rowsq2 + row0 + ai * 128 + m * 16, ss);
            }
    }
};
__device__ __forceinline__ void ffn_up_store(pg8::Acc& acc, const float* rowsq2, bf16* ACT, int pm, int pnc, int wr, int wc, int fr, int fq) {
    const int row0 = pm * 256 + wr * 64 + fr;
    unsigned lane_off = (unsigned)((wr * 64 + fr) * DFF + wc * 32 + fq * 8) * 2u; asm volatile("" : "+v"(lane_off));
    const bool f8 = pnc < FFN_T8;
    char* at = (char*)ACT + (size_t)pm * 256 * DFF * 2 + (size_t)pnc * 128 * (f8 ? 1 : 2);
    if (f8) { lane_off = (unsigned)((wr * 64 + fr) * DFF * 2 + wc * 32 + fq * 8); asm volatile("" : "+v"(lane_off)); }
#pragma unroll
    for (int ai = 0; ai < 2; ++ai)
#pragma unroll
        for (int m = 0; m < 4; ++m) {
            const int row = row0 + ai * 128 + m * 16;
            const float rs = __builtin_amdgcn_rsqf(rowsq2[row] * (1.0f / (2048.0f * NREP(5))) + EPS);
            f32x4 o[2];
#pragma unroll
            for (int n = 0; n < 2; ++n) {
                const f32x4 gt = acc[ai][0][m][n] * rs, up = acc[ai][1][m][n] * rs;
#pragma unroll
                for (int e = 0; e < 4; ++e) o[n][e] = gt[e] * sigmoidf_(gt[e]) * up[e];
            }
            if (f8) { u32x2 w; w.x = pk4_fp8(o[0][0], o[0][1], o[0][2], o[0][3]); w.y = pk4_fp8(o[1][0], o[1][1], o[1][2], o[1][3]); *(u32x2*)(at + (size_t)(ai * 128 + m * 16) * (DFF * 2) + lane_off) = w; }
            else store_bf16x8(at + (size_t)(ai * 128 + m * 16) * (DFF * 2) + lane_off, o[0], o[1]);
        }
}
struct EpiFfnUp {
    static constexpr bool PERM = true;
    const float* rowsq2; bf16* ACT; int pn_off;
    __device__ __forceinline__ void operator()(pg8::Acc& acc, const pg8::Unit& u, int wr, int wc, int fr, int fq, LAS unsigned char*) const { ffn_up_store(acc, rowsq2, ACT, u.pm, u.pn + pn_off, wr, wc, fr, fq); }
};
struct EpiFfnUpPair {
    static constexpr bool PERM = true;
    const float* rowsq2; bf16* ACT; int pn_off; int half; float* slab; unsigned* flag;
    __device__ __forceinline__ void operator()(pg8::Acc& acc, const pg8::Unit& u, int wr, int wc, int fr, int fq, LAS unsigned char*) const {
        const int tid = threadIdx.x;
        unsigned so = (unsigned)tid * 16u; asm volatile("" : "+v"(so));
        char* sb = (char*)slab;
        if (half) {
#pragma unroll
            for (int ai = 0; ai < 2; ++ai)
#pragma unroll
                for (int bj = 0; bj < 2; ++bj)
#pragma unroll
                    for (int m = 0; m < 4; ++m)
#pragma unroll
                        for (int n = 0; n < 2; ++n) *(f32x4*)(sb + (size_t)((((ai * 2 + bj) * 4 + m) * 2 + n) * 8192) + so) = acc[ai][bj][m][n];
            asm volatile("s_waitcnt vmcnt(0)" ::: "memory");
            __builtin_amdgcn_s_barrier(); asm volatile("" ::: "memory");
            if (tid == 0) { __builtin_amdgcn_fence(__ATOMIC_RELEASE, "agent"); asm volatile("s_waitcnt vmcnt(0)" ::: "memory"); __hip_atomic_store(flag, 1u, __ATOMIC_RELAXED, __HIP_MEMORY_SCOPE_AGENT); }
        } else {
            if (tid < 64) {
                unsigned spins = 0;
                while ((unsigned)__builtin_amdgcn_readfirstlane(__hip_atomic_load(flag, __ATOMIC_RELAXED, __HIP_MEMORY_SCOPE_AGENT)) == 0u) { __builtin_amdgcn_s_sleep(2); if (++spins > (1u << 24)) break; }
                __builtin_amdgcn_fence(__ATOMIC_ACQUIRE, "agent");
                asm volatile("s_waitcnt vmcnt(0)" ::: "memory");
            }
            asm volatile("" ::: "memory"); __builtin_amdgcn_s_barrier(); asm volatile("" ::: "memory");
#pragma unroll
            for (int ai = 0; ai < 2; ++ai)
#pragma unroll
                for (int bj = 0; bj < 2; ++bj)
#pragma unroll
                    for (int m = 0; m < 4; ++m) {
#pragma unroll
                        for (int n = 0; n < 2; ++n) acc[ai][bj][m][n] += *(const f32x4*)(sb + (size_t)((((ai * 2 + bj) * 4 + m) * 2 + n) * 8192) + so);
                        asm volatile("" ::: "memory");
                    }
            ffn_up_store(acc, rowsq2, ACT, u.pm, u.pn + pn_off, wr, wc, fr, fq);
        }
    }
};
struct EpiFfnDown {
    static constexpr bool PERM = false;
    const bf16* X1B; float* OUT;
    __device__ __forceinline__ void operator()(pg8::Acc& acc, const pg8::Unit& u, int wr, int wc, int fr, int fq, LAS unsigned char*) const {
        unsigned lo = (unsigned)((wr * 64 + fr) * 2048 + wc * 32 + fq * 4) * 4u; asm volatile("" : "+v"(lo));
        const size_t tile = ((size_t)u.pm * 256 * 2048 + (size_t)u.pn * 256) * 4;
        const char* st = (const char*)X1B + tile / 2; char* ot = (char*)OUT + tile;
#pragma unroll
        for (int ai = 0; ai < 2; ++ai)
#pragma unroll
            for (int m = 0; m < 4; ++m) {
                const size_t ro = (size_t)(ai * 128 + m * 16) * 8192;
#pragma unroll
                for (int bj = 0; bj < 2; ++bj)
#pragma unroll
                    for (int n = 0; n < 2; ++n) __builtin_nontemporal_store(ld_bf16x4((const bf16*)(st + ro / 2 + (lo >> 1) + bj * 256 + n * 32)) + acc[ai][bj][m][n], (f32x4*)(ot + ro + lo + bj * 512 + n * 64));
            }
    }
};

__device__ __forceinline__ void kiwi_issue(const bf16* H1r, const bf16* Wr, int kc, LAS unsigned char* buf, int wave, int lane) {
    const int sub = lane >> 4, pos = lane & 15;
#pragma unroll
    for (int j = 0; j < 4; ++j) {
        const int rowi = 4 * (wave + 8 * j) + sub;
        const bf16* base = (j == 0) ? H1r + (size_t)rowi * 2048 : Wr + (size_t)(rowi - 32) * 2048;
        __builtin_amdgcn_global_load_lds((const unsigned*)(base + kc * 128 + ((pos ^ (rowi & 15)) * 8)), (LAS unsigned*)(buf + (wave + 8 * j) * 1024), 16, 0, 0);
    }
}
__device__ __forceinline__ void kiwi_unit(int rb, const bf16* H1, const bf16* WIN, const float* gki, bf16* KI, float* WI, LAS unsigned char* lds, int wave, int lane) {
    const int r = lane & 31, hs = lane >> 5;
    const bf16* H1r = H1 + (size_t)(rb * 32) * 2048; const bf16* Wr = WIN + (size_t)10240 * 2048;
    f32x16 acc[3];
#pragma unroll
    for (int cb = 0; cb < 3; ++cb)
#pragma unroll
        for (int i = 0; i < 16; ++i) acc[cb][i] = 0.f;
    kiwi_issue(H1r, Wr, 0, lds, wave, lane); kiwi_issue(H1r, Wr, 1, lds + 32768, wave, lane); kiwi_issue(H1r, Wr, 2, lds + 65536, wave, lane);
    asm volatile("s_waitcnt vmcnt(8)" ::: "memory"); LDS_BARRIER();
    const unsigned fbase = (unsigned)(r * 256 + (((2 * wave + hs) ^ (r & 15)) << 4));
#pragma unroll 1
    for (int kc = 0; kc < 16; ++kc) {
        LAS unsigned char* cur = lds + (kc & 3) * 32768;
        if (kc + 3 < 16) kiwi_issue(H1r, Wr, kc + 3, lds + ((kc + 3) & 3) * 32768, wave, lane);
        const bf16x8 a = *(const LAS bf16x8*)(cur + fbase);
#pragma unroll
        for (int cb = 0; cb < 3; ++cb) { const bf16x8 bfr = *(const LAS bf16x8*)(cur + (32 + 32 * cb) * 256 + fbase); acc[cb] = __builtin_amdgcn_mfma_f32_32x32x16_bf16(a, bfr, acc[cb], 0, 0, 0); }
        if (kc + 3 < 16) asm volatile("s_waitcnt vmcnt(8)" ::: "memory"); else if (kc + 2 < 16) asm volatile("s_waitcnt vmcnt(4)" ::: "memory"); else asm volatile("s_waitcnt vmcnt(0)" ::: "memory");
        LDS_BARRIER();
    }
    LAS float* part = (LAS float*)lds;
#pragma unroll
    for (int cb = 0; cb < 3; ++cb)
#pragma unroll
        for (int i = 0; i < 16; ++i) part[(wave * 48 + cb * 16 + i) * 64 + lane] = acc[cb][i];
    LDS_BARRIER();
#pragma unroll
    for (int ii = 0; ii < 2; ++ii) {
        const int i = 2 * wave + ii; float v[3];
#pragma unroll
        for (int cb = 0; cb < 3; ++cb) { float s = 0.f;
#pragma unroll
            for (int w = 0; w < 8; ++w) s += part[(w * 48 + cb * 16 + i) * 64 + lane];
            v[cb] = s; }
        float ss = v[0] * v[0] + v[1] * v[1];
        ss += __shfl_xor(ss, 1); ss += __shfl_xor(ss, 2); ss += __shfl_xor(ss, 4); ss += __shfl_xor(ss, 8); ss += __shfl_xor(ss, 16);
        const float rs = 1.0f / sqrtf(ss * (1.0f / 64.0f) + EPS);
        const size_t row = (size_t)(rb * 32 + rowoff16(i) + 4 * hs);
        KI[row * 64 + r] = (bf16)f2bf(v[0] * rs * gki[r]); KI[row * 64 + 32 + r] = (bf16)f2bf(v[1] * rs * gki[32 + r]);
        if (r < 16) WI[row * 16 + r] = v[2];
    }
    LDS_BARRIER();
}

constexpr int W8_FLAG = 0x10000;
__device__ __forceinline__ int rowmap(int mode, int n) {
    if (mode == 1) {
        if (n < 2048) return FP8_QK ? (W8_FLAG | (6144 + n)) : n;
        if (n < 3072) return W8_FLAG | (4096 + (n - 2048));
        if (n < 4096) return (FP8_QK ? 0 : 2048) + (n - 3072);
        if (n < 4160) return 10240 + (n - 4096); if (n < 4176) return 10240 + 64 + (n - 4160);
        if (n < 5200) return (FP8_QK ? 1024 : 3072) + (n - 4176);
        if (n < 6224) return W8_FLAG | (5120 + (n - 5200));
        const int j = n - 6224, gb = j >> 11, c = j & 2047; return W8_FLAG | ((c >> 7) * 256 + gb * 128 + (c & 127)); }
    if (mode == 4) return W8_FLAG | n;
    if (mode == 2) return (n >> 7) * 256 + (n & 127);
    if (mode == 3) return (n >> 7) * 256 + 128 + (n & 127);
    return n;
}
constexpr int P0_PITCH = 68, P0_WAVE_BYTES = 64 * P0_PITCH * 4;
__device__ __forceinline__ void p0_transpose_item(const float* W, int N, bf16* WT, int ldk, int koff, int mode, const float* kscale, LAS float* scr, int item, int lane, unsigned char* W8 = nullptr, int pitch8 = 2048) {
    const int nblk = (N + 63) / 64, kb = item / nblk, nb = item % nblk, k0 = 64 * kb, n0 = 64 * nb;
    const int kr = lane >> 4, nc = lane & 15; const bool ok = (n0 + 4 * nc) < N;
    const float* wp = W + (size_t)(k0 + kr) * N + n0 + 4 * nc;
    f32x4 v[16];
#pragma unroll
    for (int i = 0; i < 16; ++i) v[i] = ok ? __builtin_nontemporal_load((const f32x4*)(wp + (size_t)(4 * i) * N)) : (f32x4){0.f, 0.f, 0.f, 0.f};
#pragma unroll
    for (int i = 0; i < 16; ++i) *(LAS f32x4*)(scr + (4 * i + kr) * P0_PITCH + 4 * nc) = v[i];
    LDS_WAIT(); asm volatile("" ::: "memory");
    const int c = lane & 7, ng = lane >> 3;
    f32x4 ks0 = (f32x4){1.f, 1.f, 1.f, 1.f}, ks1 = ks0;
    if (kscale) { ks0 = *(const f32x4*)(kscale + k0 + 8 * c); ks1 = *(const f32x4*)(kscale + k0 + 8 * c + 4); }
#pragma unroll
    for (int j = 0; j < 2; ++j) {
        const int nn = 4 * (ng + 8 * j);
        f32x4 r[8];
#pragma unroll
        for (int kk = 0; kk < 8; ++kk) r[kk] = *(const LAS f32x4*)(scr + (8 * c + kk) * P0_PITCH + nn) * (kk < 4 ? ks0[kk] : ks1[kk - 4]);
        const int rm = (n0 + nn < N) ? rowmap(mode, n0 + nn) : 0;
        if (((mode == 1 || mode == 4) && (rm & W8_FLAG)) || (mode == 5 && k0 < FFN_KF)) {
            {
                unsigned char* op8 = W8 + (size_t)(rm & (W8_FLAG - 1)) * pitch8 + k0 + 8 * c;
#pragma unroll
                for (int e = 0; e < 4; ++e) { u32x2 o; o.x = pk4_fp8(r[0][e] * GATE_WSCALE, r[1][e] * GATE_WSCALE, r[2][e] * GATE_WSCALE, r[3][e] * GATE_WSCALE); o.y = pk4_fp8(r[4][e] * GATE_WSCALE, r[5][e] * GATE_WSCALE, r[6][e] * GATE_WSCALE, r[7][e] * GATE_WSCALE); __builtin_nontemporal_store(o, (u32x2*)(op8 + (size_t)e * pitch8)); }
            }
        } else if (n0 + nn < N) {
            bf16* op = WT + (size_t)rm * ldk + koff + k0 + 8 * c;
#pragma unroll
            for (int e = 0; e < 4; ++e) { u32x4 o; o.x = pk2(r[0][e], r[1][e]); o.y = pk2(r[2][e], r[3][e]); o.z = pk2(r[4][e], r[5][e]); o.w = pk2(r[6][e], r[7][e]); __builtin_nontemporal_store(o, (u32x4*)(op + (size_t)e * ldk)); }
        }
    }
    LDS_WAIT(); asm volatile("" ::: "memory");
}
__device__ __forceinline__ void p0_prologue(const Ptrs& P, LAS unsigned char* lds, int vcu, int G, int part) {
    const int tid = threadIdx.x, lane = tid & 63, wave = __builtin_amdgcn_readfirstlane(tid >> 6);
    unsigned char* ws = P.ws;
    LAS float* scr = (LAS float*)(lds + wave * P0_WAVE_BYTES);
    const int gw = vcu * 8 + wave, NGW = G * 8;
    bf16* WIN = (bf16*)(ws + WS_WIN); bf16* WAB = (bf16*)(ws + WS_WAB); bf16* WOUT = (bf16*)(ws + WS_WOUT); bf16* W1 = (bf16*)(ws + WS_W1); bf16* W2 = (bf16*)(ws + WS_W2);
    unsigned char* H1F8 = (unsigned char*)P.out + OUT_H1F8; unsigned char* W8 = (unsigned char*)P.out + OUT_W8;
    constexpr int I_IN = 32 * 162, I_A = 16 * 32, I_O = 32 * 32, I_G = 32 * 88, I_D = 88 * 32;
    constexpr int NITEMS = I_IN + 2 * I_A + I_O + 2 * I_G + I_D;
    const int it_hi = (part == 1) ? I_IN : NITEMS;
    int it0 = gw; if (part == 2 && gw < I_IN) it0 = gw + ((I_IN - gw + NGW - 1) / NGW) * NGW;
    for (int it = it0; it < it_hi; it += NGW) {
        int r = it;
        if (r < I_IN) { p0_transpose_item(P.w_in, DIN, WIN, 2048, 0, 1, nullptr, scr, r, lane, W8); continue; } r -= I_IN;
        if (r < I_A) { p0_transpose_item(P.w_proj_a, 2048, WAB, 2048, 0, 4, nullptr, scr, r, lane, (unsigned char*)WAB, 4096); continue; } r -= I_A;
        if (r < I_A) { p0_transpose_item(P.w_proj_b, 2048, WAB, 2048, 1024, 0, nullptr, scr, r, lane); continue; } r -= I_A;
        if (r < I_O) { p0_transpose_item(P.w_out, 2048, WOUT, 2048, 0, 0, nullptr, scr, r, lane); continue; } r -= I_O;
        if (r < I_G) { p0_transpose_item(P.w_gate, DFF, W1, 2048, 0, 2, P.norm2_g, scr, r, lane); continue; } r -= I_G;
        if (r < I_G) { p0_transpose_item(P.w_up, DFF, W1, 2048, 0, 3, P.norm2_g, scr, r, lane); continue; } r -= I_G;
        p0_transpose_item(P.w_down, 2048, W2, DFF, 0, 5, nullptr, scr, r, lane, (unsigned char*)W2, DFF * 2);
    }
    if (part == 2) return;
    for (int rr = DIN + gw; rr < NIN; rr += NGW) { u32x4* p = (u32x4*)(WIN + (size_t)rr * 2048); for (int j = lane; j < 256; j += 64) p[j] = (u32x4){0u, 0u, 0u, 0u}; }
    bf16* H1 = (bf16*)(ws + WS_H1);
    for (int m = gw; m < MTOK; m += NGW) {
        const f32x4* xr = (const f32x4*)(P.x + (size_t)m * DM) + lane; const f32x4* gr = (const f32x4*)P.norm1_g + lane;
        f32x4 v[8]; float s = 0.f;
#pragma unroll
        for (int j = 0; j < 8; ++j) { v[j] = __builtin_nontemporal_load(xr + 64 * j); s += (v[j][0] * v[j][0] + v[j][1] * v[j][1]) + (v[j][2] * v[j][2] + v[j][3] * v[j][3]); }
        const float rs = 1.0f / sqrtf(wave_sum(s) * (1.0f / DM) + EPS);
        u32x2* o = (u32x2*)(H1 + (size_t)m * DM) + lane; unsigned* o8 = (unsigned*)(H1F8 + (size_t)m * DM) + lane;
#pragma unroll
        for (int j = 0; j < 8; ++j) { const f32x4 gg = gr[64 * j]; const float h0 = v[j][0] * rs * gg[0], h1 = v[j][1] * rs * gg[1], h2 = v[j][2] * rs * gg[2], h3 = v[j][3] * rs * gg[3];
            u32x2 w; w.x = pk2(h0, h1); w.y = pk2(h2, h3); __builtin_nontemporal_store(w, o + 64 * j); __builtin_nontemporal_store(pk4_fp8(h0, h1, h2, h3), o8 + 64 * j); }
    }
    const int gt = vcu * 512 + tid, NGT = G * 512;
    bf16* WSP = (bf16*)(ws + WS_WSP); float* TBL = (float*)(ws + WS_TBL);
    for (int i = gt; i < NG * CHUNK * CHUNK; i += NGT) { const int s = i & 127, t = (i >> 7) & 127; WSP[i] = (bf16)f2bf(s <= t ? P.w_spatial[i] : 0.f); }
    for (int i = gt; i < NH * 132; i += NGT) { const int h = i / 132, d = i % 132; const int bk = d < 128 ? (int)T5_BUCKET[d] : 31; TBL[i] = P.rel_bias[bk * NH + h] * LOG2E; }
}

constexpr int IDX_ROW = 2048, IDX_WAVE_BYTES = 2 * IDX_ROW * 4;
__device__ __forceinline__ float half_min(float v) { v = fminf(v, __shfl_xor(v, 1)); v = fminf(v, __shfl_xor(v, 2)); v = fminf(v, __shfl_xor(v, 4)); v = fminf(v, __shfl_xor(v, 8)); return fminf(v, __shfl_xor(v, 16)); }
__device__ __forceinline__ float half_max(float v) { v = fmaxf(v, __shfl_xor(v, 1)); v = fmaxf(v, __shfl_xor(v, 2)); v = fmaxf(v, __shfl_xor(v, 4)); v = fmaxf(v, __shfl_xor(v, 8)); return fmaxf(v, __shfl_xor(v, 16)); }
__device__ __forceinline__ void indexer_unit(int b, int tb, const bf16* QI, const bf16* KI, const float* WI, unsigned* MASK, LAS unsigned char* lds, int wave, int lane, int mode = 0) {
    const int r = lane & 31, hs = lane >> 5;
    const int qa = tb * 16 + 2 * wave;
    const int cmax = (qa + 1) >> 5;
    const int aq = qa + ((r >> 2) & 1), ah = (r & 3) + 4 * (r >> 3);
    const bf16* ap = QI + ((size_t)(b * SEQ + aq)) * 1024 + ah * 64 + 8 * hs;
    bf16x8 af[4];
#pragma unroll
    for (int kk = 0; kk < 4; ++kk) af[kk] = *(const bf16x8*)(ap + 16 * kk);
    const int myq = qa + hs;
    const f32x4* wp = (const f32x4*)(WI + (size_t)(b * SEQ + myq) * 16);
    float wg[16];
#pragma unroll
    for (int j = 0; j < 4; ++j) { const f32x4 t = wp[j]; wg[4 * j] = t[0]; wg[4 * j + 1] = t[1]; wg[4 * j + 2] = t[2]; wg[4 * j + 3] = t[3]; }
    const bf16* kib = KI + (size_t)(b * SEQ) * 64;
    const unsigned kio = (unsigned)((8 * wave + (lane >> 3)) * 64 + (((lane & 7) ^ (((8 * wave + (lane >> 3)) >> 1) & 7)) * 8)) * 2u;
#define IDX_ISSUE(ch, buf) do { _Pragma("unroll") for (int _j = 0; _j < 4; ++_j) \
        __builtin_amdgcn_global_load_lds((const unsigned*)((const char*)kib + (size_t)(ch) * 32768 + (size_t)_j * 8192 + kio), (LAS unsigned*)((buf) + (wave + 8 * _j) * 1024), 16, 0, 0); } while (0)
    const unsigned fb = (unsigned)(r * 128 + ((((r >> 1) & 7) ^ hs) << 4));
    float u[64];
    float mn4[4] = {INFINITY, INFINITY, INFINITY, INFINITY}, mx4[4] = {-INFINITY, -INFINITY, -INFINITY, -INFINITY};
    if (mode != 2) {
        IDX_ISSUE(0, lds);
        if (8 <= cmax) { IDX_ISSUE(1, lds + 32768); asm volatile("s_waitcnt vmcnt(4)" ::: "memory"); } else asm volatile("s_waitcnt vmcnt(0)" ::: "memory");
        LDS_BARRIER();
    }
#pragma unroll
    for (int ch = 0; ch < 8; ++ch) {
        if (8 * ch <= cmax && mode != 2) {
            LAS unsigned char* cur = lds + (ch % 3) * 32768;
            const bool ahead = (ch + 2 < 8) && (8 * (ch + 2) <= cmax);
            if (ahead) IDX_ISSUE(ch + 2, lds + ((ch + 2) % 3) * 32768);
#pragma unroll
            for (int j = 0; j < 8; ++j) {
                const int c = 8 * ch + j;
                {
                    f32x16 acc;
#pragma unroll
                    for (int i = 0; i < 16; ++i) acc[i] = 0.f;
#pragma unroll
                    for (int kk = 0; kk < 4; ++kk) { const bf16x8 kf = *(const LAS bf16x8*)(cur + j * 4096 + (fb ^ (unsigned)(kk << 5))); acc = __builtin_amdgcn_mfma_f32_32x32x16_bf16(af[kk], kf, acc, 0, 0, 0); }
                    float s4[4] = {0.f, 0.f, 0.f, 0.f};
#pragma unroll
                    for (int i = 0; i < 16; ++i) { const float av = acc[i]; const int rb = __float_as_int(av); s4[i & 3] += wg[i] * __int_as_float(rb > 0 ? rb : 0); }
                    const float sv = (s4[0] + s4[1]) + (s4[2] + s4[3]); const bool ok = (32 * c + r <= myq);
                    u[c] = ok ? sv : -INFINITY; mx4[j & 3] = fmaxf(mx4[j & 3], ok ? sv : -INFINITY); mn4[j & 3] = fminf(mn4[j & 3], ok ? sv : INFINITY);
                }
            }
            if (ahead) asm volatile("s_waitcnt vmcnt(4)" ::: "memory"); else asm volatile("s_waitcnt vmcnt(0)" ::: "memory");
            LDS_BARRIER();
        } else {
#pragma unroll
            for (int j = 0; j < 8; ++j) u[8 * ch + j] = -INFINITY;
        }
    }
#undef IDX_ISSUE
    if (mode == 1) return;
    float T = -3.0e38f;
    if (qa >= 256) {
        float L = half_min(fminf(fminf(mn4[0], mn4[1]), fminf(mn4[2], mn4[3]))), H = half_max(fmaxf(fmaxf(mx4[0], mx4[1]), fmaxf(mx4[2], mx4[3])));
        bool done0 = false, done1 = false;
        for (int it = 0; it < 48; ++it) {
            const float mid = 0.5f * L + 0.5f * H;
            int cn4[4] = {0, 0, 0, 0};
#pragma unroll
            for (int g = 0; g < 8; ++g)
                if (8 * g <= cmax) {
#pragma unroll
                    for (int j = 0; j < 8; ++j) cn4[j & 3] += (u[8 * g + j] >= mid) ? 1 : 0;
                }
            int cnt = (cn4[0] + cn4[1]) + (cn4[2] + cn4[3]);
            cnt += __builtin_amdgcn_update_dpp(0, cnt, 0xB1, 0xF, 0xF, true);
            cnt += __builtin_amdgcn_update_dpp(0, cnt, 0x4E, 0xF, 0xF, true);
            cnt += __builtin_amdgcn_update_dpp(0, cnt, 0x141, 0xF, 0xF, true);
            cnt += __builtin_amdgcn_update_dpp(0, cnt, 0x140, 0xF, 0xF, true);
            const int c0 = __builtin_amdgcn_readlane(cnt, 0) + __builtin_amdgcn_readlane(cnt, 16);
            const int c1 = __builtin_amdgcn_readlane(cnt, 32) + __builtin_amdgcn_readlane(cnt, 48);
            const int mine = hs ? c1 : c0; const bool mydone = hs ? done1 : done0;
            if (!mydone) { if (mine == 256) T = mid; else if (mine > 256) L = mid; else H = mid; }
            done0 |= (c0 == 256); done1 |= (c1 == 256);
            if (done0 && done1) break;
        }
        if (!(hs ? done1 : done0)) T = L;
    }
    unsigned wl4[4] = {0u, 0u, 0u, 0u}, wh4[4] = {0u, 0u, 0u, 0u};
#pragma unroll
    for (int g = 0; g < 8; ++g)
        if (8 * g <= cmax) {
#pragma unroll
            for (int j = 0; j < 8; ++j) {
                const int c = 8 * g + j;
                const unsigned long long bal = __ballot(u[c] >= T);
                const unsigned blo = (unsigned)bal, bhi = (unsigned)(bal >> 32);
                asm volatile("s_nop 3\n\tv_writelane_b32 %0, %2, %4\n\tv_writelane_b32 %1, %3, %4" : "+v"(wl4[j & 3]), "+v"(wh4[j & 3]) : "s"(blo), "s"(bhi), "i"(c));
            }
            __builtin_amdgcn_sched_barrier(0);
        }
    const unsigned wlo = (wl4[0] | wl4[1]) | (wl4[2] | wl4[3]), whi = (wh4[0] | wh4[1]) | (wh4[2] | wh4[3]);
    MASK[(size_t)(b * SEQ + qa) * 64 + lane] = wlo; MASK[(size_t)(b * SEQ + qa + 1) * 64 + lane] = whi;
    LDS_WAIT();
}

__device__ __forceinline__ void sgu_unit(int b, int c, int g, const bf16* WSP, const bf16* VBT, const bf16* U, const float* rowsq_vb, float vbscale, const float* sgu_g, const float* bsp, bf16* OAB, LAS float* rsl, int wave, int lane) {
    const int tb = (wave >> 1) * 32, dblk = (wave & 1) * 64, r = lane & 31, hs = lane >> 5;
    LAS float* rw = rsl + wave * 128;
    const float q0 = rowsq_vb[b * SEQ + c * CHUNK + lane], q1 = rowsq_vb[b * SEQ + c * CHUNK + 64 + lane];
    f32x16 acc[2];
#pragma unroll
    for (int i = 0; i < 16; ++i) { acc[0][i] = 0.f; acc[1][i] = 0.f; }
    const int kkmax = 2 * (wave >> 1) + 1;
    u32x4 raw[8]; bf16x8 vfr[8][2];
#pragma unroll
    for (int kk = 0; kk < 8; ++kk)
        if (kk <= kkmax) {
            raw[kk] = *(const u32x4*)(WSP + (size_t)(g * CHUNK + tb + r) * CHUNK + 16 * kk + 8 * hs);
#pragma unroll
            for (int j2 = 0; j2 < 2; ++j2) vfr[kk][j2] = *(const bf16x8*)(VBT + ((size_t)(b * 1024 + g * 128 + dblk + 32 * j2 + r)) * 2048 + c * CHUNK + 16 * kk + 8 * hs);
        }
    const int t = tb + r; const size_t row = (size_t)(b * SEQ + c * CHUNK + t); const float bt = bsp[g * CHUNK + t];
    u32x2 uraw[2][4];
#pragma unroll
    for (int j2 = 0; j2 < 2; ++j2)
#pragma unroll
        for (int q4 = 0; q4 < 4; ++q4) uraw[j2][q4] = *(const u32x2*)(U + row * 1024 + g * 128 + dblk + 32 * j2 + 8 * q4 + 4 * hs);
    rw[lane] = 1.0f / sqrtf(q0 * vbscale + EPS); rw[64 + lane] = 1.0f / sqrtf(q1 * vbscale + EPS);
    LDS_WAIT();
#pragma unroll
    for (int kk = 0; kk < 8; ++kk)
        if (kk <= kkmax) {
            const LAS float* rp = rw + 16 * kk + 8 * hs;
            u32x4 sc;
            sc.x = pk2(bf2f(raw[kk].x & 0xffffu) * rp[0], bf2f(raw[kk].x >> 16) * rp[1]); sc.y = pk2(bf2f(raw[kk].y & 0xffffu) * rp[2], bf2f(raw[kk].y >> 16) * rp[3]);
            sc.z = pk2(bf2f(raw[kk].z & 0xffffu) * rp[4], bf2f(raw[kk].z >> 16) * rp[5]); sc.w = pk2(bf2f(raw[kk].w & 0xffffu) * rp[6], bf2f(raw[kk].w >> 16) * rp[7]);
            const bf16x8 wfr = __builtin_bit_cast(bf16x8, sc);
#pragma unroll
            for (int j2 = 0; j2 < 2; ++j2) acc[j2] = __builtin_amdgcn_mfma_f32_32x32x16_bf16(vfr[kk][j2], wfr, acc[j2], 0, 0, 0);
        }
#pragma unroll
    for (int j2 = 0; j2 < 2; ++j2)
#pragma unroll
        for (int q4 = 0; q4 < 4; ++q4) {
            const int d = g * 128 + dblk + 32 * j2 + 8 * q4 + 4 * hs;
            const f32x4 gd = *(const f32x4*)(sgu_g + d); const u32x2 uw = uraw[j2][q4]; f32x4 uv, o;
            uv[0] = bf2f(uw.x & 0xffffu); uv[1] = bf2f(uw.x >> 16); uv[2] = bf2f(uw.y & 0xffffu); uv[3] = bf2f(uw.y >> 16);
#pragma unroll
            for (int e = 0; e < 4; ++e) o[e] = uv[e] * (acc[j2][4 * q4 + e] * gd[e] + bt);
            store_bf16x4(OAB + row * 2048 + 1024 + d, o);
        }
    LDS_WAIT();
}

constexpr int AT_TILE = 16384, AT_BUF = 65536;
__device__ __forceinline__ void attn_issue(const bf16* Kg, const bf16* Vg, int s, LAS unsigned char* buf, int wave, unsigned voffK, unsigned voffV) {
#pragma unroll
    for (int tt = 0; tt < 2; ++tt)
#pragma unroll
        for (int j = 0; j < 2; ++j) {
            const int blk = wave + 8 * j;
            __builtin_amdgcn_global_load_lds((const unsigned*)((const char*)Kg + (size_t)(2 * s + tt) * 131072 + (size_t)j * 65536 + voffK), (LAS unsigned*)(buf + tt * AT_TILE + blk * 1024), 16, 0, 0);
            __builtin_amdgcn_global_load_lds((const unsigned*)((const char*)Vg + (size_t)(2 * s + tt) * 128 + (size_t)j * 262144 + voffV), (LAS unsigned*)(buf + 2 * AT_TILE + tt * AT_TILE + blk * 1024), 16, 0, 0);
        }
}
__device__ __forceinline__ void attn_unit(int b, int h, int iq, const bf16* Q, const bf16* K, const bf16* VT, const unsigned* MASK, const LAS float* tbl, bf16* OAB, LAS unsigned char* lds, int wave, int lane, int par, bool have_tile0, bool prefetch_next, bf16x8 (&qfx)[8], u32x2& mwx, int iq_next) {
    const int tid = threadIdx.x, qg = wave & 3, kg = wave >> 2, r = lane & 31, hs = lane >> 5;
    const int qw = 128 * iq + 32 * qg;
    const size_t qrow = (size_t)(b * SEQ + qw + r);
    const bf16* Kg = K + (size_t)(b * SEQ) * 1024 + h * HD;
    const bf16* Vg = VT + (size_t)(b * 1024 + h * HD) * 2048;
    const int nsteps = iq + 1;
    const int rq = 4 * wave + (lane >> 4);
    const unsigned voffK = (unsigned)(rq * 1024 + (((lane & 15) ^ (rq & 15)) * 8)) * 2u;
    const unsigned voffV = (unsigned)((8 * wave + (lane >> 3)) * 2048 + (((lane & 7) ^ (rq & 7)) * 8)) * 2u;
    if (!have_tile0) attn_issue(Kg, Vg, 0, lds + (par & 1) * AT_BUF, wave, voffK, voffV);
    bf16x8 qf[8]; u32x2 mw;
    if (have_tile0) {
#pragma unroll
        for (int kk = 0; kk < 8; ++kk) qf[kk] = qfx[kk];
        mw = mwx;
    } else {
#pragma unroll
        for (int kk = 0; kk < 8; ++kk) qf[kk] = *(const bf16x8*)(Q + qrow * 1024 + h * HD + 16 * kk + 8 * hs);
        mw = *(const u32x2*)(MASK + qrow * 64 + 2 * kg);
    }
    f32x16 o[4];
#pragma unroll
    for (int db = 0; db < 4; ++db)
#pragma unroll
        for (int i = 0; i < 16; ++i) o[db][i] = 0.f;
    float mref = 0.f, lrun = 0.f;
    const float c31 = tbl[128];
    const unsigned kbase = (unsigned)(r * 256 + (((r & 15) ^ hs) << 4));
    const unsigned vbase = (unsigned)(r * 128 + ((((r >> 1) & 7) ^ hs) << 4));
    AT_WAIT_BARRIER();
    for (int s = 0; s < nsteps; ++s) {
        LAS unsigned char* cur = lds + ((s + par) & 1) * AT_BUF; LAS unsigned char* nxt = lds + ((s + 1 + par) & 1) * AT_BUF;
        const bool more = (s + 1 < nsteps);
        if (more) attn_issue(Kg, Vg, s + 1, nxt, wave, voffK, voffV);
        else if (prefetch_next) attn_issue(Kg, Vg, 0, nxt, wave, voffK, voffV);
        const int t = 2 * s + kg;
        u32x2 mwn = mw;
        if (more) mwn = *(const u32x2*)(MASK + qrow * 64 + 2 * (t + 2));
        f32x16 p[2];
        const LAS unsigned char* Kt = cur + kg * AT_TILE;
        unsigned kofs = kbase; asm volatile("" : "+v"(kofs));
        const bool far = (qw - (64 * t + 63)) >= 113;
        if (far) {
            const int cb = __float_as_int(c31 - mref);
#pragma unroll
            for (int kb = 0; kb < 2; ++kb) {
                const int word = (int)((kb == 0 ? mw.x : mw.y) >> (4 * hs));
#pragma unroll
                for (int i = 0; i < 16; ++i) { const int tmask = __builtin_amdgcn_sbfe(word, rowoff16(i), 1); int rr; asm("v_bfi_b32 %0, %1, %2, %3" : "=v"(rr) : "v"(tmask), "v"(cb), "v"((int)0xFF800000)); p[kb][i] = __int_as_float(rr); }
            }
        } else {
            const int dist0 = (qw + r) - (64 * t + 4 * hs);
#pragma unroll
            for (int kb = 0; kb < 2; ++kb) {
                const int word = (int)((kb == 0 ? mw.x : mw.y) >> (4 * hs));
#pragma unroll
                for (int i = 0; i < 16; ++i) {
                    int di = dist0 - 32 * kb - rowoff16(i); di = di < 0 ? 0 : (di > 128 ? 128 : di);
                    const int cb = __float_as_int(tbl[di] - mref); const int tmask = __builtin_amdgcn_sbfe(word, rowoff16(i), 1); int rr;
                    asm("v_bfi_b32 %0, %1, %2, %3" : "=v"(rr) : "v"(tmask), "v"(cb), "v"((int)0xFF800000)); p[kb][i] = __int_as_float(rr);
                }
            }
        }
#pragma unroll
        for (int kb = 0; kb < 2; ++kb)
#pragma unroll
            for (int kk = 0; kk < 8; ++kk) {
                const bf16x8 kf = *(const LAS bf16x8*)(Kt + kb * 8192 + (kofs ^ (unsigned)(kk << 5)));
                p[kb] = __builtin_amdgcn_mfma_f32_32x32x16_bf16(kf, qf[kk], p[kb], 0, 0, 0);
            }
        float mx4[4] = {-INFINITY, -INFINITY, -INFINITY, -INFINITY};
#pragma unroll
        for (int kb = 0; kb < 2; ++kb)
#pragma unroll
            for (int i = 0; i < 16; ++i) { const float v = p[kb][i]; mx4[i & 3] = fmaxf(mx4[i & 3], v); }
        float mx = fmaxf(fmaxf(mx4[0], mx4[1]), fmaxf(mx4[2], mx4[3]));
        mx = fmaxf(mx, __shfl_xor(mx, 32));
        if (__any(mx > 8.0f)) {
            const float d = fmaxf(mx, 0.f), f = __builtin_amdgcn_exp2f(-d);
            mref += d; lrun *= f;
#pragma unroll
            for (int kb = 0; kb < 2; ++kb)
#pragma unroll
                for (int i = 0; i < 16; ++i) p[kb][i] -= d;
#pragma unroll
            for (int db = 0; db < 4; ++db)
#pragma unroll
                for (int i = 0; i < 16; ++i) o[db][i] *= f;
        }
        float ls4[4] = {0.f, 0.f, 0.f, 0.f};
#pragma unroll
        for (int kb = 0; kb < 2; ++kb)
#pragma unroll
            for (int i = 0; i < 16; ++i) { const float pv = p[kb][i]; const float e = __builtin_amdgcn_exp2f(pv); p[kb][i] = e; ls4[i & 3] += e; }
        lrun += (ls4[0] + ls4[1]) + (ls4[2] + ls4[3]);
        const LAS unsigned char* Vt = cur + 2 * AT_TILE + kg * AT_TILE;
        unsigned vofs = vbase; asm volatile("" : "+v"(vofs));
#pragma unroll
        for (int s4 = 0; s4 < 4; ++s4) {
            const int kb = s4 >> 1, e0 = 8 * (s4 & 1);
            u32x4 w; w.x = pk2(p[kb][e0], p[kb][e0 + 1]); w.y = pk2(p[kb][e0 + 2], p[kb][e0 + 3]); w.z = pk2(p[kb][e0 + 4], p[kb][e0 + 5]); w.w = pk2(p[kb][e0 + 6], p[kb][e0 + 7]);
            const bf16x8 pf = __builtin_bit_cast(bf16x8, w);
#pragma unroll
            for (int db = 0; db < 4; ++db) {
                const bf16x8 vf = *(const LAS bf16x8*)(Vt + db * 4096 + (vofs ^ (unsigned)((2 * s4) << 4)));
                o[db] = __builtin_amdgcn_mfma_f32_32x32x16_bf16(vf, pf, o[db], 0, 0, 0);
            }
        }
        mw = mwn;
        AT_WAIT_BARRIER();
    }
    if (prefetch_next) {
        const size_t qrow2 = (size_t)(b * SEQ + 128 * iq_next + 32 * qg + r);
#pragma unroll
        for (int kk = 0; kk < 8; ++kk) qfx[kk] = *(const bf16x8*)(Q + qrow2 * 1024 + h * HD + 16 * kk + 8 * hs);
        mwx = *(const u32x2*)(MASK + qrow2 * 64 + 2 * kg);
    }
    lrun += __shfl_xor(lrun, 32);
    LAS unsigned char* ebase = lds + ((nsteps - 1 + par) & 1) * AT_BUF;
    LAS unsigned* comb = (LAS unsigned*)(ebase + qg * 8704); LAS float* combf = (LAS float*)(ebase + qg * 8704 + 8192);
    if (kg == 1) {
#pragma unroll
        for (int db = 0; db < 4; ++db)
#pragma unroll
            for (int i2 = 0; i2 < 8; ++i2) comb[(db * 8 + i2) * 64 + lane] = pk2(o[db][2 * i2], o[db][2 * i2 + 1]);
        combf[lane] = mref; combf[64 + lane] = lrun;
    }
    LDS_BARRIER();
    if (kg == 0) {
        const float m1 = combf[lane], l1 = combf[64 + lane];
        const float mm = fmaxf(mref, m1);
        const float a0 = __builtin_amdgcn_exp2f(mref - mm), a1 = __builtin_amdgcn_exp2f(m1 - mm);
        const float inv = 1.0f / (lrun * a0 + l1 * a1);
        const float s0 = a0 * inv, s1 = a1 * inv;
        LAS unsigned char* stg = ebase + 34816 + qg * 4608;
#pragma unroll
        for (int db = 0; db < 4; ++db)
#pragma unroll
            for (int i4 = 0; i4 < 4; ++i4) {
                float v[4];
                const unsigned c01 = comb[(db * 8 + 2 * i4) * 64 + lane], c23 = comb[(db * 8 + 2 * i4 + 1) * 64 + lane];
                v[0] = o[db][4 * i4] * s0 + bf2f(c01 & 0xffffu) * s1; v[1] = o[db][4 * i4 + 1] * s0 + bf2f(c01 >> 16) * s1;
                v[2] = o[db][4 * i4 + 2] * s0 + bf2f(c23 & 0xffffu) * s1; v[3] = o[db][4 * i4 + 3] * s0 + bf2f(c23 >> 16) * s1;
                *(LAS unsigned*)(stg + r * 144 + (32 * db + 8 * i4 + 4 * hs)) = pk4_fp8(v[0] * OA_SCALE, v[1] * OA_SCALE, v[2] * OA_SCALE, v[3] * OA_SCALE);
            }
        LDS_WAIT();
#pragma unroll
        for (int j = 0; j < 4; ++j) {
            const int cid = lane + 64 * j, row = cid >> 3, ch = cid & 7;
            const u32x4 v = *(const LAS u32x4*)(stg + row * 144 + ch * 16);
            *(u32x4*)((unsigned char*)OAB + ((size_t)(b * SEQ + qw + row)) * 4096 + h * HD + ch * 16) = v;
        }
    }
    LDS_BARRIER();
}

#define XB_TMO      128
#define XB_XCNT(j)  (256  + 64 * (j))
#define XB_XSUB(j)  (1280 + 64 * (j))
#define XB_XGEN(j)  (2304 + 64 * (j))
#define XB_TOP      3328
#define XB_TOPGEN   3392
#define XCD_BAR_WORDS 3456
#define XB_SPIN_CAP (1u << 22)
__device__ __forceinline__ unsigned xb_ld(unsigned* p)              { return __hip_atomic_load(p, __ATOMIC_RELAXED, __HIP_MEMORY_SCOPE_AGENT); }
__device__ __forceinline__ unsigned xb_add(unsigned* p, unsigned v) { return __hip_atomic_fetch_add(p, v, __ATOMIC_RELAXED, __HIP_MEMORY_SCOPE_AGENT); }
__device__ __forceinline__ unsigned xb_xcc_id() { return (unsigned)__builtin_amdgcn_s_getreg((3 << 11) | 20) & 0xFu; }
#define XB_SPIN(cond, bar) do { unsigned _sp = 0; while (cond) { __builtin_amdgcn_s_sleep(1); \
    if ((++_sp & 255u) == 0u) { if (xb_ld(&(bar)[XB_TMO])) break; if (_sp > XB_SPIN_CAP) { atomicAdd(&(bar)[XB_TMO], 1u); break; } } } } while (0)
struct XcdBarrier { unsigned* bar; unsigned x; volatile LAS unsigned* st; };
__device__ __forceinline__ XcdBarrier xcd_barrier_post(unsigned* bar, volatile LAS unsigned* st) {
    XcdBarrier b; b.bar = bar; b.x = xb_xcc_id(); b.st = st;
    if (threadIdx.x == 0) (void)xb_add(&bar[XB_XCNT(b.x)], 1u);
    return b;
}
__device__ __forceinline__ void xcd_barrier_complete(unsigned* bar, unsigned x, unsigned& nloc, unsigned& nx) {
    const unsigned G = gridDim.x * gridDim.y * gridDim.z;
    unsigned sum, cnt, mine, sp = 0u;
    for (;;) {
        sum = 0u; cnt = 0u; mine = 0u;
#pragma unroll
        for (unsigned j = 0; j < 16; ++j) { const unsigned c = xb_ld(&bar[XB_XCNT(j)]); sum += c; cnt += (c > 0u) ? 1u : 0u; mine = (j == x) ? c : mine; }
        if (sum == G) break;
        __builtin_amdgcn_s_sleep(1);
        if ((++sp & 255u) == 0u) { if (xb_ld(&bar[XB_TMO])) break; if (sp > XB_SPIN_CAP) { atomicAdd(&bar[XB_TMO], 1u); break; } }
    }
    nloc = mine > 0u ? mine : 1u; nx = cnt > 0u ? cnt : 1u;
}
__device__ __forceinline__ void xcd_barrier(const XcdBarrier& b) {
    asm volatile("s_waitcnt vmcnt(0)" ::: "memory");
    __syncthreads();
    if (threadIdx.x == 0) {
        unsigned* bar = b.bar;
        __builtin_amdgcn_s_waitcnt(0);
        unsigned nloc = b.st[0], nx = b.st[1];
        if (nloc == 0u) { xcd_barrier_complete(bar, b.x, nloc, nx); b.st[0] = nloc; b.st[1] = nx; }
        const unsigned old = xb_add(&bar[XB_XSUB(b.x)], 1u);
        const unsigned gen = old / nloc;
        if (old + 1u == (gen + 1u) * nloc) {
            __builtin_amdgcn_fence(__ATOMIC_RELEASE, "agent");
            asm volatile("s_waitcnt vmcnt(0)" ::: "memory");
            const unsigned og = xb_add(&bar[XB_TOP], 1u);
            const unsigned tg = og / nx;
            if (og + 1u == (tg + 1u) * nx) xb_add(&bar[XB_TOPGEN], 1u);
            else XB_SPIN(xb_ld(&bar[XB_TOPGEN]) == tg, bar);
            __builtin_amdgcn_fence(__ATOMIC_ACQUIRE, "agent");
            xb_add(&bar[XB_XGEN(b.x)], 1u);
            asm volatile("s_waitcnt vmcnt(0)" ::: "memory");
        } else {
            XB_SPIN(xb_ld(&bar[XB_XGEN(b.x)]) == gen, bar);
            __builtin_amdgcn_fence(__ATOMIC_ACQUIRE, "agent");
            asm volatile("s_waitcnt vmcnt(0)" ::: "memory");
        }
    }
    __syncthreads();
}

struct Args { Ptrs p; int ph_lo, ph_hi, vbrep, mode; };
constexpr int NPHASE = 8;

__global__ void __launch_bounds__(512, 2) fwd(Args args) {
    extern __shared__ __attribute__((aligned(16))) unsigned char lds_raw[];
    LAS unsigned char* lds = (LAS unsigned char*)lds_raw;
    const Ptrs& P = args.p; unsigned char* ws = P.ws;
    const int tid = threadIdx.x, lane = tid & 63, wave = __builtin_amdgcn_readfirstlane(tid >> 6);
    const int G = gridDim.x, bx = blockIdx.x;
    const int vcu = (G % 8 == 0) ? (bx % 8) * (G / 8) + bx / 8 : bx;
    const int lo = args.ph_lo, hi = args.ph_hi;
#ifndef PHASE_MASK
#define PHASE_MASK 0xff
#endif
#define IN(k) (((PHASE_MASK >> (k)) & 1) && lo <= (k) && (k) < hi)
#if ONE_LAUNCH
    volatile LAS unsigned* bst = (volatile LAS unsigned*)(lds + LDS_BYTES - 64);
    if (tid < 16) bst[tid] = 0u;
    {
        unsigned* ctl = (unsigned*)(ws + WS_CTL);
        for (int i = bx * 512 + tid; i < (int)(CTL_BYTES / 4); i += G * 512) __hip_atomic_store(&ctl[i], 0u, __ATOMIC_RELAXED, __HIP_MEMORY_SCOPE_AGENT);
        asm volatile("s_waitcnt vmcnt(0)" ::: "memory");
    }
    __syncthreads();
    if (tid == 0) __builtin_amdgcn_fence(__ATOMIC_RELEASE, "agent");
    cg::this_grid().sync();
    XcdBarrier xbar = xcd_barrier_post((unsigned*)(ws + WS_CTL + CTL_BAR), bst);
#define SEAM(k) do { if (IN(k) && IN((k) + 1)) { xcd_barrier(xbar); if (NREP(13) == 2) xcd_barrier(xbar); } } while (0)
#else
#define SEAM(k) do { } while (0)
#endif
    bf16* WIN = (bf16*)(ws + WS_WIN); bf16* WAB = (bf16*)(ws + WS_WAB); bf16* WOUT = (bf16*)(ws + WS_WOUT); bf16* W1 = (bf16*)(ws + WS_W1); bf16* W2 = (bf16*)(ws + WS_W2);
    bf16* H1 = (bf16*)(ws + WS_H1); bf16* OAB = (bf16*)(ws + WS_OAB); bf16* ACT = (bf16*)(ws + WS_ACT);
    bf16* Qb = (bf16*)(ws + WS_Q); bf16* Kb = (bf16*)(ws + WS_K); bf16* VT = (bf16*)(ws + WS_VT); bf16* QI = (bf16*)(ws + WS_QI);
    bf16* Ub = (bf16*)(ws + WS_U); bf16* VBT = (bf16*)(ws + WS_VBT); bf16* X1B = (bf16*)(ws + WS_X1B); const unsigned char* GA = ws + WS_GA; const unsigned char* GB = ws + WS_GB;
    bf16* KI = (bf16*)(ws + WS_KI); float* WI = (float*)(ws + WS_WI); bf16* WSP = (bf16*)(ws + WS_WSP); float* TBL = (float*)(ws + WS_TBL);
    unsigned* MASK = (unsigned*)(ws + WS_MASK); bf16* MERGED = (bf16*)(ws + WS_MERGED);
    float* rowsq_vb = (float*)(ws + WS_CTL + CTL_ROWSQ_VB); float* rowsq2 = (float*)(ws + WS_CTL + CTL_ROWSQ2);

    if (IN(0)) for (int rep = 0; rep < NREP(0); ++rep) {
#if ONE_LAUNCH
        p0_prologue(P, lds, vcu, G, 1);
        asm volatile("s_waitcnt vmcnt(0)" ::: "memory");
        __syncthreads();
        if (IN(1) && tid == 0) { __builtin_amdgcn_fence(__ATOMIC_RELEASE, "agent"); asm volatile("s_waitcnt vmcnt(0)" ::: "memory"); (void)xb_add((unsigned*)(ws + WS_CTL + CTL_SEAM0), 1u); }
        p0_prologue(P, lds, vcu, G, 2);
#else
        p0_prologue(P, lds, vcu, G, 0);
#endif
    }
#if ONE_LAUNCH
    if (IN(0) && IN(1)) {
        asm volatile("s_waitcnt vmcnt(0)" ::: "memory");
        __syncthreads();
        if (tid == 0) { unsigned* c0 = (unsigned*)(ws + WS_CTL + CTL_SEAM0); XB_SPIN(xb_ld(c0) < (unsigned)G, xbar.bar); __builtin_amdgcn_fence(__ATOMIC_ACQUIRE, "agent"); asm volatile("s_waitcnt vmcnt(0)" ::: "memory"); }
        __syncthreads();
    }
#endif
    if (IN(1)) for (int rep = 0; rep < NREP(1); ++rep) {
        { pg8::Gemm g{H1, WIN, MTOK, P1_NB16, DM, DM, DM}; pg8::StaticOrder S; S.init(MTOK, P1_NB16, G, bx);
          EpiIn<false> E{ws, P.q_norm_g, P.k_norm_g};
          pg8::gemm_phase<EpiIn<false>, pg8::NoMid, NREP(12)>(lds, g, S, E); }
        { pg8::Gemm g{(const pg8::bf16_t*)((const unsigned char*)P.out + OUT_H1F8), (const pg8::bf16_t*)((const unsigned char*)P.out + OUT_W8), MTOK, P1_NF8, DM / 2, DM / 2, DM / 2}; pg8::StaticOrder S; S.init(MTOK, P1_NF8, G, bx);
          EpiIn<true> E{ws, P.q_norm_g, P.k_norm_g};
          pg8::gemm_phase<EpiIn<true>, pg8::NoMid, 1, pg8::StaticOrder, true>(lds, g, S, E); }
        for (int rb = bx; rb < MTOK / 32; rb += G) kiwi_unit(rb, H1, WIN, P.idx_k_norm_g, KI, WI, lds, wave, lane);
    }
    SEAM(1);
    if (IN(2)) for (int rep = 0; rep < NREP(2); ++rep) {
        for (int r2 = 0; r2 < NREP(8); ++r2)
        for (int p = vcu; p < 256; p += G) { const int b = p >> 6, i = p & 63; indexer_unit(b, i, QI, KI, WI, MASK, lds, wave, lane, args.mode); indexer_unit(b, 127 - i, QI, KI, WI, MASK, lds, wave, lane, args.mode); }
#if ONE_LAUNCH
        asm volatile("s_waitcnt vmcnt(0)" ::: "memory");
        __syncthreads();
        if (IN(3) && tid == 0) { __builtin_amdgcn_fence(__ATOMIC_RELEASE, "agent"); asm volatile("s_waitcnt vmcnt(0)" ::: "memory"); (void)xb_add((unsigned*)(ws + WS_CTL + CTL_SEAM2), 1u); }
#else
        __syncthreads();
#endif
        if (args.mode == 0)
        for (int r2 = 0; r2 < NREP(9); ++r2)
        for (int un = vcu; un < 512; un += G) { const int b = un >> 7, c = (un >> 3) & 15, g = un & 7; sgu_unit(b, c, g, WSP, VBT, Ub, rowsq_vb, 1.0f / (float)(WBW * NREP(1) * NREP(12) * args.vbrep), P.sgu_norm_g, P.b_spatial, OAB, (LAS float*)(lds + SCR_OFF), wave, lane); }
    }
#if ONE_LAUNCH
    if (IN(2) && IN(3)) {
        __syncthreads();
        if (tid == 0) { unsigned* c2 = (unsigned*)(ws + WS_CTL + CTL_SEAM2); XB_SPIN(xb_ld(c2) < (unsigned)G, xbar.bar); __builtin_amdgcn_fence(__ATOMIC_ACQUIRE, "agent"); asm volatile("s_waitcnt vmcnt(0)" ::: "memory"); }
        __syncthreads();
    }
#endif
    if (IN(3)) for (int rep = 0; rep < NREP(3); ++rep) {
        LAS float* tbl = (LAS float*)(lds + SCR_OFF);
        for (int p = vcu; p < 256; p += G) {
            const int b = p >> 6, h = (p >> 3) & 7, i = p & 7;
            __syncthreads();
            if (tid < 132) tbl[tid] = TBL[h * 132 + tid];
            __syncthreads();
            bf16x8 qfx[8]; u32x2 mwx;
            attn_unit(b, h, i, Qb, Kb, VT, MASK, tbl, OAB, lds, wave, lane, 0, false, true, qfx, mwx, 15 - i);
            attn_unit(b, h, 15 - i, Qb, Kb, VT, MASK, tbl, OAB, lds, wave, lane, (i + 1) & 1, true, false, qfx, mwx, 0);
        }
    }
    SEAM(3);
    if (IN(4)) for (int rep = 0; rep < NREP(4); ++rep) {
        pg8::Gemm g{OAB, WAB, MTOK, DM, 1536, DM, DM, 8}; pg8::StaticOrder S; S.init(MTOK, DM, G, bx);
        EpiMerge E{GB, MERGED}; MidMerge H{GA, GB, 1.0f / (GATE_WSCALE * OA_SCALE)}; pg8::gemm_phase<EpiMerge, MidMerge, 1, pg8::StaticOrder, 2>(lds, g, S, E, H);
    }
    SEAM(4);
    if (IN(5)) for (int rep = 0; rep < NREP(5); ++rep) {
        pg8::Gemm g{MERGED, WOUT, MTOK, DM, DM, DM, DM}; pg8::StaticOrder S; S.init(MTOK, DM, G, bx);
        EpiOut E{P.x, X1B, rowsq2}; pg8::gemm_phase(lds, g, S, E);
    }
    SEAM(5);
    if (IN(6)) for (int rep = 0; rep < NREP(6); ++rep) {
        { pg8::Gemm g{X1B, W1, MTOK, 10240, DM, DM, DM}; pg8::StaticOrder S; S.init(MTOK, 10240, G, bx); EpiFfnUp E{rowsq2, ACT, 0}; pg8::gemm_phase(lds, g, S, E); }
        if (G == 256) {
            const int xcd = bx & 7, idx = bx >> 3, t = xcd * 16 + (idx >> 1), half = idx & 1;
            pg8::Gemm g{X1B + half * 1024, W1 + (size_t)10240 * 2048 + half * 1024, MTOK, 1024, 1024, DM, DM}; pg8::OneUnit S{t >> 2, t & 3};
            EpiFfnUpPair E{rowsq2, ACT, 40, half, (float*)(ws + WS_SLAB) + (size_t)t * 65536, (unsigned*)(ws + WS_CTL + CTL_PAIR) + t * 16};
            pg8::gemm_phase<EpiFfnUpPair, pg8::NoMid, 1, pg8::OneUnit>(lds, g, S, E);
        } else {
            pg8::Gemm g{X1B, W1 + (size_t)10240 * 2048, MTOK, 1024, DM, DM, DM}; pg8::StaticOrder S; S.init(MTOK, 1024, G, bx); EpiFfnUp E{rowsq2, ACT, 40}; pg8::gemm_phase(lds, g, S, E);
        }
    }
    SEAM(6);
    if (IN(7)) for (int rep = 0; rep < NREP(7); ++rep) {
        pg8::Gemm g{ACT, W2, MTOK, DM, FFN_T8 * 64 + (DFF - FFN_KF), DFF, DFF, FFN_T8}; pg8::StaticOrder S; S.init(MTOK, DM, G, bx);
        EpiFfnDown E{X1B, P.out}; MidScale H{1.0f / GATE_WSCALE}; pg8::gemm_phase<EpiFfnDown, MidScale, 1, pg8::StaticOrder, 2>(lds, g, S, E, H);
    }
#undef IN
#undef SEAM
}

extern "C" void kernel_launch(void* const* d_in, const int* in_sizes, int n_in, void* d_out, int out_size, void* d_ws, size_t ws_size, hipStream_t stream) {
    static int grid = 0;
    if (grid == 0) {
        if (n_in != 17 || in_sizes[0] != MTOK * DM || out_size != MTOK * DM || ws_size < WS_END) { fprintf(stderr, "kernel_launch: unexpected shapes (n_in %d, in0 %d, out %d, ws %zu < %zu); nothing launched\n", n_in, n_in > 0 ? in_sizes[0] : -1, out_size, ws_size, (size_t)WS_END); grid = -1; return; }
        int dev = 0, cus = 0;
        if (hipGetDevice(&dev) != hipSuccess || hipDeviceGetAttribute(&cus, hipDeviceAttributeMultiprocessorCount, dev) != hipSuccess) { grid = -1; return; }
        if (hipFuncSetAttribute((const void*)fwd, hipFuncAttributeMaxDynamicSharedMemorySize, LDS_BYTES) != hipSuccess) { fprintf(stderr, "kernel_launch: hipFuncSetAttribute failed\n"); grid = -1; return; }
        int per_cu = 0;
        if (hipOccupancyMaxActiveBlocksPerMultiprocessor(&per_cu, (const void*)fwd, 512, LDS_BYTES) != hipSuccess || per_cu < 1) { fprintf(stderr, "kernel_launch: occupancy query says %d blocks per CU\n", per_cu); (void)hipGetLastError(); grid = -1; return; }
        grid = cus;
    }
    if (grid < 0) return;
#if !ONE_LAUNCH
    (void)hipMemsetAsync((char*)d_ws + WS_CTL, 0, CTL_BYTES, stream);
#endif
    Args a{};
    const float** pp = (const float**)&a.p;
    for (int i = 0; i < 17; ++i) pp[i] = (const float*)d_in[i];
    a.p.out = (float*)d_out; a.p.ws = (unsigned char*)d_ws;
#if ONE_LAUNCH
    a.ph_lo = 0; a.ph_hi = NPHASE; a.vbrep = 1; a.mode = 0;
    void* kargs[] = {&a};
    hipError_t e = hipLaunchCooperativeKernel((const void*)fwd, dim3(grid), dim3(512), kargs, LDS_BYTES, stream);
    if (e != hipSuccess) fprintf(stderr, "cooperative launch failed: %s (grid %d)\n", hipGetErrorString(e), grid);
#else
#ifndef ML_REP_PHASE
#define ML_REP_PHASE -1
#endif
    a.vbrep = (ML_REP_PHASE == 1) ? 2 : 1; a.mode = 0;
#ifndef ML_P2_MODE
#define ML_P2_MODE 0
#endif
    for (int ph = 0; ph < NPHASE; ++ph) { a.ph_lo = ph; a.ph_hi = ph + 1; if (ph == 2 && ML_P2_MODE) { a.mode = ML_P2_MODE; hipLaunchKernelGGL(fwd, dim3(grid), dim3(512), LDS_BYTES, stream, a); a.mode = 0; }
        for (int k = 0; k < ((ph == ML_REP_PHASE) ? 2 : 1); ++k) hipLaunchKernelGGL(fwd, dim3(grid), dim3(512), LDS_BYTES, stream, a); }
#endif
}
```
